# Optimizing an MI355X kernel written in HIP

```python
import math
import jax, jax.numpy as jnp
from jax import lax
import numpy as np

D_MODEL = 2048
BATCH = 4
SEQ = 4096
DEPTH = 1

CTX_LEN = 256
GRID_W = 64
D_MIX = D_MODEL
CM_WIDTH = D_MIX // 2
CM_HEADS = 8
CM_HEAD_DIM = CM_WIDTH // CM_HEADS
CM_CHUNK = 128
CM_CHUNK_ROWS = CM_CHUNK // GRID_W
GLA_WIDTH = D_MIX - CM_WIDTH
GLA_HEADS = 4
GLA_DV = GLA_WIDTH // GLA_HEADS
GLA_DK = GLA_DV // 2
GLA_KEY_WIDTH = GLA_HEADS * GLA_DK
GLA_GATE_RANK = 16
GLA_GATE_NORMALIZER = 16.0
GLA_CHUNK = 64
N_EXPERTS = 32
TOP_K = 4
D_EXPERT = D_MODEL
SWIGLU_LIMIT = 7.0
SWIGLU_ALPHA = 1.702
MOE_BLOCK = 256
N_MOD = 6
DEEPNORM_ALPHA = (2 * DEPTH) ** 0.25
DEEPNORM_BETA = (8 * DEPTH) ** -0.25
LN_EPS = 1e-5
RMS_EPS = 1e-6
D_IN = 2 * CM_WIDTH + 2 * GLA_KEY_WIDTH + 2 * GLA_WIDTH + 2 * GLA_GATE_RANK
IN_SPLITS = (CM_WIDTH,
             2 * CM_WIDTH,
             2 * CM_WIDTH + GLA_KEY_WIDTH,
             2 * CM_WIDTH + 2 * GLA_KEY_WIDTH,
             2 * CM_WIDTH + 2 * GLA_KEY_WIDTH + GLA_WIDTH,
             2 * CM_WIDTH + 2 * GLA_KEY_WIDTH + 2 * GLA_WIDTH,
             2 * CM_WIDTH + 2 * GLA_KEY_WIDTH + 2 * GLA_WIDTH + GLA_GATE_RANK)

kernel_name = 'hybrid_chunkmlp_gla_moe_prefix'


def layer_norm(t, g, b):
    tf = t.astype(jnp.float32)
    mu = jnp.mean(tf, axis=-1, keepdims=True)
    var = jnp.mean(jnp.square(tf - mu), axis=-1, keepdims=True)
    return ((tf - mu) * lax.rsqrt(var + LN_EPS)).astype(t.dtype) * g + b


def modulate(t, shift, scale):
    return t * (1 + scale) + shift


def post_norm(h, y, g, b):
    return layer_norm(DEEPNORM_ALPHA * h + y, g, b)


def split_heads(t, n_heads):
    b, l, _ = t.shape
    return t.reshape(b, l, n_heads, -1).transpose(0, 2, 1, 3)


def flip_seq(t):
    return jnp.flip(t, axis=2)


def chunk_spatial_gate(u, v, n_chunks, norm_g, norm_b, w_s, b_s):
    b, l, _ = v.shape
    v = layer_norm(v, norm_g, norm_b).reshape(b, n_chunks, CM_CHUNK, CM_HEADS, CM_HEAD_DIM)
    s = jnp.einsum('hpq,bnqhe->bnphe', w_s, v) + b_s.T[:, :, None]
    return u * s.reshape(b, l, CM_WIDTH)


def gla_inputs(qp, kp, vp, lr_f, lr_b, w_gk_f, b_gk_f, w_gk_b, b_gk_b):
    q = split_heads(qp, GLA_HEADS) * (GLA_DK ** -0.5)
    k = split_heads(kp, GLA_HEADS)
    v = split_heads(vp, GLA_HEADS)
    g_f = jax.nn.log_sigmoid((lr_f @ w_gk_f + b_gk_f).astype(jnp.float32)) / GLA_GATE_NORMALIZER
    g_b = jax.nn.log_sigmoid((lr_b @ w_gk_b + b_gk_b).astype(jnp.float32)) / GLA_GATE_NORMALIZER
    return q, k, v, split_heads(g_f, GLA_HEADS), split_heads(g_b, GLA_HEADS)


def gla_chunked(q, k, v, g, s0):
    bsz, nh, l, dk = q.shape
    dv = v.shape[-1]
    n = l // GLA_CHUNK
    q = q.reshape(bsz, nh, n, GLA_CHUNK, dk).astype(jnp.float32)
    k = k.reshape(bsz, nh, n, GLA_CHUNK, dk).astype(jnp.float32)
    v = v.reshape(bsz, nh, n, GLA_CHUNK, dv).astype(jnp.float32)
    bcum = jnp.cumsum(g.reshape(bsz, nh, n, GLA_CHUNK, dk), axis=3)
    b_last = bcum[:, :, :, -1:, :]
    qe = q * jnp.exp(bcum)
    ke = k * jnp.exp(-bcum)
    kd = k * jnp.exp(b_last - bcum)
    mask = jnp.tril(jnp.ones((GLA_CHUNK, GLA_CHUNK), dtype=bool))
    att = jnp.where(mask, jnp.einsum('bhntd,bhnsd->bhnts', qe, ke), 0.0)
    o_intra = jnp.einsum('bhnts,bhnse->bhnte', att, v)
    u = jnp.einsum('bhnsd,bhnse->bhnde', kd, v)
    decay = jnp.exp(b_last[:, :, :, 0, :])

    def step(s, inp):
        d, uu = inp
        return d[..., None] * s + uu, s

    s_fin, s_prev = lax.scan(step, s0, (jnp.moveaxis(decay, 2, 0), jnp.moveaxis(u, 2, 0)))
    s_prev = jnp.moveaxis(s_prev, 0, 2)
    o = o_intra + jnp.einsum('bhntd,bhnde->bhnte', qe, s_prev)
    return o.reshape(bsz, nh, l, dv), s_fin


def gla_bidirectional(q, k, v, g_f, g_b, s0_f, s0_b):
    o_f, s_f = gla_chunked(q, k, v, g_f, s0_f)
    o_b, s_b = gla_chunked(flip_seq(q), flip_seq(k), flip_seq(v), flip_seq(g_b), s0_b)
    return o_f + flip_seq(o_b), s_f, s_b


def gla_output(o, gate, norm_g):
    o = o * lax.rsqrt(jnp.mean(jnp.square(o), axis=-1, keepdims=True) + RMS_EPS) * norm_g
    b, nh, l, dv = o.shape
    o = o.transpose(0, 2, 1, 3).reshape(b, l, nh * dv)
    return (o * jax.nn.silu(gate.astype(jnp.float32))).astype(gate.dtype)


def moe(h, w_r, b_r, w_gu, b_gu, w_dn, b_dn):
    n, d = h.shape
    logits = (h @ w_r + b_r).astype(jnp.float32)
    top_val, top_idx = lax.top_k(logits, TOP_K)
    top_w = jax.nn.softmax(top_val, axis=-1)
    m = n * TOP_K
    e_flat = top_idx.reshape(-1).astype(jnp.int32)
    w_flat = top_w.reshape(-1)
    t_flat = jnp.arange(m, dtype=jnp.int32) // TOP_K
    order = jnp.argsort(e_flat)
    e_sorted = e_flat[order]
    counts = jnp.bincount(e_flat, length=N_EXPERTS).astype(jnp.int32)
    starts = jnp.cumsum(counts) - counts
    padded = (counts + MOE_BLOCK - 1) // MOE_BLOCK * MOE_BLOCK
    pad_ends = jnp.cumsum(padded)
    pad_starts = pad_ends - padded
    dest = pad_starts[e_sorted] + jnp.arange(m, dtype=jnp.int32) - starts[e_sorted]
    n_blocks = -(-(m + N_EXPERTS * (MOE_BLOCK - 1)) // MOE_BLOCK)
    n_slots = n_blocks * MOE_BLOCK
    slot_tok = jnp.zeros((n_slots,), jnp.int32).at[dest].set(t_flat[order])
    slot_w = jnp.zeros((n_slots,), jnp.float32).at[dest].set(w_flat[order])
    blk_start = jnp.arange(n_blocks, dtype=jnp.int32) * MOE_BLOCK
    blk_exp = jnp.minimum(jnp.searchsorted(pad_ends, blk_start, side='right'), N_EXPERTS - 1)

    def expert_block(args):
        tok, e = args
        xb = h[tok]
        gu = xb @ w_gu[e] + b_gu[e]
        gate, up = jnp.split(gu, 2, axis=-1)
        gate = jnp.minimum(gate, SWIGLU_LIMIT)
        up = jnp.clip(up, -SWIGLU_LIMIT, SWIGLU_LIMIT)
        act = (up + 1) * gate * jax.nn.sigmoid(SWIGLU_ALPHA * gate)
        return act @ w_dn[e] + b_dn[e]

    yb = lax.map(expert_block, (slot_tok.reshape(n_blocks, MOE_BLOCK), blk_exp))
    contrib = yb.reshape(n_slots, d).astype(jnp.float32) * slot_w[:, None]
    y = jnp.zeros((n, d), jnp.float32).at[slot_tok].add(contrib)
    return y.astype(h.dtype)


def setup_inputs(seed: int = 0) -> dict:
    key = jax.random.key(seed)
    ks = jax.random.split(key, 32)

    def nrm(k, shape, scale):
        return jax.random.normal(k, shape, jnp.float32) * scale

    return {
        'x': nrm(ks[0], (BATCH, SEQ, D_MODEL), 1.0),
        'c': nrm(ks[1], (BATCH, D_MODEL), 1.0),
        'ctx': nrm(ks[2], (BATCH, CTX_LEN, D_MODEL), 1.0),
        'c_ctx': nrm(ks[3], (D_MODEL,), 1.0),
        'ln_in_g': 1.0 + nrm(ks[4], (D_MODEL,), 0.01),
        'ln_in_b': nrm(ks[5], (D_MODEL,), 0.01),
        'w_ada': nrm(ks[6], (DEPTH, D_MODEL, N_MOD * D_MODEL), D_MODEL ** -0.5),
        'b_ada': nrm(ks[7], (DEPTH, N_MOD * D_MODEL), 0.01),
        'w_in': nrm(ks[8], (DEPTH, D_MODEL, D_IN), D_MODEL ** -0.5),
        'cm_norm_g': 1.0 + nrm(ks[9], (DEPTH, CM_WIDTH), 0.01),
        'cm_norm_b': nrm(ks[10], (DEPTH, CM_WIDTH), 0.01),
        'cm_w_s': nrm(ks[11], (DEPTH, CM_HEADS, CM_CHUNK, CM_CHUNK), CM_CHUNK ** -0.5),
        'cm_b_s': 1.0 + nrm(ks[12], (DEPTH, CM_HEADS, CM_CHUNK), 0.01),
        'gla_w_gk_f': nrm(ks[13], (DEPTH, GLA_GATE_RANK, GLA_KEY_WIDTH), GLA_GATE_RANK ** -0.5),
        'gla_b_gk_f': nrm(ks[14], (DEPTH, GLA_KEY_WIDTH), 0.1),
        'gla_w_gk_b': nrm(ks[15], (DEPTH, GLA_GATE_RANK, GLA_KEY_WIDTH), GLA_GATE_RANK ** -0.5),
        'gla_b_gk_b': nrm(ks[16], (DEPTH, GLA_KEY_WIDTH), 0.1),
        'gla_norm_g': 1.0 + nrm(ks[17], (DEPTH, GLA_DV), 0.01),
        'w_out': nrm(ks[18], (DEPTH, D_MIX, D_MODEL), D_MIX ** -0.5 * DEEPNORM_BETA),
        'ln1_g': 1.0 + nrm(ks[19], (DEPTH, D_MODEL), 0.01),
        'ln1_b': nrm(ks[20], (DEPTH, D_MODEL), 0.01),
        'w_router': nrm(ks[21], (DEPTH, D_MODEL, N_EXPERTS), D_MODEL ** -0.5),
        'b_router': nrm(ks[22], (DEPTH, N_EXPERTS), 0.01),
        'w_gate_up': nrm(ks[23], (DEPTH, N_EXPERTS, D_MODEL, 2 * D_EXPERT), D_MODEL ** -0.5),
        'b_gate_up': nrm(ks[24], (DEPTH, N_EXPERTS, 2 * D_EXPERT), 0.01),
        'w_down': nrm(ks[25], (DEPTH, N_EXPERTS, D_EXPERT, D_MODEL), D_EXPERT ** -0.5 * DEEPNORM_BETA),
        'b_down': nrm(ks[26], (DEPTH, N_EXPERTS, D_MODEL), 0.01),
        'ln2_g': 1.0 + nrm(ks[27], (DEPTH, D_MODEL), 0.01),
        'ln2_b': nrm(ks[28], (DEPTH, D_MODEL), 0.01),
    }


def reference(x, c, ctx, c_ctx, ln_in_g, ln_in_b, w_ada, b_ada, w_in, cm_norm_g, cm_norm_b,
              cm_w_s, cm_b_s, gla_w_gk_f, gla_b_gk_f, gla_w_gk_b, gla_b_gk_b, gla_norm_g,
              w_out, ln1_g, ln1_b, w_router, b_router, w_gate_up, b_gate_up, w_down, b_down,
              ln2_g, ln2_b):
    bsz, n_lat, d = x.shape
    rows = n_lat // GRID_W
    n_chunks_x = rows // CM_CHUNK_ROWS
    n_chunks_c = ctx.shape[1] // CM_CHUNK
    h_x = layer_norm(x, ln_in_g, ln_in_b)
    h_c = layer_norm(ctx, ln_in_g, ln_in_b)
    s_zero = jnp.zeros((bsz, GLA_HEADS, GLA_DK, GLA_DV), jnp.float32)

    for l in range(DEPTH):
        last = l == DEPTH - 1
        mod_x = jax.nn.silu(c) @ w_ada[l] + b_ada[l]
        mod_c = jax.nn.silu(c_ctx) @ w_ada[l] + b_ada[l]
        sh1x, sc1x, g1x, sh2x, sc2x, g2x = jnp.split(mod_x[:, None, :], N_MOD, axis=-1)
        sh1c, sc1c, g1c, sh2c, sc2c, g2c = jnp.split(mod_c, N_MOD, axis=-1)

        px = modulate(h_x, sh1x, sc1x) @ w_in[l]
        pc = modulate(h_c, sh1c, sc1c) @ w_in[l]
        ux, vx, qx, kx, vvx, gox, lfx, lbx = jnp.split(px, IN_SPLITS, axis=-1)
        uc, vc, qc, kc, vvc, goc, lfc, lbc = jnp.split(pc, IN_SPLITS, axis=-1)

        cm_x = chunk_spatial_gate(jax.nn.gelu(ux, approximate=False), jax.nn.gelu(vx, approximate=False),
                                  n_chunks_x, cm_norm_g[l], cm_norm_b[l], cm_w_s[l], cm_b_s[l])

        q_c, k_c, v_c, gf_c, gb_c = gla_inputs(qc, kc, vvc, lfc, lbc, gla_w_gk_f[l], gla_b_gk_f[l],
                                               gla_w_gk_b[l], gla_b_gk_b[l])
        q_x, k_x, v_x, gf_x, gb_x = gla_inputs(qx, kx, vvx, lfx, lbx, gla_w_gk_f[l], gla_b_gk_f[l],
                                               gla_w_gk_b[l], gla_b_gk_b[l])
        o_c, s_cf, s_cb = gla_bidirectional(q_c, k_c, v_c, gf_c, gb_c, s_zero, s_zero)
        o_x, _, _ = gla_bidirectional(q_x, k_x, v_x, gf_x, gb_x, s_cf, s_cb)
        gla_x = gla_output(o_x, gox, gla_norm_g[l])

        y_x = jnp.concatenate([cm_x, gla_x], axis=-1) @ w_out[l]
        h_x = post_norm(h_x, g1x * y_x, ln1_g[l], ln1_b[l])
        f_x = moe(modulate(h_x, sh2x, sc2x).reshape(-1, d), w_router[l], b_router[l],
                  w_gate_up[l], b_gate_up[l], w_down[l], b_down[l]).reshape(bsz, n_lat, d)
        h_x = post_norm(h_x, g2x * f_x, ln2_g[l], ln2_b[l])

        if not last:
            cm_c = chunk_spatial_gate(jax.nn.gelu(uc, approximate=False), jax.nn.gelu(vc, approximate=False),
                                      n_chunks_c, cm_norm_g[l], cm_norm_b[l], cm_w_s[l], cm_b_s[l])
            gla_c = gla_output(o_c, goc, gla_norm_g[l])
            y_c = jnp.concatenate([cm_c, gla_c], axis=-1) @ w_out[l]
            h_c = post_norm(h_c, g1c * y_c, ln1_g[l], ln1_b[l])
            f_c = moe(modulate(h_c, sh2c, sc2c).reshape(-1, d), w_router[l], b_router[l],
                      w_gate_up[l], b_gate_up[l], w_down[l], b_down[l]).reshape(h_c.shape)
            h_c = post_norm(h_c, g2c * f_c, ln2_g[l], ln2_b[l])

    return h_x
```

```cpp
#include <hip/hip_runtime.h>
#include <cstdio>
#include <cstdint>

#ifndef PROBE_DUP
#define PROBE_DUP -1
#endif
#ifndef PROBE_CM2
#define PROBE_CM2 0
#endif
#ifndef PROBE_XBAR
#define PROBE_XBAR 0
#endif
#ifndef MK_ONE_LAUNCH
#define MK_ONE_LAUNCH 1
#endif

#define GAS __attribute__((address_space(1)))
#define LAS __attribute__((address_space(3)))
typedef unsigned short bf16;
typedef short bf16x8 __attribute__((ext_vector_type(8)));
typedef float f32x4 __attribute__((ext_vector_type(4)));
typedef unsigned u32x4 __attribute__((ext_vector_type(4)));
typedef unsigned u32x2 __attribute__((ext_vector_type(2)));
#define RLX_AGENT __ATOMIC_RELAXED, __HIP_MEMORY_SCOPE_AGENT
#define LDS_WAIT() asm volatile("s_waitcnt lgkmcnt(0)" ::: "memory")
#define LBAR() do { asm volatile("s_waitcnt lgkmcnt(0)" ::: "memory"); __builtin_amdgcn_s_barrier(); asm volatile("" ::: "memory"); } while (0)

constexpr int D = 2048, NBATCH = 4, SEQ = 4096, T = NBATCH * SEQ, CTX = 256, TC = NBATCH * CTX, MR = T + TC;
constexpr int DIN = 5152, NP = 5120;
constexpr int C_U = 0, C_V = 1024, C_Q = 2048, C_K = 2560, C_VG = 3072, C_GO = 4096;
constexpr int NE = 32, NSLOTMAX = 73728;
constexpr float ALPHA = 1.189207115002721f;
constexpr float LN_EPS = 1e-5f, RMS_EPS = 1e-6f;
constexpr float YSC = 16.0f;
constexpr int NWAVES = 8, NTHREADS = 512;
constexpr int NPHASE = 11;
constexpr int NCVB = 32, CV_GU = 65536, CV_TOT = 98304, CV2 = 20480, CV2X = 3072, CV3 = 0, CV4 = 24576, CV5 = 1536, CV_P0 = CV_GU - CV2 - CV2X - CV3 - CV4 - CV5;

constexpr size_t MiB = 1u << 20;
constexpr size_t WS_CTL = 0, CTL_BYTES = 1 * MiB;
constexpr size_t WS_MOD = 1 * MiB;
constexpr size_t WS_WIN = 4 * MiB;
constexpr size_t WS_WOUT = 26 * MiB;
constexpr size_t WS_WGU = 64 * MiB;
constexpr size_t WS_WDN = 576 * MiB;
constexpr size_t WS_HN = 832 * MiB;
constexpr size_t WS_HM = 900 * MiB;
constexpr size_t WS_P = 968 * MiB;
constexpr size_t WS_LR = 1138 * MiB;
constexpr size_t WS_ACAT = 1142 * MiB;
constexpr size_t WS_OF = 1206 * MiB;
constexpr size_t WS_OB = 1270 * MiB;
constexpr size_t WS_Z = 1334 * MiB;
constexpr size_t WS_H1 = 1462 * MiB;
constexpr size_t WS_HM2 = 1526 * MiB;
constexpr size_t WS_TOPW = 1590 * MiB;
constexpr size_t WS_TOPEP = 1591 * MiB;
constexpr size_t WS_LIST = 1592 * MiB;
constexpr size_t WS_ACT = 1594 * MiB;
constexpr size_t WS_YB = 1882 * MiB;
constexpr size_t WS_HM2LO = 2138 * MiB;
constexpr size_t WS_HM2F8 = 2202 * MiB;
constexpr size_t WS_END = 2234 * MiB;
constexpr int CW_CNT = 1024;
constexpr int CW_MODCNT = 3584;
constexpr int CW_BAR = 4096;

constexpr int LDS_BYTES = 163840;
constexpr int MISC_OFF = 135168 + 320;
constexpr int TBL_OFF = 135168 + 1024;
constexpr int EPT_OFF = 135168 + 2048;
constexpr int EPT_RL = 21, EPT_UNITS9 = 9;

typedef __bf16 bf16v2 __attribute__((ext_vector_type(2)));
typedef float f32v2 __attribute__((ext_vector_type(2)));
__device__ __forceinline__ unsigned pk2(float lo, float hi) { const f32v2 v = {lo, hi}; return __builtin_bit_cast(unsigned, __builtin_convertvector(v, bf16v2)); }
__device__ __forceinline__ unsigned f2bf(float f) { return pk2(f, 0.f) & 0xffffu; }
__device__ __forceinline__ float bf2f(unsigned b) { return __builtin_bit_cast(float, b << 16); }
__device__ __forceinline__ float bflo(unsigned w) { return __builtin_bit_cast(float, w << 16); }
__device__ __forceinline__ float bfhi(unsigned w) { return __builtin_bit_cast(float, w & 0xffff0000u); }
__device__ __forceinline__ float wave_sum(float v) {
#pragma unroll
    for (int o = 1; o < 64; o <<= 1) v += __shfl_xor(v, o);
    return v;
}
__device__ __forceinline__ float wave_max(float v) {
#pragma unroll
    for (int o = 1; o < 64; o <<= 1) v = fmaxf(v, __shfl_xor(v, o));
    return v;
}
__device__ __forceinline__ float gelu_exact(float x) { return 0.5f * x * (1.0f + erff(x * 0.70710678118654752f)); }
__device__ __forceinline__ float siluf(float x) { return x / (1.0f + expf(-x)); }
__device__ __forceinline__ float logsigmoidf(float x) { return fminf(x, 0.f) - log1pf(expf(-fabsf(x))); }

__device__ __forceinline__ unsigned lds_rd_u16(unsigned addr) { unsigned v; asm volatile("ds_read_u16 %0, %1\n\ts_waitcnt lgkmcnt(0)" : "=v"(v) : "v"(addr) : "memory"); return v; }
__device__ __forceinline__ int lds_rd_b32(unsigned addr) { int v; asm volatile("ds_read_b32 %0, %1\n\ts_waitcnt lgkmcnt(0)" : "=v"(v) : "v"(addr) : "memory"); return v; }
__device__ __forceinline__ f32x4 lds_rd_b128(unsigned addr) { f32x4 v; asm volatile("ds_read_b128 %0, %1\n\ts_waitcnt lgkmcnt(0)" : "=v"(v) : "v"(addr) : "memory"); return v; }
#define XB_TMO      128
#define XB_XCNT(j)  (256  + 64 * (j))
#define XB_XSUB(j)  (1280 + 64 * (j))
#define XB_XGEN(j)  (2304 + 64 * (j))
#define XB_TOP      3328
#define XB_TOPGEN   3392
#define XCD_BAR_WORDS 3456
#define XB_SPIN_CAP (1u << 18)
__device__ __forceinline__ unsigned xb_ld(unsigned* p)              { return __hip_atomic_load(p, __ATOMIC_RELAXED, __HIP_MEMORY_SCOPE_AGENT); }
__device__ __forceinline__ unsigned xb_add(unsigned* p, unsigned v) { return __hip_atomic_fetch_add(p, v, __ATOMIC_RELAXED, __HIP_MEMORY_SCOPE_AGENT); }
__device__ __forceinline__ unsigned xb_xcc_id() { return (unsigned)__builtin_amdgcn_s_getreg((3 << 11) | 20) & 0xFu; }
#define XB_SPIN(cond, bar) do { unsigned _sp = 0; while (cond) { __builtin_amdgcn_s_sleep(1); \
    if ((++_sp & 255u) == 0u) { if (xb_ld(&(bar)[XB_TMO])) break; if (_sp > XB_SPIN_CAP) { atomicAdd(&(bar)[XB_TMO], 1u); break; } } } } while (0)
struct XcdBarrier { unsigned* bar; unsigned x; volatile LAS unsigned* st; };
__device__ __forceinline__ XcdBarrier xcd_barrier_post(unsigned* bar, volatile LAS unsigned* st) {
    XcdBarrier b; b.bar = bar; b.x = xb_xcc_id(); b.st = st;
    if (threadIdx.x == 0) (void)xb_add(&bar[XB_XCNT(b.x)], 1u);
    return b;
}
__device__ __forceinline__ void xcd_barrier_complete(unsigned* bar, unsigned x, unsigned& nloc, unsigned& nx) {
    const unsigned G = gridDim.x * gridDim.y * gridDim.z;
    unsigned sum, cnt, mine, sp = 0u;
    for (;;) {
        sum = 0u; cnt = 0u; mine = 0u;
#pragma unroll
        for (unsigned j = 0; j < 16; ++j) { const unsigned c = xb_ld(&bar[XB_XCNT(j)]); sum += c; cnt += (c > 0u) ? 1u : 0u; mine = (j == x) ? c : mine; }
        if (sum == G) break;
        __builtin_amdgcn_s_sleep(1);
        if ((++sp & 255u) == 0u) { if (xb_ld(&bar[XB_TMO])) break; if (sp > XB_SPIN_CAP) { atomicAdd(&bar[XB_TMO], 1u); break; } }
    }
    nloc = mine > 0u ? mine : 1u; nx = cnt > 0u ? cnt : 1u;
}
__device__ __forceinline__ void xcd_barrier(const XcdBarrier& b) {
    asm volatile("s_waitcnt vmcnt(0)" ::: "memory");
    __syncthreads();
    if (threadIdx.x == 0) {
        unsigned* bar = b.bar;
        __builtin_amdgcn_s_waitcnt(0);
        unsigned nloc = b.st[0], nx = b.st[1];
        if (nloc == 0u) { xcd_barrier_complete(bar, b.x, nloc, nx); b.st[0] = nloc; b.st[1] = nx; }
        const unsigned old = xb_add(&bar[XB_XSUB(b.x)], 1u);
        const unsigned gen = old / nloc;
        if (old + 1u == (gen + 1u) * nloc) {
            __builtin_amdgcn_fence(__ATOMIC_RELEASE, "agent");
            asm volatile("s_waitcnt vmcnt(0)" ::: "memory");
            const unsigned og = xb_add(&bar[XB_TOP], 1u);
            const unsigned tg = og / nx;
            if (og + 1u == (tg + 1u) * nx) xb_add(&bar[XB_TOPGEN], 1u);
            else XB_SPIN(xb_ld(&bar[XB_TOPGEN]) == tg, bar);
            __builtin_amdgcn_fence(__ATOMIC_ACQUIRE, "agent");
            xb_add(&bar[XB_XGEN(b.x)], 1u);
            asm volatile("s_waitcnt vmcnt(0)" ::: "memory");
        } else {
            XB_SPIN(xb_ld(&bar[XB_XGEN(b.x)]) == gen, bar);
            __builtin_amdgcn_fence(__ATOMIC_ACQUIRE, "agent");
            asm volatile("s_waitcnt vmcnt(0)" ::: "memory");
        }
    }
    __syncthreads();
}

template <int NB, class AR, class BR, class EP>
__device__ __forceinline__ void wave_gemm32(const AR& arow, const BR& brow, const EP& epi, int K, int lane) {
    const int r = lane & 15, kq = lane >> 4;
    const bf16* a[2]; const bf16* b[NB][2];
#pragma unroll
    for (int m = 0; m < 2; ++m) a[m] = arow(16 * m + r) + 8 * kq;
#pragma unroll
    for (int w = 0; w < NB; ++w)
#pragma unroll
        for (int n = 0; n < 2; ++n) b[w][n] = brow(16 * n + r, w) + 8 * kq;
    f32x4 acc[NB][2][2];
#pragma unroll
    for (int w = 0; w < NB; ++w)
#pragma unroll
        for (int m = 0; m < 2; ++m)
#pragma unroll
            for (int n = 0; n < 2; ++n) acc[w][m][n] = (f32x4){0.f, 0.f, 0.f, 0.f};
#pragma unroll 2
    for (int k = 0; k < K; k += 32) {
        bf16x8 af[2], bfr[NB][2];
#pragma unroll
        for (int m = 0; m < 2; ++m) af[m] = *(const bf16x8*)(a[m] + k);
#pragma unroll
        for (int w = 0; w < NB; ++w)
#pragma unroll
            for (int n = 0; n < 2; ++n) bfr[w][n] = *(const bf16x8*)(b[w][n] + k);
#pragma unroll
        for (int w = 0; w < NB; ++w)
#pragma unroll
            for (int m = 0; m < 2; ++m)
#pragma unroll
                for (int n = 0; n < 2; ++n) acc[w][m][n] = __builtin_amdgcn_mfma_f32_16x16x32_bf16(af[m], bfr[w][n], acc[w][m][n], 0, 0, 0);
    }
#pragma unroll
    for (int m = 0; m < 2; ++m)
#pragma unroll
        for (int n = 0; n < 2; ++n)
#pragma unroll
            for (int q = 0; q < 4; ++q) epi(16 * m + 4 * kq + q, 16 * n + r, acc[0][m][n][q], NB == 2 ? acc[NB - 1][m][n][q] : 0.f);
}

__device__ __forceinline__ void transpose_item(const float* W, int K, int N, bf16* WT, int k0, int n0, int r0, LAS float* scr, int lane) {
#pragma unroll
    for (int i = 0; i < 32; ++i) { const int kk = 2 * i + (lane >> 5); scr[kk * 33 + (lane & 31)] = W[(size_t)(k0 + kk) * N + n0 + (lane & 31)]; }
    LDS_WAIT();
    const int c = lane & 7;
#pragma unroll
    for (int j = 0; j < 4; ++j) { const int n = (lane >> 3) + 8 * j; const LAS float* s = scr + (8 * c) * 33 + n;
        u32x4 o; o.x = pk2(s[0 * 33], s[1 * 33]); o.y = pk2(s[2 * 33], s[3 * 33]); o.z = pk2(s[4 * 33], s[5 * 33]); o.w = pk2(s[6 * 33], s[7 * 33]);
        *(u32x4*)(WT + (size_t)(r0 + n) * K + k0 + 8 * c) = o; }
    LDS_WAIT();
}

namespace pg8 {
typedef unsigned short bf16_t;
constexpr int BM = 256, BK = 64, HALF = 128, HTB = HALF * BK * 2, STAGE_BYTES = 8 * HTB, NXCD = 8;
__device__ __forceinline__ int lds_byte(int r, int c) { const int st = (r >> 4) * 2 + (c >> 5), rr = r & 15, cc = c & 31, ob = rr * 64 + cc * 2; return st * 1024 + (ob ^ (((ob >> 9) & 1) << 5)); }
__device__ __forceinline__ void stage_rc(int b, int& R, int& C) { const int st = b / 1024, sb = b % 1024, swz = sb ^ (((sb >> 9) & 1) << 5); R = (st >> 1) * 16 + swz / 64; C = (st & 1) * 32 + (swz % 64) / 2; }
__device__ __forceinline__ int perm32(int rho) { const int n = rho >> 4, i = rho & 15; return 8 * (i >> 2) + 4 * n + (i & 3); }
struct Unit { int pm, pn, e, mt, nv, ord; };
__device__ __forceinline__ unsigned cvt_pk_bf16(float lo, float hi) { unsigned r; asm volatile("v_cvt_pk_bf16_f32 %0, %1, %2" : "=v"(r) : "v"(lo), "v"(hi)); return r; }
typedef float f32x2 __attribute__((ext_vector_type(2)));
__device__ __forceinline__ f32x2 gelu_pk(f32x2 v) {
    const f32x2 av = __builtin_elementwise_abs(v), d = av * 0.2316418882f + 1.0f;
    f32x2 t; t.x = __builtin_amdgcn_rcpf(d.x); t.y = __builtin_amdgcn_rcpf(d.y);
    f32x2 q = t * 0.5307027145f + (-0.7265760135f); q = q * t + 0.7107068705f; q = q * t + (-0.142248368f); q = q * t + 0.127414796f; q = q * t;
    const f32x2 s = (v * v) * (-0.72134752044f);
    f32x2 e; e.x = __builtin_amdgcn_exp2f(s.x); e.y = __builtin_amdgcn_exp2f(s.y);
    const f32x2 m = v * (q * e), r = v - m;
    f32x2 o; o.x = v.x < 0.f ? m.x : r.x; o.y = v.y < 0.f ? m.y : r.y; return o;
}
typedef int i32x8 __attribute__((ext_vector_type(8)));
typedef int i32x4 __attribute__((ext_vector_type(4)));
template <class Epi, class Sched, int ESZ = 2>
__device__ __forceinline__ void gemm_phase(LAS unsigned char* lds, const void* A, int K, const Sched& S, const Epi& E) {
    const int tid = threadIdx.x, wid = __builtin_amdgcn_readfirstlane(tid >> 6), lane = tid & 63, wr = wid >> 2, wc = wid & 3, fr = lane & 15, fq = lane >> 4;
    const int rowb = K * ESZ, nt = rowb / 128;
    unsigned voffB[2];
#pragma unroll
    for (int i = 0; i < 2; ++i) { int R, C; stage_rc(tid * 16 + i * 8192, R, C); const int Rb = Epi::PERM ? ((R & ~31) + perm32(R & 31)) : R; voffB[i] = (unsigned)(Rb * rowb + C * 2); }
    const size_t kstep = (size_t)128;
    const size_t hstep = (size_t)HALF * rowb;
    const unsigned ldsw = (unsigned)wid * 1024u;
    const int aoff = lds_byte(wr * 64 + fr, fq * 8), boff = lds_byte(wc * 32 + fr, fq * 8);
#define PG8_SA(b, h) (((b) * 2 + (h)) * HTB)
#define PG8_SB(b, h) ((4 + (b) * 2 + (h)) * HTB)
#define PG8_STAGE(bufoff, gbase, voff) do { _Pragma("unroll") for (int _i = 0; _i < 2; ++_i) \
        __builtin_amdgcn_global_load_lds((const unsigned*)((const char*)(gbase) + (voff)[_i]), (LAS unsigned*)(lds + (bufoff) + ldsw + _i * 8192), 16, 0, 0); } while (0)
#define PG8_LDA(dst, b, h) do { _Pragma("unroll") for (int m = 0; m < 4; ++m) _Pragma("unroll") for (int k = 0; k < 2; ++k) dst[m][k] = *(const LAS bf16x8*)(lds + PG8_SA(b, h) + aoff + m * 2048 + k * 1024); } while (0)
#define PG8_LDB(dst, b, h) do { _Pragma("unroll") for (int n = 0; n < 2; ++n) _Pragma("unroll") for (int k = 0; k < 2; ++k) dst[n][k] = *(const LAS bf16x8*)(lds + PG8_SB(b, h) + boff + n * 2048 + k * 1024); } while (0)
#define PG8_CAT(x) __builtin_shufflevector(__builtin_bit_cast(i32x4, x[0]), __builtin_bit_cast(i32x4, x[1]), 0, 1, 2, 3, 4, 5, 6, 7)
#define PG8_MMA(ai, bj, At, Bt) do { __builtin_amdgcn_s_setprio(1); if constexpr (ESZ == 2) { _Pragma("unroll") for (int m = 0; m < 4; ++m) _Pragma("unroll") for (int n = 0; n < 2; ++n) _Pragma("unroll") for (int k = 0; k < 2; ++k) \
        acc[ai][bj][m][n] = __builtin_amdgcn_mfma_f32_16x16x32_bf16(Bt[n][k], At[m][k], acc[ai][bj][m][n], 0, 0, 0); } else { _Pragma("unroll") for (int m = 0; m < 4; ++m) _Pragma("unroll") for (int n = 0; n < 2; ++n) \
        acc[ai][bj][m][n] = __builtin_amdgcn_mfma_scale_f32_16x16x128_f8f6f4(PG8_CAT(Bt[n]), PG8_CAT(At[m]), acc[ai][bj][m][n], 0, 0, 0, 0x77777777, 0, 0x7f7f7f7f); } __builtin_amdgcn_s_setprio(0); } while (0)
#define PG8_WAIT_V(n) asm volatile("s_waitcnt vmcnt(" #n ")" ::: "memory")
#define PG8_WAIT_L(n) asm volatile("s_waitcnt lgkmcnt(" #n ")" ::: "memory")
#define PG8_BAR __builtin_amdgcn_s_barrier()
#define PG8_SCHED __builtin_amdgcn_sched_barrier(0)
#define PG8_ROWS(dst, u) do { int _t = threadIdx.x; asm volatile("" : "+v"(_t)); _Pragma("unroll") for (int _i = 0; _i < 2; ++_i) { int _R, _C; stage_rc(_t * 16 + _i * 8192, _R, _C); \
        _Pragma("unroll") for (int _h = 0; _h < 2; ++_h) dst[_h][_i] = (unsigned)(S.a_row(u, _h * HALF + _R) * rowb + _C * 2); } } while (0)
    Unit cur, nxt; int ui = 0;
    if (!S.next(0, cur)) return;
    f32x4 acc[2][2][4][2];
#pragma unroll
    for (int a = 0; a < 2; ++a)
#pragma unroll
        for (int b = 0; b < 2; ++b)
#pragma unroll
            for (int m = 0; m < 4; ++m)
#pragma unroll
                for (int n = 0; n < 2; ++n) acc[a][b][m][n] = (f32x4){0.f, 0.f, 0.f, 0.f};
    bf16x8 At[4][2], B0[2][2], B1[2][2];
    unsigned va[2][2], vn[2][2];
    PG8_ROWS(va, cur);
    const char* cA = (const char*)A; const char* cB = S.b_base(cur);
    PG8_WAIT_V(0);
    PG8_STAGE(PG8_SB(0, 0), cB, voffB); PG8_STAGE(PG8_SB(0, 1), cB + hstep, voffB); PG8_STAGE(PG8_SA(0, 0), cA, va[0]); PG8_STAGE(PG8_SA(0, 1), cA, va[1]);
    if (wr == 1) PG8_BAR;
    PG8_WAIT_V(2); PG8_BAR;
    PG8_STAGE(PG8_SB(1, 0), cB + kstep, voffB); PG8_STAGE(PG8_SA(1, 0), cA + kstep, va[0]); PG8_STAGE(PG8_SB(1, 1), cB + hstep + kstep, voffB);
    PG8_WAIT_V(6); PG8_BAR;
    for (;;) {
        const bool has_next = S.next(ui + 1, nxt);
        if (has_next) { PG8_ROWS(vn, nxt); }
        else {
#pragma unroll
            for (int h = 0; h < 2; ++h)
#pragma unroll
                for (int i = 0; i < 2; ++i) vn[h][i] = va[h][i]; }
        const char* nB = has_next ? S.b_base(nxt) : cB;
        for (int t = 0; t < nt; t += 2) {
            const bool last = (t == nt - 2);
            const char* a1 = cA + (size_t)(t + 1) * kstep;
            const char* a2 = last ? cA : cA + (size_t)(t + 2) * kstep; const char* b2 = last ? nB : cB + (size_t)(t + 2) * kstep;
            const char* a3 = a2 + kstep; const char* b3 = b2 + kstep;
            PG8_LDB(B0, 0, 0); PG8_LDB(B1, 0, 1); PG8_SCHED; PG8_LDA(At, 0, 0); PG8_STAGE(PG8_SA(1, 1), a1, va[1]);
            if (last) {
#pragma unroll
                for (int h = 0; h < 2; ++h)
#pragma unroll
                    for (int i = 0; i < 2; ++i) va[h][i] = vn[h][i]; }
            PG8_WAIT_V(8); PG8_WAIT_L(0); PG8_BAR; PG8_MMA(0, 0, At, B0); PG8_MMA(0, 1, At, B1); PG8_BAR; PG8_SCHED;
            PG8_LDA(At, 0, 1); PG8_STAGE(PG8_SB(0, 0), b2, voffB); PG8_STAGE(PG8_SB(0, 1), b2 + hstep, voffB); PG8_STAGE(PG8_SA(0, 0), a2, va[0]);
            PG8_WAIT_V(8); PG8_WAIT_L(0); PG8_BAR; PG8_MMA(1, 0, At, B0); PG8_MMA(1, 1, At, B1); PG8_BAR; PG8_SCHED;
            PG8_LDB(B0, 1, 0); PG8_LDB(B1, 1, 1); PG8_SCHED; PG8_LDA(At, 1, 0); PG8_STAGE(PG8_SA(0, 1), a2, va[1]);
            PG8_WAIT_V(8); PG8_WAIT_L(0); PG8_BAR; PG8_MMA(0, 0, At, B0); PG8_MMA(0, 1, At, B1); PG8_BAR; PG8_SCHED;
            PG8_LDA(At, 1, 1); PG8_STAGE(PG8_SB(1, 0), b3, voffB); PG8_STAGE(PG8_SB(1, 1), b3 + hstep, voffB); PG8_STAGE(PG8_SA(1, 0), a3, va[0]);
            PG8_WAIT_V(8); PG8_WAIT_L(0); PG8_BAR; PG8_MMA(1, 0, At, B0); PG8_MMA(1, 1, At, B1); PG8_BAR; PG8_SCHED;
        }
        if (wr == 0) PG8_BAR;
        E(acc, cur, wr, wc, fr, fq, ui);
        if (!has_next) break;
#pragma unroll
        for (int a = 0; a < 2; ++a)
#pragma unroll
            for (int b = 0; b < 2; ++b)
#pragma unroll
                for (int m = 0; m < 4; ++m)
#pragma unroll
                    for (int n = 0; n < 2; ++n) acc[a][b][m][n] = (f32x4){0.f, 0.f, 0.f, 0.f};
        cur = nxt; cB = nB; ++ui;
        if (wr == 1) PG8_BAR;
    }
    PG8_WAIT_V(0);
    PG8_BAR;
#undef PG8_SA
#undef PG8_SB
#undef PG8_STAGE
#undef PG8_LDA
#undef PG8_LDB
#undef PG8_MMA
#undef PG8_CAT
#undef PG8_WAIT_V
#undef PG8_WAIT_L
#undef PG8_BAR
#undef PG8_SCHED
#undef PG8_ROWS
}

struct DenseOrder {
    int nM, nN, nwg, G, c; const bf16_t* Bt; int K;
    __device__ __forceinline__ void init(int M, int N, int G_, int c_, const bf16_t* Bt_, int K_) { nM = M / BM; nN = N / BM; nwg = nM * nN; G = G_; c = c_; Bt = Bt_; K = K_; }
    __device__ __forceinline__ bool next(int i, Unit& u) const {
        const long L = (long)i * G + c; if (L >= nwg) return false;
        int wgid = (int)L; { const int q = nwg / NXCD, r = nwg % NXCD, xcd = wgid % NXCD, off = wgid / NXCD; wgid = (xcd < r ? xcd * (q + 1) : r * (q + 1) + (xcd - r) * q) + off; }
        const int nig = 8 * nN, gid = wgid / nig, fm = gid * 8, gsz = (nM - fm) < 8 ? (nM - fm) : 8;
        u.pm = fm + ((wgid % nig) % gsz); u.pn = (wgid % nig) / gsz; u.e = 0; u.mt = u.pm; u.nv = 256; u.ord = 0; return true;
    }
    __device__ __forceinline__ const char* b_base(const Unit& u) const { return (const char*)Bt + (size_t)u.pn * 256 * K * 2; }
    __device__ __forceinline__ int a_row(const Unit& u, int r) const { return u.pm * 256 + r; }
};
}

struct EpiInProj {
    static constexpr bool PERM = true;
    bf16* P;
    __device__ __forceinline__ void operator()(const f32x4 (&acc)[2][2][4][2], const pg8::Unit& u, int wr, int wc, int fr, int fq, int ui) const {
        asm volatile("" : "+v"(fr), "+v"(fq));
        const int row0 = u.pm * 256 + wr * 64 + fr, col0 = u.pn * 256 + wc * 32 + 8 * fq; const bool act = u.pn < 8;
#pragma unroll
        for (int ai = 0; ai < 2; ++ai)
#pragma unroll
            for (int m = 0; m < 4; ++m) { bf16* rowp = P + (size_t)(row0 + ai * 128 + m * 16) * NP + col0;
#pragma unroll
                for (int bj = 0; bj < 2; ++bj) { f32x4 v0 = acc[ai][bj][m][0], v1 = acc[ai][bj][m][1];
                    if (act) { pg8::f32x2 a = pg8::gelu_pk((pg8::f32x2){v0[0], v0[1]}), b = pg8::gelu_pk((pg8::f32x2){v0[2], v0[3]}), c = pg8::gelu_pk((pg8::f32x2){v1[0], v1[1]}), d = pg8::gelu_pk((pg8::f32x2){v1[2], v1[3]});
                        v0 = (f32x4){a.x, a.y, b.x, b.y}; v1 = (f32x4){c.x, c.y, d.x, d.y}; }
                    u32x4 w; w.x = pg8::cvt_pk_bf16(v0[0], v0[1]); w.y = pg8::cvt_pk_bf16(v0[2], v0[3]); w.z = pg8::cvt_pk_bf16(v1[0], v1[1]); w.w = pg8::cvt_pk_bf16(v1[2], v1[3]);
                    *(u32x4*)(rowp + bj * 128) = w; } }
    }
};
struct EpiOutProj {
    static constexpr bool PERM = true;
    bf16* Z; const bf16* HN; const float* MOD;
    __device__ __forceinline__ void operator()(const f32x4 (&acc)[2][2][4][2], const pg8::Unit& u, int wr, int wc, int fr, int fq, int ui) const {
        asm volatile("" : "+v"(fr), "+v"(fq));
        const int row0 = u.pm * 256 + wr * 64 + fr, col0 = u.pn * 256 + wc * 32 + 8 * fq;
        const float* g1 = MOD + ((u.pm * 256) / SEQ) * (6 * D) + 2 * D;
        f32x4 gv[2][2];
#pragma unroll
        for (int bj = 0; bj < 2; ++bj)
#pragma unroll
            for (int n = 0; n < 2; ++n) gv[bj][n] = *(const f32x4*)(g1 + col0 + bj * 128 + 4 * n);
#pragma unroll
        for (int ai = 0; ai < 2; ++ai)
#pragma unroll
            for (int m = 0; m < 4; ++m) { const size_t ro = (size_t)(row0 + ai * 128 + m * 16) * D + col0;
#pragma unroll
                for (int bj = 0; bj < 2; ++bj) { const u32x4 h = *(const u32x4*)(HN + ro + bj * 128); const f32x4 a0 = acc[ai][bj][m][0], a1 = acc[ai][bj][m][1], g0 = gv[bj][0], g1v = gv[bj][1];
                    u32x4 o; o.x = pk2(ALPHA * bflo(h.x) + g0.x * a0.x, ALPHA * bfhi(h.x) + g0.y * a0.y); o.y = pk2(ALPHA * bflo(h.y) + g0.z * a0.z, ALPHA * bfhi(h.y) + g0.w * a0.w);
                    o.z = pk2(ALPHA * bflo(h.z) + g1v.x * a1.x, ALPHA * bfhi(h.z) + g1v.y * a1.y); o.w = pk2(ALPHA * bflo(h.w) + g1v.z * a1.z, ALPHA * bfhi(h.w) + g1v.w * a1.w);
                    *(u32x4*)(Z + ro + bj * 128) = o; } }
    }
};
struct EpiGateUp {
    static constexpr bool PERM = true;
    unsigned char* ACT; const LAS bf16* BT;
    __device__ __forceinline__ void operator()(const f32x4 (&acc)[2][2][4][2], const pg8::Unit& u, int wr, int wc, int fr, int fq, int ui) const {
        asm volatile("" : "+v"(fr), "+v"(fq));
        const int j0 = u.pn * 128 + wc * 32 + 8 * fq;
        const unsigned bt = (unsigned)(size_t)BT + (unsigned)(ui * 256 + wc * 32 + 8 * fq) * 2u;
        const f32x4 rg = lds_rd_b128(bt), ru = lds_rd_b128(bt + 256);
        const u32x4 rgu = __builtin_bit_cast(u32x4, rg), ruu = __builtin_bit_cast(u32x4, ru);
        const f32x4 bg0 = {bflo(rgu.x), bfhi(rgu.x), bflo(rgu.y), bfhi(rgu.y)}, bg1 = {bflo(rgu.z), bfhi(rgu.z), bflo(rgu.w), bfhi(rgu.w)};
        const f32x4 bu0 = {bflo(ruu.x), bfhi(ruu.x), bflo(ruu.y), bfhi(ruu.y)}, bu1 = {bflo(ruu.z), bfhi(ruu.z), bflo(ruu.w), bfhi(ruu.w)};
#pragma unroll
        for (int ai = 0; ai < 2; ++ai)
#pragma unroll
            for (int m = 0; m < 4; ++m) { const int i = ai * 128 + wr * 64 + m * 16 + fr;
                f32x4 g0 = acc[ai][0][m][0] + bg0, g1 = acc[ai][0][m][1] + bg1, u0 = acc[ai][1][m][0] + bu0, u1 = acc[ai][1][m][1] + bu1; float r[8];
#pragma unroll
                for (int q = 0; q < 4; ++q) { float g = fminf(g0[q], 7.f), up = fminf(fmaxf(u0[q], -7.f), 7.f); r[q] = (up + 1.f) * g * __builtin_amdgcn_rcpf(1.f + __builtin_amdgcn_exp2f(-2.4554669595930156f * g));
                    g = fminf(g1[q], 7.f); up = fminf(fmaxf(u1[q], -7.f), 7.f); r[4 + q] = (up + 1.f) * g * __builtin_amdgcn_rcpf(1.f + __builtin_amdgcn_exp2f(-2.4554669595930156f * g)); }
                int w0 = __builtin_amdgcn_cvt_pk_fp8_f32(r[0], r[1], 0, false); w0 = __builtin_amdgcn_cvt_pk_fp8_f32(r[2], r[3], w0, true);
                int w1 = __builtin_amdgcn_cvt_pk_fp8_f32(r[4], r[5], 0, false); w1 = __builtin_amdgcn_cvt_pk_fp8_f32(r[6], r[7], w1, true);
                u32x2 w; w.x = (unsigned)w0; w.y = (unsigned)w1;
                if (i < u.nv) *(u32x2*)(ACT + ((size_t)u.pm * 256 + i) * D + j0) = w; }
    }
};
struct EpiDown {
    static constexpr bool PERM = true;
    unsigned char* YB; const LAS float* BT; const LAS int* LT;
    __device__ __forceinline__ void operator()(const f32x4 (&acc)[2][2][4][2], const pg8::Unit& u, int wr, int wc, int fr, int fq, int ui) const {
        asm volatile("" : "+v"(fr), "+v"(fq));
        const int col0 = u.pn * 256 + wc * 32 + 8 * fq;
        f32x4 bv[2][2];
#pragma unroll
        for (int bj = 0; bj < 2; ++bj)
#pragma unroll
            for (int n = 0; n < 2; ++n) bv[bj][n] = lds_rd_b128((unsigned)(size_t)BT + (unsigned)(ui * 256 + wc * 32 + 8 * fq + bj * 128 + 4 * n) * 4u);
#pragma unroll
        for (int ai = 0; ai < 2; ++ai)
#pragma unroll
            for (int m = 0; m < 4; ++m) { const int i = ai * 128 + wr * 64 + m * 16 + fr;
                if (i < u.nv) { const int flat = lds_rd_b32((unsigned)(size_t)LT + (unsigned)(ui * 256 + i) * 4u); unsigned char* rowp = YB + (size_t)flat * D + col0;
#pragma unroll
                    for (int bj = 0; bj < 2; ++bj) { const f32x4 v0 = (acc[ai][bj][m][0] + bv[bj][0]) * YSC, v1 = (acc[ai][bj][m][1] + bv[bj][1]) * YSC;
                        int w0 = __builtin_amdgcn_cvt_pk_fp8_f32(v0[0], v0[1], 0, false); w0 = __builtin_amdgcn_cvt_pk_fp8_f32(v0[2], v0[3], w0, true);
                        int w1 = __builtin_amdgcn_cvt_pk_fp8_f32(v1[0], v1[1], 0, false); w1 = __builtin_amdgcn_cvt_pk_fp8_f32(v1[2], v1[3], w1, true);
                        u32x2 w; w.x = (unsigned)w0; w.y = (unsigned)w1;
                        *(u32x2*)(rowp + bj * 128) = w; } } }
    }
};
struct InProjOrder {
    int G, c; const bf16* Bt;
    __device__ __forceinline__ bool next(int i, pg8::Unit& u) const {
        const int L = i * G + c; if (L >= 1304) return false;
        if (L < 1280) { int wgid = L; { const int q = 1280 / 8, xcd = wgid % 8, off = wgid / 8; wgid = xcd * q + off; }
            const int nig = 8 * 20, gid = wgid / nig, fm = gid * 8; u.pm = fm + ((wgid % nig) % 8); u.pn = (wgid % nig) / 8; }
        else { const int j = L - 1280; u.pm = 64 + j / 6; u.pn = 10 + j % 6; }
        u.e = 0; u.mt = u.pm; u.nv = 256; u.ord = 0; return true;
    }
    __device__ __forceinline__ const char* b_base(const pg8::Unit& u) const { return (const char*)Bt + (size_t)u.pn * 256 * D * 2; }
    __device__ __forceinline__ int a_row(const pg8::Unit& u, int r) const { return u.pm * 256 + r; }
};
template <bool GATHER> struct MoeOrder {
    const LAS int* tb; const LAS int* cn; int NT, G, c; const void* Bt; size_t estride; const int* LIST; int rowb;
    const LAS int* UT;
    const LAS unsigned short* RL;
    __device__ __forceinline__ bool search(int i, pg8::Unit& u) const {
        const int nwg = tb[NE] * NT; const long L = (long)i * G + c; if (L >= nwg) return false;
        int v = (int)L; { const int q = nwg / 8, r = nwg % 8, xcd = v % 8, off = v / 8; v = (xcd < r ? xcd * (q + 1) : r * (q + 1) + (xcd - r) * q) + off; }
        int e = 0; while (v >= tb[e + 1] * NT) ++e;
        const int local = v - tb[e] * NT, mte = tb[e + 1] - tb[e];
        u.e = e; u.mt = local % mte; u.pn = local / mte; u.pm = tb[e] + u.mt; const int rem = cn[e] - u.mt * 256; u.nv = rem < 256 ? rem : 256; return true;
    }
    __device__ __forceinline__ void build(LAS int* ut, int tid) const {
        if (tid < 32) { pg8::Unit u; const bool ok = search(tid, u); ut[4 * tid] = ok ? u.e : -1; ut[4 * tid + 1] = u.mt; ut[4 * tid + 2] = u.pn; ut[4 * tid + 3] = u.nv; }
    }
    int utv;
    int utp;
    __device__ __forceinline__ void pack(int lane) { const int l = lane & 31; const int e = UT[4 * l]; utv = e < 0 ? -1 : (e | (UT[4 * l + 2] << 5) | (UT[4 * l + 1] << 9) | (UT[4 * l + 3] << 16)); utp = e < 0 ? 0 : tb[e] + UT[4 * l + 1]; }
    __device__ __forceinline__ bool next(int i, pg8::Unit& u) const {
        if (i >= 32) return false;
        const int w = __builtin_amdgcn_readlane(utv, i); if (w < 0) return false;
        u.e = w & 31; u.pn = (w >> 5) & 15; u.mt = (w >> 9) & 127; u.nv = (w >> 16) & 511; u.pm = __builtin_amdgcn_readlane(utp, i); u.ord = i; return true;
    }
    __device__ __forceinline__ const char* b_base(const pg8::Unit& u) const { return (const char*)Bt + (size_t)u.e * estride + (size_t)u.pn * 256 * rowb; }
    __device__ __forceinline__ int a_row(const pg8::Unit& u, int r) const {
        if constexpr (GATHER) return (int)lds_rd_u16((unsigned)(size_t)RL + (unsigned)(u.ord * 256 + (r < u.nv ? r : 0)) * 2u);
        else return u.pm * 256 + r;
    }
};

__device__ __forceinline__ void item8_load(const float* W, int N, int k0, int n0, int lane, f32x4 (&rg)[16]) {
#pragma unroll
    for (int i = 0; i < 16; ++i) rg[i] = __builtin_nontemporal_load((const f32x4*)(W + (size_t)(k0 + 8 * i + (lane >> 3)) * N + n0 + 4 * (lane & 7)));
}
__device__ __forceinline__ void item8_finish(int K, unsigned char* WT, int k0, int r0, LAS float* scr, int lane, const f32x4 (&rg)[16]) {
#pragma unroll
    for (int i = 0; i < 16; ++i) { LAS float* d = scr + (8 * i + (lane >> 3)) * 33 + 4 * (lane & 7); d[0] = rg[i].x; d[1] = rg[i].y; d[2] = rg[i].z; d[3] = rg[i].w; }
    LDS_WAIT();
    const int c = lane & 7;
#pragma unroll
    for (int j = 0; j < 4; ++j) { const int n = (lane >> 3) + 8 * j; const LAS float* sp = scr + (16 * c) * 33 + n; int w[4];
#pragma unroll
        for (int q = 0; q < 4; ++q) { w[q] = __builtin_amdgcn_cvt_pk_fp8_f32(sp[(4 * q) * 33] * 256.f, sp[(4 * q + 1) * 33] * 256.f, 0, false); w[q] = __builtin_amdgcn_cvt_pk_fp8_f32(sp[(4 * q + 2) * 33] * 256.f, sp[(4 * q + 3) * 33] * 256.f, w[q], true); }
        u32x4 o; o.x = (unsigned)w[0]; o.y = (unsigned)w[1]; o.z = (unsigned)w[2]; o.w = (unsigned)w[3];
        *(u32x4*)(WT + (size_t)(r0 + n) * K + k0 + 16 * c) = o; }
    LDS_WAIT();
}

struct Args { const float* in[29]; float* out; unsigned char* ws; int ph_lo, ph_hi; };

__global__ void __launch_bounds__(NTHREADS, 2) fwd(Args args) {
    extern __shared__ __attribute__((aligned(16))) unsigned char lds_raw[];
    LAS unsigned char* lds = (LAS unsigned char*)lds_raw;
    volatile LAS unsigned* MISC = (volatile LAS unsigned*)(lds + MISC_OFF);
    const int tid = threadIdx.x, lane = tid & 63, wave = __builtin_amdgcn_readfirstlane(tid >> 6);
    const int G = gridDim.x, bid = blockIdx.x;
    const int gw = bid * NWAVES + wave, NGW = G * NWAVES;
    unsigned char* ws = args.ws;
    unsigned* ctl = (unsigned*)(ws + WS_CTL);
    const float* x = args.in[0]; const float* cvec = args.in[1]; const float* ctx = args.in[2]; const float* c_ctx = args.in[3];
    const float* ln_in_g = args.in[4]; const float* ln_in_b = args.in[5]; const float* w_ada = args.in[6]; const float* b_ada = args.in[7];
    const float* w_in = args.in[8]; const float* cm_norm_g = args.in[9]; const float* cm_norm_b = args.in[10]; const float* cm_w_s = args.in[11];
    const float* cm_b_s = args.in[12]; const float* wgk_f = args.in[13]; const float* bgk_f = args.in[14]; const float* wgk_b = args.in[15];
    const float* bgk_b = args.in[16]; const float* gla_norm_g = args.in[17]; const float* w_out = args.in[18]; const float* ln1_g = args.in[19];
    const float* ln1_b = args.in[20]; const float* w_router = args.in[21]; const float* b_router = args.in[22]; const float* w_gu = args.in[23];
    const float* b_gu = args.in[24]; const float* w_dn = args.in[25]; const float* b_dn = args.in[26]; const float* ln2_g = args.in[27]; const float* ln2_b = args.in[28];
    float* out = args.out;
    float* MOD = (float*)(ws + WS_MOD);
    bf16* WinT = (bf16*)(ws + WS_WIN); bf16* WoutT = (bf16*)(ws + WS_WOUT); unsigned char* WguT = (unsigned char*)(ws + WS_WGU); unsigned char* WdnT = (unsigned char*)(ws + WS_WDN);
    bf16* HN = (bf16*)(ws + WS_HN); bf16* HM = (bf16*)(ws + WS_HM); bf16* P = (bf16*)(ws + WS_P); float* LR = (float*)(ws + WS_LR);
    bf16* ACAT = (bf16*)(ws + WS_ACAT); float* OF = (float*)(ws + WS_OF); float* OB = (float*)(ws + WS_OB); bf16* Z = (bf16*)(ws + WS_Z);
    bf16* H1 = (bf16*)(ws + WS_H1); bf16* HM2 = (bf16*)(ws + WS_HM2); float* TOPW = (float*)(ws + WS_TOPW); unsigned* TOPEP = (unsigned*)(ws + WS_TOPEP);
    int* LIST = (int*)(ws + WS_LIST); unsigned char* ACT = (unsigned char*)(ws + WS_ACT); unsigned char* YB = ws + WS_YB;
    unsigned* CNT = ctl + CW_CNT;
    unsigned char* HM2F8 = ws + WS_HM2F8;
    bf16* HM2LO = (bf16*)(ws + WS_HM2LO); bf16* WRH = (bf16*)(ws + WS_MOD + 512 * 1024); bf16* WRL = (bf16*)(ws + WS_MOD + 640 * 1024);
    bf16* QEF = (bf16*)(ws + WS_ACT); bf16* QEB = (bf16*)(ws + WS_ACT + 18 * MiB); bf16* KDF = (bf16*)(ws + WS_ACT + 36 * MiB); bf16* KDB = (bf16*)(ws + WS_ACT + 54 * MiB);
    bf16* VTg = (bf16*)(ws + WS_ACT + 72 * MiB); float* DECF = (float*)(ws + WS_ACT + 108 * MiB); float* DECB = (float*)(ws + WS_ACT + 109 * MiB); float* OI = (float*)(ws + WS_ACT + 110 * MiB);

    for (int u = tid; u < (LDS_BYTES - 131072) / 4; u += NTHREADS) ((LAS unsigned*)(lds + 131072))[u] = 0u;
    LBAR();
    XcdBarrier bar; bar.bar = ctl + CW_BAR; bar.x = 0; bar.st = nullptr;
    if (MK_ONE_LAUNCH) bar = xcd_barrier_post(ctl + CW_BAR, MISC + 8);
    const int lo = args.ph_lo, hi = args.ph_hi;
#define IN(k) (lo <= (k) && (k) < hi)
#define SEAM(k) do { if (IN(k) && IN((k) + 1)) xcd_barrier(bar); } while (0)
#define MOE_LOAD(r_, RG) do { int rr_ = (r_); \
        if (rr_ < 65536) { const int e_ = rr_ / 2048, q_ = rr_ % 2048; item8_load(w_gu + (size_t)e_ * 2048 * 4096, 4096, 128 * (q_ / 128), 32 * (q_ % 128), lane, RG); } \
        else { rr_ -= 65536; const int e_ = rr_ / 1024, q_ = rr_ % 1024; item8_load(w_dn + (size_t)e_ * 2048 * 2048, D, 128 * (q_ / 64), 32 * (q_ % 64), lane, RG); } } while (0)
#define MOE_FIN(r_, RG) do { LAS float* scr_ = (LAS float*)(lds + wave * 16896); int rr_ = (r_); \
        if (rr_ < 65536) { const int e_ = rr_ / 2048, q_ = rr_ % 2048, n0_ = 32 * (q_ % 128), half_ = n0_ / 2048, j0_ = n0_ % 2048; \
            item8_finish(D, WguT + (size_t)e_ * 4096 * 2048, 128 * (q_ / 128), 256 * (j0_ / 128) + 128 * half_ + (j0_ % 128), scr_, lane, RG); } \
        else { rr_ -= 65536; const int e_ = rr_ / 1024, q_ = rr_ % 1024; item8_finish(D, WdnT + (size_t)e_ * 2048 * 2048, 128 * (q_ / 64), 32 * (q_ % 64), scr_, lane, RG); } } while (0)
#define MOE_RANGE(first_, end_, stride_) do { f32x4 rgA_[16], rgB_[16]; int ia_ = (first_); if (ia_ < (end_)) MOE_LOAD(ia_, rgA_); \
        while (ia_ < (end_)) { const int ib_ = ia_ + (stride_); if (ib_ < (end_)) MOE_LOAD(ib_, rgB_); MOE_FIN(ia_, rgA_); if (ib_ >= (end_)) break; \
            ia_ = ib_ + (stride_); if (ia_ < (end_)) MOE_LOAD(ia_, rgA_); MOE_FIN(ib_, rgB_); } } while (0)
    const int Gc = G - NCVB; const bool is_conv = bid >= Gc;
    const int NGWc = Gc * NWAVES;
#define CONV_SLICE(first_, count_) MOE_RANGE((first_) + (bid - Gc) * NWAVES + wave, (first_) + (count_), NCVB * NWAVES)

    if (IN(0)) {
        {
            LAS float* sc = (LAS float*)lds;
            LAS float* red = (LAS float*)(lds + 40960);
            if (bid < 192) {
                for (int i = tid; i < 5 * D; i += NTHREADS) { const int r = i / D, k = i % D; const float v = r < 4 ? cvec[r * D + k] : c_ctx[k]; sc[i] = siluf(v); }
                LBAR();
            }
            for (int u = bid; u < 192; u += G) {
                const int cg = tid & 15, kg = tid >> 4, n0 = u * 64 + cg * 4;
                float acc[5][4];
#pragma unroll
                for (int r = 0; r < 5; ++r)
#pragma unroll
                    for (int j = 0; j < 4; ++j) acc[r][j] = 0.f;
#pragma unroll 16
                for (int kk = 0; kk < 64; ++kk) { const int k = kg * 64 + kk; const f32x4 w = *(const f32x4*)(w_ada + (size_t)k * (6 * D) + n0);
#pragma unroll
                    for (int r = 0; r < 5; ++r) { const float s = sc[r * D + k]; acc[r][0] += s * w.x; acc[r][1] += s * w.y; acc[r][2] += s * w.z; acc[r][3] += s * w.w; } }
#pragma unroll
                for (int r = 0; r < 5; ++r)
#pragma unroll
                    for (int j = 0; j < 4; ++j) red[(kg * 5 + r) * 64 + cg * 4 + j] = acc[r][j];
                LBAR();
                if (tid < 320) { const int r = tid / 64, cidx = tid % 64; float s = 0.f;
                    for (int g2 = 0; g2 < 32; ++g2) s += red[(g2 * 5 + r) * 64 + cidx];
                    MOD[r * (6 * D) + u * 64 + cidx] = s + b_ada[u * 64 + cidx]; }
                LBAR();
            }
            LBAR();
            asm volatile("s_waitcnt vmcnt(0)" ::: "memory"); __syncthreads();
            if (tid == 0 && bid < 192) { __builtin_amdgcn_fence(__ATOMIC_RELEASE, "agent"); asm volatile("s_waitcnt vmcnt(0)" ::: "memory"); __hip_atomic_fetch_add(ctl + CW_MODCNT, 1u, RLX_AGENT); }
        }
        {
            LAS float* scr = (LAS float*)(lds + wave * 16896);
            constexpr int I_IN = 32 * 161, I_OUT = 32 * 64;
            for (int it = gw; it < I_IN + I_OUT; it += NGW) {
                int r = it;
                if (r < I_IN) { const int kb = r / 161, nb = r % 161; transpose_item(w_in, D, DIN, WinT, 64 * kb, 32 * nb, 32 * nb, scr, lane); continue; } r -= I_IN;
                { const int kb = r / 64, nb = r % 64; transpose_item(w_out, D, D, WoutT, 64 * kb, 32 * nb, 32 * nb, scr, lane); }
            }
            MOE_RANGE(gw, CV_P0, NGW);
        }
        for (int i = gw * 64 + lane; i < D * NE; i += NGW * 64) { const int k = i >> 5, e = i & 31; const float w = w_router[i]; const unsigned hi = f2bf(w); WRH[(size_t)e * D + k] = (bf16)hi; WRL[(size_t)e * D + k] = (bf16)f2bf(w - bf2f(hi)); }
        if (tid == 0) { const unsigned want = G < 192 ? (unsigned)G : 192u; unsigned sp = 0;
            while (__hip_atomic_load(ctl + CW_MODCNT, RLX_AGENT) < want) { __builtin_amdgcn_s_sleep(2); if (++sp > (1u << 22)) break; }
            __builtin_amdgcn_fence(__ATOMIC_ACQUIRE, "agent"); asm volatile("s_waitcnt vmcnt(0)" ::: "memory"); }
        __syncthreads();
        for (int m0 = gw; m0 < MR; m0 += 2 * NGW) {
            f32x4 vv[2][8];
#pragma unroll
            for (int t2 = 0; t2 < 2; ++t2) { const int m = (m0 + t2 * NGW) < MR ? m0 + t2 * NGW : m0; const float* xr = m < T ? x + (size_t)m * D : ctx + (size_t)(m - T) * D;
#pragma unroll
                for (int j = 0; j < 8; ++j) vv[t2][j] = *(const f32x4*)(xr + 4 * (lane + 64 * j)); }
#pragma unroll
            for (int t2 = 0; t2 < 2; ++t2) { const int m = m0 + t2 * NGW; if (m >= MR) break;
                const float* shp = MOD + (m < T ? m / SEQ : 4) * (6 * D); const float* scp = shp + D;
                f32x4 v[8]; float s = 0.f;
#pragma unroll
                for (int j = 0; j < 8; ++j) { v[j] = vv[t2][j]; s += (v[j].x + v[j].y) + (v[j].z + v[j].w); }
                const float mean = wave_sum(s) * (1.f / D); float s2 = 0.f;
#pragma unroll
                for (int j = 0; j < 8; ++j) { v[j] = v[j] - mean; s2 += (v[j].x * v[j].x + v[j].y * v[j].y) + (v[j].z * v[j].z + v[j].w * v[j].w); }
                const float rstd = 1.f / sqrtf(wave_sum(s2) * (1.f / D) + LN_EPS);
#pragma unroll
                for (int j = 0; j < 8; ++j) { const int c = 4 * (lane + 64 * j); const f32x4 g = *(const f32x4*)(ln_in_g + c), bb = *(const f32x4*)(ln_in_b + c);
                    f32x4 hh; hh.x = v[j].x * rstd * g.x + bb.x; hh.y = v[j].y * rstd * g.y + bb.y; hh.z = v[j].z * rstd * g.z + bb.z; hh.w = v[j].w * rstd * g.w + bb.w;
                    u32x2 o; o.x = pk2(hh.x, hh.y); o.y = pk2(hh.z, hh.w);
                    *(u32x2*)(HN + (size_t)m * D + c) = o;
                    const f32x4 s4 = *(const f32x4*)(shp + c), c4 = *(const f32x4*)(scp + c);
                    o.x = pk2(hh.x * (1.f + c4.x) + s4.x, hh.y * (1.f + c4.y) + s4.y); o.y = pk2(hh.z * (1.f + c4.z) + s4.z, hh.w * (1.f + c4.w) + s4.w);
                    *(u32x2*)(HM + (size_t)m * D + c) = o; }
            }
        }
    }
    SEAM(0);


    if (IN(2) && is_conv) CONV_SLICE(CV_P0, CV2);
    if (IN(2) && !is_conv) {
        InProjOrder S{Gc, bid, WinT};
        EpiInProj E{P};
        pg8::gemm_phase<EpiInProj, InProjOrder>(lds, HM, D, S, E);
        if (bid >= 1304 - 5 * Gc) {
            const int nt5 = 6 * Gc - 1304;
            for (int u = (bid - (1304 - 5 * Gc)) * NWAVES + wave; u < MR / 32; u += nt5 * NWAVES) {
                const int row0 = u * 32;
                auto arow = [=](int i) { return HM + (size_t)(row0 + i) * D; };
                auto brow = [=](int j, int) { return WinT + (size_t)(NP + j) * D; };
                auto epi = [=](int i, int j, float v, float) { LR[(size_t)(row0 + i) * 32 + j] = v; };
                wave_gemm32<1>(arow, brow, epi, D, lane);
            }
            MOE_RANGE(CV_P0 + CV2 + (bid - (1304 - 5 * Gc)) * NWAVES + wave, CV_P0 + CV2 + CV2X, nt5 * NWAVES);
        }
    }
    SEAM(2);

    if (IN(3)) {
        LAS float* LRs = (LAS float*)lds;
        LAS float* PART = (LAS float*)(lds + 8192);
        LAS bf16* QEs = (LAS bf16*)(lds + 10240);
        LAS bf16* KEs = (LAS bf16*)(lds + 27648);
        LAS bf16* ATTs = (LAS bf16*)(lds + 45056);
        LAS bf16* VTs = (LAS bf16*)(lds + 54272);
        LAS bf16* Qs = (LAS bf16*)(lds + 91136);
        LAS bf16* Ks = (LAS bf16*)(lds + 108544);
        for (int u = bid; u < NBATCH * 68 * 4; u += G) {
            const int h = u & 3, bc = u >> 2, b = bc / 68, c = bc % 68; const bool lat = c >= 4;
            const int row0 = lat ? b * SEQ + (c - 4) * 64 : T + b * CTX + c * 64;
            const int d = tid & 127, tq = tid >> 7;
            const f32x4 lr4 = *(const f32x4*)(LR + (size_t)(row0 + (tid >> 3)) * 32 + (tid & 7) * 4);
            u32x4 vraw[4];
#pragma unroll
            for (int i = 0; i < 4; ++i) { const int ch = tid + 512 * i, sx = ch & 63, e8 = ch >> 6; vraw[i] = *(const u32x4*)(P + (size_t)(row0 + sx) * NP + C_VG + h * 256 + e8 * 8); }
            u32x4 qk4[4];
#pragma unroll
            for (int i = 0; i < 2; ++i) { const int ch = tid + 512 * i, t = ch >> 4, c16 = ch & 15; const bf16* pr = P + (size_t)(row0 + t) * NP + h * 128 + c16 * 8; qk4[i] = *(const u32x4*)(pr + C_Q); qk4[2 + i] = *(const u32x4*)(pr + C_K); }
            float wg[2][16], bias2[2];
#pragma unroll
            for (int r = 0; r < 16; ++r) { wg[0][r] = wgk_f[r * 512 + h * 128 + d]; wg[1][r] = wgk_b[r * 512 + h * 128 + d]; }
            bias2[0] = bgk_f[h * 128 + d]; bias2[1] = bgk_b[h * 128 + d];
            *(LAS f32x4*)(LRs + (tid >> 3) * 32 + (tid & 7) * 4) = lr4;
#pragma unroll
            for (int i = 0; i < 2; ++i) { const int ch = tid + 512 * i, t = ch >> 4, c16 = ch & 15; *(LAS u32x4*)(Qs + t * 136 + c16 * 8) = qk4[i]; *(LAS u32x4*)(Ks + t * 136 + c16 * 8) = qk4[2 + i]; }
#pragma unroll
            for (int i = 0; i < 4; ++i) { const int ch = tid + 512 * i, sx = ch & 63, e8 = ch >> 6; const unsigned ww[4] = {vraw[i].x, vraw[i].y, vraw[i].z, vraw[i].w};
#pragma unroll
                for (int j = 0; j < 4; ++j) { VTs[(e8 * 8 + 2 * j) * 72 + sx] = (bf16)(ww[j] & 0xffffu); VTs[(e8 * 8 + 2 * j + 1) * 72 + sx] = (bf16)(ww[j] >> 16); } }
            LBAR();
#pragma unroll
            for (int i = 0; i < 4; ++i) { const int ch = tid + 512 * i, e = ch >> 3, c8 = ch & 7; *(u32x4*)(VTg + ((size_t)u * 256 + e) * 64 + c8 * 8) = *(const LAS u32x4*)(VTs + e * 72 + c8 * 8); }
            bf16 qraw[16], kraw[16];
#pragma unroll
            for (int i = 0; i < 16; ++i) { qraw[i] = Qs[(16 * tq + i) * 136 + d]; kraw[i] = Ks[(16 * tq + i) * 136 + d]; }
            f32x4 att[2]; att[0] = (f32x4){0.f, 0.f, 0.f, 0.f}; att[1] = att[0];
#pragma unroll
            for (int dir = 0; dir < 2; ++dir) {
                bf16* QEg = dir ? QEB : QEF; bf16* KDg = dir ? KDB : KDF; float* DECg = dir ? DECB : DECF;
                const float (&w)[16] = wg[dir]; const float bias = bias2[dir];
                float cs[16];
#pragma unroll
                for (int i = 0; i < 16; ++i) { const LAS float* lr = LRs + (16 * tq + i) * 32 + dir * 16; float pre = bias;
#pragma unroll
                    for (int r4 = 0; r4 < 4; ++r4) { const f32x4 l4 = *(const LAS f32x4*)(lr + 4 * r4); pre += l4.x * w[4 * r4] + l4.y * w[4 * r4 + 1] + l4.z * w[4 * r4 + 2] + l4.w * w[4 * r4 + 3]; }
                    cs[i] = (fminf(pre, 0.f) - __logf(1.f + __expf(-fabsf(pre)))) * (1.f / 16.f); }
                if (dir == 0) {
#pragma unroll
                    for (int i = 1; i < 16; ++i) cs[i] += cs[i - 1];
                    PART[tq * 128 + d] = cs[15];
                } else {
#pragma unroll
                    for (int i = 14; i >= 0; --i) cs[i] += cs[i + 1];
                    PART[tq * 128 + d] = cs[0];
                }
                LBAR();
                const float p0 = PART[d], p1 = PART[128 + d], p2 = PART[256 + d], p3 = PART[384 + d]; const float blast = (p0 + p1) + (p2 + p3);
                float off;
                if (dir == 0) off = (tq > 0 ? p0 : 0.f) + (tq > 1 ? p1 : 0.f) + (tq > 2 ? p2 : 0.f);
                else off = (tq < 3 ? p3 : 0.f) + (tq < 2 ? p2 : 0.f) + (tq < 1 ? p1 : 0.f);
                unsigned kdp[8];
#pragma unroll
                for (int i = 0; i < 16; ++i) { const int t = 16 * tq + i; const float bcm = off + cs[i];
                    const float q = bf2f(qraw[i]) * 0.08838834764831845f, k = bf2f(kraw[i]);
                    const unsigned qe = f2bf(q * __expf(bcm)), ke = f2bf(k * __expf(-bcm)), kd = f2bf(k * __expf(blast - bcm));
                    QEs[t * 136 + d] = (bf16)qe; KEs[t * 136 + d] = (bf16)ke;
                    if (i & 1) kdp[i >> 1] |= kd << 16; else kdp[i >> 1] = kd; }
                { u32x4 k0, k1; k0.x = kdp[0]; k0.y = kdp[1]; k0.z = kdp[2]; k0.w = kdp[3]; k1.x = kdp[4]; k1.y = kdp[5]; k1.z = kdp[6]; k1.w = kdp[7];
                  bf16* kr = KDg + ((size_t)u * 128 + d) * 64 + 16 * tq; *(u32x4*)kr = k0; *(u32x4*)(kr + 8) = k1; }
                if (tq == 0) DECg[(size_t)u * 128 + d] = expf(blast);
                LBAR();
                if (lat) {
#pragma unroll
                    for (int i = 0; i < 2; ++i) { const int ch = tid + 512 * i, t = ch >> 4, c8 = ch & 15, g16 = c8 >> 1, hh2 = c8 & 1;
                        const u32x2 lo = *(const LAS u32x2*)(QEs + t * 136 + 16 * g16 + 4 * hh2), hi = *(const LAS u32x2*)(QEs + t * 136 + 16 * g16 + 8 + 4 * hh2);
                        u32x4 o; o.x = lo.x; o.y = lo.y; o.z = hi.x; o.w = hi.y; *(u32x4*)(QEg + ((size_t)u * 64 + t) * 128 + c8 * 8) = o; }
                    const int tr = wave >> 1, tc0 = 2 * (wave & 1), r16 = lane & 15, q4 = lane >> 4;
                    f32x4 tmp[2]; tmp[0] = (f32x4){0.f, 0.f, 0.f, 0.f}; tmp[1] = tmp[0];
#pragma unroll
                    for (int ks = 0; ks < 4; ++ks) { const bf16x8 a = *(const LAS bf16x8*)(QEs + (16 * tr + r16) * 136 + 32 * ks + 8 * q4);
#pragma unroll
                        for (int n = 0; n < 2; ++n) { const bf16x8 bb = *(const LAS bf16x8*)(KEs + (16 * (tc0 + n) + r16) * 136 + 32 * ks + 8 * q4);
                            tmp[n] = __builtin_amdgcn_mfma_f32_16x16x32_bf16(a, bb, tmp[n], 0, 0, 0); } }
#pragma unroll
                    for (int n = 0; n < 2; ++n)
#pragma unroll
                        for (int rg = 0; rg < 4; ++rg) { const int t = 16 * tr + 4 * q4 + rg, sx = 16 * (tc0 + n) + r16; const bool keep = dir == 0 ? sx <= t : sx >= t; att[n][rg] += keep ? tmp[n][rg] : 0.f; }
                }
                LBAR();
            }
            if (lat) {
                { const int tr = wave >> 1, tc0 = 2 * (wave & 1), r16 = lane & 15, q4 = lane >> 4;
#pragma unroll
                  for (int n = 0; n < 2; ++n)
#pragma unroll
                      for (int rg = 0; rg < 4; ++rg) ATTs[(16 * tr + 4 * q4 + rg) * 72 + 16 * (tc0 + n) + r16] = (bf16)f2bf(att[n][rg]); }
                LBAR();
                const int r16 = lane & 15, q4 = lane >> 4;
                f32x4 oa[4][2];
#pragma unroll
                for (int tr = 0; tr < 4; ++tr) { oa[tr][0] = (f32x4){0.f, 0.f, 0.f, 0.f}; oa[tr][1] = oa[tr][0]; }
#pragma unroll
                for (int ks = 0; ks < 2; ++ks) { bf16x8 bb[2];
#pragma unroll
                    for (int n = 0; n < 2; ++n) bb[n] = *(const LAS bf16x8*)(VTs + (16 * (2 * wave + n) + r16) * 72 + 32 * ks + 8 * q4);
#pragma unroll
                    for (int tr = 0; tr < 4; ++tr) { const bf16x8 a = *(const LAS bf16x8*)(ATTs + (16 * tr + r16) * 72 + 32 * ks + 8 * q4);
#pragma unroll
                        for (int n = 0; n < 2; ++n) oa[tr][n] = __builtin_amdgcn_mfma_f32_16x16x32_bf16(a, bb[n], oa[tr][n], 0, 0, 0); } }
#pragma unroll
                for (int tr = 0; tr < 4; ++tr)
#pragma unroll
                    for (int n = 0; n < 2; ++n)
#pragma unroll
                        for (int rg = 0; rg < 4; ++rg) OI[(size_t)(row0 + 16 * tr + 4 * q4 + rg) * 1024 + h * 256 + 16 * (2 * wave + n) + r16] = oa[tr][n][rg];
            }
            LBAR();
        }
            LAS float* stat = (LAS float*)lds;
            LAS float* gn = (LAS float*)(lds + 1024);
            LAS float* bn = (LAS float*)(lds + 5120);
            LAS float* bsl = (LAS float*)(lds + 9216);
            LAS bf16* Ws = (LAS bf16*)(lds + 13312);
            LAS bf16* VnT = (LAS bf16*)(lds + 48128);
            {
                for (int i = tid; i < 1024; i += NTHREADS) { gn[i] = cm_norm_g[i]; bn[i] = cm_norm_b[i]; bsl[i] = cm_b_s[i]; }
                LBAR();
                for (int u = bid; u < NBATCH * 32 * 2; u += G) {
                    const int r0 = (u >> 1) * 128, h0 = (u & 1) * 4, r16 = lane & 15, q4 = lane >> 4;
#pragma unroll 1
                    for (int qb = 0; qb < 16; qb += 8) {
                        u32x4 ra[8], rb[8];
#pragma unroll
                        for (int j = 0; j < 8; ++j) { const bf16* vr = P + (size_t)(r0 + wave * 16 + qb + j) * NP + C_V + 16 * lane; ra[j] = *(const u32x4*)vr; rb[j] = *(const u32x4*)(vr + 8); }
#pragma unroll
                        for (int j = 0; j < 8; ++j) {
                            const float f[16] = {bflo(ra[j].x), bfhi(ra[j].x), bflo(ra[j].y), bfhi(ra[j].y), bflo(ra[j].z), bfhi(ra[j].z), bflo(ra[j].w), bfhi(ra[j].w), bflo(rb[j].x), bfhi(rb[j].x), bflo(rb[j].y), bfhi(rb[j].y), bflo(rb[j].z), bfhi(rb[j].z), bflo(rb[j].w), bfhi(rb[j].w)};
                            float sm = 0.f;
#pragma unroll
                            for (int i = 0; i < 16; ++i) sm += f[i];
                            const float mean = wave_sum(sm) * (1.f / 1024.f); float s2 = 0.f;
#pragma unroll
                            for (int i = 0; i < 16; ++i) { const float dl = f[i] - mean; s2 += dl * dl; }
                            const float rstd = 1.f / sqrtf(wave_sum(s2) * (1.f / 1024.f) + LN_EPS);
                            if (lane == 0) { stat[2 * (wave * 16 + qb + j)] = mean; stat[2 * (wave * 16 + qb + j) + 1] = rstd; }
                        }
                    }
                    f32x4 wreg[8]; u32x4 vreg[4]; u32x2 ureg[8];
#define CM_LOAD(h_) do { int t_ = tid; asm volatile("" : "+v"(t_)); _Pragma("unroll") for (int i_ = 0; i_ < 8; ++i_) { const int ch_ = t_ + 512 * i_; wreg[i_] = *(const f32x4*)(cm_w_s + ((size_t)(h_) * 128 + (ch_ >> 5)) * 128 + 4 * (ch_ & 31)); } \
                        _Pragma("unroll") for (int i_ = 0; i_ < 4; ++i_) { const int ch_ = t_ + 512 * i_; vreg[i_] = *(const u32x4*)(P + (size_t)(r0 + (ch_ & 127)) * NP + C_V + (h_) * 128 + (ch_ >> 7) * 8); } } while (0)
                    CM_LOAD(h0);
                    LBAR();
#pragma unroll 1
                    for (int h = h0; h < h0 + 4; ++h) {
#pragma unroll
                        for (int tp = 0; tp < 8; ++tp) ureg[tp] = *(const u32x2*)(P + (size_t)(r0 + 16 * tp + r16) * NP + C_U + h * 128 + 16 * wave + 4 * q4);
#pragma unroll
                        for (int i = 0; i < 8; ++i) { const int ch = tid + 512 * i; u32x2 o; o.x = pk2(wreg[i].x, wreg[i].y); o.y = pk2(wreg[i].z, wreg[i].w); *(LAS u32x2*)(Ws + (ch >> 5) * 136 + 4 * (ch & 31)) = o; }
#pragma unroll
                        for (int i = 0; i < 4; ++i) { const int ch = tid + 512 * i, q = ch & 127, e8 = ch >> 7; const u32x4 w = vreg[i];
                            const float mean = stat[2 * q], rstd = stat[2 * q + 1]; const LAS float* gp = gn + h * 128 + e8 * 8; const LAS float* bp = bn + h * 128 + e8 * 8;
                            const f32x4 g0 = *(const LAS f32x4*)gp, g1 = *(const LAS f32x4*)(gp + 4), b0 = *(const LAS f32x4*)bp, b1 = *(const LAS f32x4*)(bp + 4);
                            const float vv[8] = {bflo(w.x), bfhi(w.x), bflo(w.y), bfhi(w.y), bflo(w.z), bfhi(w.z), bflo(w.w), bfhi(w.w)};
                            const float gg[8] = {g0.x, g0.y, g0.z, g0.w, g1.x, g1.y, g1.z, g1.w}, bb[8] = {b0.x, b0.y, b0.z, b0.w, b1.x, b1.y, b1.z, b1.w};
#pragma unroll
                            for (int j = 0; j < 8; ++j) VnT[(e8 * 8 + j) * 136 + q] = (bf16)f2bf((vv[j] - mean) * rstd * gg[j] + bb[j]); }
                        if (h + 1 < h0 + 4) CM_LOAD(h + 1);
                        LBAR();
                        f32x4 acc[8];
#pragma unroll
                        for (int tp = 0; tp < 8; ++tp) acc[tp] = (f32x4){0.f, 0.f, 0.f, 0.f};
#pragma unroll
                        for (int ks = 0; ks < 4; ++ks) { const bf16x8 a = *(const LAS bf16x8*)(VnT + (16 * wave + r16) * 136 + 32 * ks + 8 * q4);
#pragma unroll
                            for (int tp = 0; tp < 8; ++tp) { const bf16x8 bq = *(const LAS bf16x8*)(Ws + (16 * tp + r16) * 136 + 32 * ks + 8 * q4);
                                acc[tp] = __builtin_amdgcn_mfma_f32_16x16x32_bf16(a, bq, acc[tp], 0, 0, 0); } }
#pragma unroll
                        for (int tp = 0; tp < 8; ++tp) { const int pp = 16 * tp + r16, e0 = 16 * wave + 4 * q4; const float bs = bsl[h * 128 + pp]; const u32x2 uu = ureg[tp];
                            u32x2 o; o.x = pk2(bflo(uu.x) * (acc[tp][0] + bs), bfhi(uu.x) * (acc[tp][1] + bs)); o.y = pk2(bflo(uu.y) * (acc[tp][2] + bs), bfhi(uu.y) * (acc[tp][3] + bs));
                            *(u32x2*)(ACAT + (size_t)(r0 + pp) * D + h * 128 + e0) = o; }
                        LBAR();
                    }
#undef CM_LOAD
                }
            }
    }
    SEAM(3);

    if (IN(4)) {
        if (bid < 64) {
            const int bhd = bid >> 1, eh = bid & 1, b = bhd >> 3, h = (bhd >> 1) & 3, dir = bhd & 1;
            const bf16* QEg = dir ? QEB : QEF; const bf16* KDg = dir ? KDB : KDF; const float* DECg = dir ? DECB : DECF; float* O = dir ? OB : OF;
            constexpr int GBUF = 55296;
            if (wave >= 4) {
                const int pt = tid - 256;
                u32x4 R0_[13], R1_[13], R2_[13];
#define G2_PLOAD(R, n) do { const int c_ = dir ? ((n) < 4 ? 3 - (n) : 71 - (n)) : (n); const size_t u_ = (size_t)(b * 68 + c_) * 4 + h; \
                    _Pragma("unroll") for (int i_ = 0; i_ < 4; ++i_) { const int q_ = pt + 256 * i_; R[i_] = c_ >= 4 ? *(const u32x4*)(QEg + u_ * 8192 + (size_t)q_ * 8) : (u32x4){0u, 0u, 0u, 0u}; \
                        R[4 + i_] = *(const u32x4*)(KDg + u_ * 8192 + (size_t)q_ * 8); R[8 + i_] = *(const u32x4*)(VTg + (u_ * 256 + eh * 128) * 64 + (size_t)q_ * 8); } \
                    R[12] = *(const u32x4*)(DECg + u_ * 128 + (pt & 31) * 4); } while (0)
#define G2_PSTORE(R, bb) do { LAS unsigned char* base_ = lds + (bb) * GBUF; \
                    _Pragma("unroll") for (int i_ = 0; i_ < 4; ++i_) { const int q_ = pt + 256 * i_; *(LAS u32x4*)(base_ + (q_ >> 4) * 272 + (q_ & 15) * 16) = R[i_]; \
                        *(LAS u32x4*)(base_ + 17408 + (q_ >> 3) * 144 + (q_ & 7) * 16) = R[4 + i_]; *(LAS u32x4*)(base_ + 36352 + (q_ >> 3) * 144 + (q_ & 7) * 16) = R[8 + i_]; } \
                    if (pt < 32) *(LAS u32x4*)(base_ + 35840 + pt * 16) = R[12]; } while (0)
                G2_PLOAD(R0_, 0); G2_PLOAD(R1_, 1); G2_PLOAD(R2_, 2); G2_PSTORE(R0_, 0); G2_PLOAD(R0_, 3);
                LBAR();
#pragma unroll 1
                for (int n = 0; n < 66; n += 3) {
                    G2_PSTORE(R1_, (n + 1) & 1); if (n + 4 < 68) G2_PLOAD(R1_, n + 4); LBAR();
                    G2_PSTORE(R2_, (n + 2) & 1); if (n + 5 < 68) G2_PLOAD(R2_, n + 5); LBAR();
                    G2_PSTORE(R0_, (n + 3) & 1); if (n + 6 < 68) G2_PLOAD(R0_, n + 6); LBAR();
                }
                G2_PSTORE(R1_, 1); LBAR();
                LBAR();
#undef G2_PLOAD
#undef G2_PSTORE
            } else {
                const int ws = eh * 4 + wave, r = lane & 31, hh = lane >> 5;
                __builtin_amdgcn_s_setprio(2);
                typedef float f32x16 __attribute__((ext_vector_type(16)));
                f32x16 S[4];
#pragma unroll
                for (int dt = 0; dt < 4; ++dt)
#pragma unroll
                    for (int i = 0; i < 16; ++i) S[dt][i] = 0.f;
                LBAR();
#pragma unroll 1
                for (int n = 0; n < 68; ++n) {
                    const int c = dir ? (n < 4 ? 3 - n : 71 - n) : n;
                    const LAS unsigned char* base = lds + (n & 1) * GBUF;
                    if (c >= 4) {
                        f32x16 o[2];
#pragma unroll
                        for (int i = 0; i < 16; ++i) { o[0][i] = 0.f; o[1][i] = 0.f; }
#pragma unroll
                        for (int dt = 0; dt < 4; ++dt)
#pragma unroll
                            for (int s2 = 0; s2 < 2; ++s2) {
                                u32x4 pk; pk.x = pk2(S[dt][8 * s2], S[dt][8 * s2 + 1]); pk.y = pk2(S[dt][8 * s2 + 2], S[dt][8 * s2 + 3]); pk.z = pk2(S[dt][8 * s2 + 4], S[dt][8 * s2 + 5]); pk.w = pk2(S[dt][8 * s2 + 6], S[dt][8 * s2 + 7]);
                                const bf16x8 bs = __builtin_bit_cast(bf16x8, pk);
#pragma unroll
                                for (int tt = 0; tt < 2; ++tt) { const bf16x8 a = *(const LAS bf16x8*)(base + (32 * tt + r) * 272 + (32 * dt + 16 * s2 + 8 * hh) * 2);
                                    o[tt] = __builtin_amdgcn_mfma_f32_32x32x16_bf16(a, bs, o[tt], 0, 0, 0); }
                            }
                        float* orow = O + (size_t)(b * SEQ + (c - 4) * 64) * 1024 + h * 256 + 32 * ws + r;
#pragma unroll
                        for (int tt = 0; tt < 2; ++tt)
#pragma unroll
                            for (int i = 0; i < 16; ++i) orow[(size_t)(32 * tt + (i & 3) + 8 * (i >> 2) + 4 * hh) * 1024] = o[tt][i];
                    }
                    bf16x8 vt[4];
#pragma unroll
                    for (int s4 = 0; s4 < 4; ++s4) vt[s4] = *(const LAS bf16x8*)(base + 36352 + (32 * wave + r) * 144 + (16 * s4 + 8 * hh) * 2);
#pragma unroll
                    for (int dt = 0; dt < 4; ++dt)
#pragma unroll
                        for (int g4 = 0; g4 < 4; ++g4) { const f32x4 dc = *(const LAS f32x4*)(base + 35840 + (32 * dt + 8 * g4 + 4 * hh) * 4);
                            S[dt][4 * g4] *= dc.x; S[dt][4 * g4 + 1] *= dc.y; S[dt][4 * g4 + 2] *= dc.z; S[dt][4 * g4 + 3] *= dc.w; }
#pragma unroll
                    for (int s4 = 0; s4 < 4; ++s4)
#pragma unroll
                        for (int dt = 0; dt < 4; ++dt) { const bf16x8 a = *(const LAS bf16x8*)(base + 17408 + (32 * dt + r) * 144 + (16 * s4 + 8 * hh) * 2);
                            S[dt] = __builtin_amdgcn_mfma_f32_32x32x16_bf16(a, vt[s4], S[dt], 0, 0, 0); }
                    LBAR();
                }
                __builtin_amdgcn_s_setprio(0);
            }
        } else {
            if (wave < 2) MOE_RANGE(CV_P0 + CV2 + CV2X + CV3 + (bid - 64) * 2 + wave, CV_P0 + CV2 + CV2X + CV3 + CV4, (G - 64) * 2);
        }
    }
    SEAM(4);

    if (IN(5) && is_conv) CONV_SLICE(CV_P0 + CV2 + CV2X + CV3 + CV4, CV5);
    if (IN(5) && !is_conv) {
        const int c0 = 16 * lane; float ng[16];
#pragma unroll
        for (int j = 0; j < 4; ++j) { const f32x4 g4 = *(const f32x4*)(gla_norm_g + ((c0 + 4 * j) & 255)); ng[4 * j] = g4.x; ng[4 * j + 1] = g4.y; ng[4 * j + 2] = g4.z; ng[4 * j + 3] = g4.w; }
        for (int m0 = gw; m0 < T; m0 += 2 * NGWc) {
            f32x4 ra[2][4], rb[2][4], ri[2][4]; u32x4 rg[2][2];
#pragma unroll
            for (int t2 = 0; t2 < 2; ++t2) { const int m = (m0 + t2 * NGWc) < T ? m0 + t2 * NGWc : m0;
#pragma unroll
                for (int j = 0; j < 4; ++j) { ra[t2][j] = *(const f32x4*)(OF + (size_t)m * 1024 + c0 + 4 * j); rb[t2][j] = *(const f32x4*)(OB + (size_t)m * 1024 + c0 + 4 * j); ri[t2][j] = *(const f32x4*)(OI + (size_t)m * 1024 + c0 + 4 * j); }
                rg[t2][0] = *(const u32x4*)(P + (size_t)m * NP + C_GO + c0); rg[t2][1] = *(const u32x4*)(P + (size_t)m * NP + C_GO + c0 + 8); }
#pragma unroll
            for (int t2 = 0; t2 < 2; ++t2) { const int m = m0 + t2 * NGWc; if (m >= T) break;
                float o[16];
#pragma unroll
                for (int j = 0; j < 4; ++j) { const f32x4 a = ra[t2][j], b2 = rb[t2][j], i3 = ri[t2][j];
                    o[4 * j] = (a.x + b2.x) + i3.x; o[4 * j + 1] = (a.y + b2.y) + i3.y; o[4 * j + 2] = (a.z + b2.z) + i3.z; o[4 * j + 3] = (a.w + b2.w) + i3.w; }
                float ss = 0.f;
#pragma unroll
                for (int j = 0; j < 16; ++j) ss += o[j] * o[j];
                ss += __shfl_xor(ss, 1); ss += __shfl_xor(ss, 2); ss += __shfl_xor(ss, 4); ss += __shfl_xor(ss, 8);
                const float rms = 1.f / sqrtf(ss * (1.f / 256.f) + RMS_EPS);
                const unsigned gw8[8] = {rg[t2][0].x, rg[t2][0].y, rg[t2][0].z, rg[t2][0].w, rg[t2][1].x, rg[t2][1].y, rg[t2][1].z, rg[t2][1].w};
                float r[16];
#pragma unroll
                for (int j = 0; j < 8; ++j) { const float g0 = bflo(gw8[j]), g1 = bfhi(gw8[j]);
                    r[2 * j] = o[2 * j] * rms * ng[2 * j] * g0 * __builtin_amdgcn_rcpf(1.f + __expf(-g0)); r[2 * j + 1] = o[2 * j + 1] * rms * ng[2 * j + 1] * g1 * __builtin_amdgcn_rcpf(1.f + __expf(-g1)); }
                u32x4 w0, w1; w0.x = pk2(r[0], r[1]); w0.y = pk2(r[2], r[3]); w0.z = pk2(r[4], r[5]); w0.w = pk2(r[6], r[7]);
                w1.x = pk2(r[8], r[9]); w1.y = pk2(r[10], r[11]); w1.z = pk2(r[12], r[13]); w1.w = pk2(r[14], r[15]);
                *(u32x4*)(ACAT + (size_t)m * D + 1024 + c0) = w0; *(u32x4*)(ACAT + (size_t)m * D + 1024 + c0 + 8) = w1; }
        }
    }
    SEAM(5);

    if (IN(6)) {
        pg8::DenseOrder S; S.init(T, D, G, bid, WoutT, D);
        EpiOutProj E{Z, HN, MOD};
        pg8::gemm_phase<EpiOutProj, pg8::DenseOrder>(lds, ACAT, D, S, E);
    }
    SEAM(6);

    if (IN(7)) {
        LAS float* part = (LAS float*)lds;
        LAS float* lgt = (LAS float*)(lds + 32768);
        LAS int* selE = (LAS int*)(lds + 36864);
        LAS unsigned* lcnt = (LAS unsigned*)(lds + 36864 + 512);
        LAS unsigned* gbs = lcnt + 32;
        if (tid < 32) lcnt[tid] = 0u;
        typedef float f32x16 __attribute__((ext_vector_type(16)));
        LAS float* LG1 = (LAS float*)(lds + 40960); LAS float* LB1 = LG1 + D; LAS float* SH2 = LB1 + D; LAS float* SC2 = SH2 + D;
        for (int i = tid; i < D; i += NTHREADS) { LG1[i] = ln1_g[i]; LB1[i] = ln1_b[i]; }
        for (int g0 = bid * 32; g0 < T; g0 += G * 32) {
            { const float* sh2g = MOD + (g0 / SEQ) * (6 * D) + 3 * D; for (int i = tid; i < D; i += NTHREADS) { SH2[i] = sh2g[i]; SC2[i] = sh2g[D + i]; } }
            LBAR();
            u32x4 zc[4], zn[4];
#pragma unroll
            for (int j2 = 0; j2 < 4; ++j2) zc[j2] = *(const u32x4*)(Z + (size_t)(g0 + wave * 4) * D + 8 * (lane + 64 * j2));
#pragma unroll
            for (int j4 = 0; j4 < 4; ++j4) {
                const int m = g0 + wave * 4 + j4;
                if (j4 + 1 < 4) {
#pragma unroll
                    for (int j2 = 0; j2 < 4; ++j2) zn[j2] = *(const u32x4*)(Z + (size_t)(m + 1) * D + 8 * (lane + 64 * j2)); }
                f32x4 v[8]; float s = 0.f;
#pragma unroll
                for (int j2 = 0; j2 < 4; ++j2) { const u32x4 zz = zc[j2];
                    v[2 * j2] = (f32x4){bflo(zz.x), bfhi(zz.x), bflo(zz.y), bfhi(zz.y)}; v[2 * j2 + 1] = (f32x4){bflo(zz.z), bfhi(zz.z), bflo(zz.w), bfhi(zz.w)}; }
#pragma unroll
                for (int j = 0; j < 8; ++j) s += (v[j].x + v[j].y) + (v[j].z + v[j].w);
                const float mean = wave_sum(s) * (1.f / D); float s2 = 0.f;
#pragma unroll
                for (int j = 0; j < 8; ++j) { v[j] = v[j] - mean; s2 += (v[j].x * v[j].x + v[j].y * v[j].y) + (v[j].z * v[j].z + v[j].w * v[j].w); }
                const float rstd = 1.f / sqrtf(wave_sum(s2) * (1.f / D) + LN_EPS);
#pragma unroll
                for (int j = 0; j < 8; ++j) { const int c = 8 * (lane + 64 * (j >> 1)) + 4 * (j & 1); const f32x4 g = *(const LAS f32x4*)(LG1 + c), bb = *(const LAS f32x4*)(LB1 + c), a = *(const LAS f32x4*)(SH2 + c), sc = *(const LAS f32x4*)(SC2 + c);
                    f32x4 h; h.x = v[j].x * rstd * g.x + bb.x; h.y = v[j].y * rstd * g.y + bb.y; h.z = v[j].z * rstd * g.z + bb.z; h.w = v[j].w * rstd * g.w + bb.w;
                    u32x2 o; o.x = pk2(h.x, h.y); o.y = pk2(h.z, h.w); *(u32x2*)(H1 + (size_t)m * D + c) = o;
                    f32x4 hm; hm.x = h.x * (1.f + sc.x) + a.x; hm.y = h.y * (1.f + sc.y) + a.y; hm.z = h.z * (1.f + sc.z) + a.z; hm.w = h.w * (1.f + sc.w) + a.w;
                    o.x = pk2(hm.x, hm.y); o.y = pk2(hm.z, hm.w); *(u32x2*)(HM2 + (size_t)m * D + c) = o;
                    u32x2 l; l.x = pk2(hm.x - bflo(o.x), hm.y - bfhi(o.x)); l.y = pk2(hm.z - bflo(o.y), hm.w - bfhi(o.y)); *(u32x2*)(HM2LO + (size_t)m * D + c) = l;
                    int f8 = __builtin_amdgcn_cvt_pk_fp8_f32(hm.x, hm.y, 0, false); f8 = __builtin_amdgcn_cvt_pk_fp8_f32(hm.z, hm.w, f8, true); *(int*)(HM2F8 + (size_t)m * D + c) = f8; }
#pragma unroll
                for (int j2 = 0; j2 < 4; ++j2) zc[j2] = zn[j2];
            }
            asm volatile("s_waitcnt vmcnt(0)" ::: "memory"); __syncthreads();
            {
                const int r = lane & 31, hh = lane >> 5; f32x16 acc;
#pragma unroll
                for (int i = 0; i < 16; ++i) acc[i] = 0.f;
#pragma unroll 4
                for (int ks = 0; ks < 16; ++ks) { const int kk = 256 * wave + 16 * ks + 8 * hh;
                    const bf16x8 ahi = *(const bf16x8*)(HM2 + (size_t)(g0 + r) * D + kk), alo = *(const bf16x8*)(HM2LO + (size_t)(g0 + r) * D + kk);
                    const bf16x8 bhi = *(const bf16x8*)(WRH + (size_t)r * D + kk), blo = *(const bf16x8*)(WRL + (size_t)r * D + kk);
                    acc = __builtin_amdgcn_mfma_f32_32x32x16_bf16(ahi, bhi, acc, 0, 0, 0); acc = __builtin_amdgcn_mfma_f32_32x32x16_bf16(alo, bhi, acc, 0, 0, 0); acc = __builtin_amdgcn_mfma_f32_32x32x16_bf16(ahi, blo, acc, 0, 0, 0); }
#pragma unroll
                for (int i = 0; i < 16; ++i) part[(wave * 32 + (i & 3) + 8 * (i >> 2) + 4 * hh) * 32 + r] = acc[i];
            }
            LBAR();
#pragma unroll
            for (int j = 0; j < 2; ++j) { const int idx = tid + 512 * j; float sum = b_router[idx & 31];
#pragma unroll
                for (int w8 = 0; w8 < 8; ++w8) sum += part[w8 * 1024 + idx];
                lgt[idx] = sum; }
            LBAR();
#pragma unroll 1
            for (int j4 = 0; j4 < 4; ++j4) {
                const int tok = wave * 4 + j4, m = g0 + tok;
                float val = lane < 32 ? lgt[tok * 32 + lane] : -INFINITY; float tv[4]; int ti[4];
#pragma unroll
                for (int k = 0; k < 4; ++k) { const float mx = wave_max(val); const unsigned long long bm = __ballot(val == mx); const int idx = __ffsll((long long)bm) - 1;
                    tv[k] = mx; ti[k] = idx; if (lane == idx) val = -INFINITY; }
                const float e1 = expf(tv[1] - tv[0]), e2 = expf(tv[2] - tv[0]), e3 = expf(tv[3] - tv[0]); const float inv = 1.f / (1.f + e1 + e2 + e3);
                if (lane < 4) { const int ex = lane == 0 ? ti[0] : lane == 1 ? ti[1] : lane == 2 ? ti[2] : ti[3]; const float w = (lane == 0 ? 1.f : lane == 1 ? e1 : lane == 2 ? e2 : e3) * inv;
                    selE[tok * 4 + lane] = ex; TOPW[m * 4 + lane] = w; }
            }
            LBAR();
            int ex = 0; unsigned lpos = 0;
            if (tid < 128) { ex = selE[tid]; lpos = __hip_atomic_fetch_add(lcnt + ex, 1u, __ATOMIC_RELAXED, __HIP_MEMORY_SCOPE_WORKGROUP); }
            LBAR();
            if (tid < 32) { const unsigned c = lcnt[tid]; gbs[tid] = c ? atomicAdd(CNT + tid * 64, c) : 0u; lcnt[tid] = 0u; }
            LBAR();
            if (tid < 128) { const unsigned pos = gbs[ex] + lpos; const int m = g0 + (tid >> 2); LIST[ex * T + pos] = m * 4 + (tid & 3); TOPEP[m * 4 + (tid & 3)] = ((unsigned)ex << 16) | pos; }
        }
    }
    SEAM(7);

    if (IN(8) || IN(9)) {
        LAS int* tb = (LAS int*)(lds + TBL_OFF);
        LAS int* cn = tb + 64;
        LBAR();
        if (tid == 0) { int a = 0; for (int e = 0; e < NE; ++e) { const int c = (int)CNT[e * 64]; cn[e] = c; tb[e] = a; a += (c + 255) / 256; } tb[NE] = a; }
        LBAR();
        if (IN(8) && is_conv) CONV_SLICE(CV_GU, CV_TOT - CV_GU);
        if (IN(8) && !is_conv) {
            LAS int* UT = (LAS int*)(lds + TBL_OFF + 512);
            LAS bf16* BT = (LAS bf16*)(lds + EPT_OFF); LAS unsigned short* RL = (LAS unsigned short*)(lds + EPT_OFF + EPT_RL * 512);
            MoeOrder<true> S{tb, cn, 16, Gc, bid, WguT, (size_t)4096 * 2048, LIST, D, UT, RL};
            S.build(UT, tid); LBAR(); S.pack(lane);
            { int pr[EPT_RL]; float pv[EPT_RL]; const int t8 = tid & 255;
#pragma unroll
              for (int i = 0; i < EPT_RL; ++i) { pg8::Unit pu; const bool ok = S.next(i, pu); pr[i] = (ok && t8 < pu.nv) ? LIST[pu.e * T + pu.mt * 256 + t8] >> 2 : 0;
                  pv[i] = ok ? b_gu[(size_t)pu.e * 4096 + (t8 >> 7) * 2048 + pu.pn * 128 + (t8 & 127)] : 0.f; }
#pragma unroll
              for (int i = 0; i < EPT_RL; ++i) if (tid < 256) { RL[i * 256 + tid] = (unsigned short)pr[i]; BT[i * 256 + tid] = (bf16)f2bf(pv[i]); } }
            LBAR();
            EpiGateUp E{ACT, BT};
            pg8::gemm_phase<EpiGateUp, MoeOrder<true>, 1>(lds, HM2F8, D, S, E);
        }
        if (IN(8) && IN(9)) xcd_barrier(bar);
        if (IN(9)) {
            LAS int* UT = (LAS int*)(lds + TBL_OFF + 512);
            MoeOrder<false> S{tb, cn, 8, G, bid, WdnT, (size_t)2048 * 2048, LIST, D, UT, nullptr};
            S.build(UT, tid); LBAR(); S.pack(lane);
            LAS float* BT = (LAS float*)(lds + EPT_OFF); LAS int* LT = (LAS int*)(lds + EPT_OFF + EPT_UNITS9 * 1024);
            { float pv[EPT_UNITS9]; int pl[EPT_UNITS9]; const int t8 = tid & 255;
#pragma unroll
              for (int i = 0; i < EPT_UNITS9; ++i) { pg8::Unit pu; const bool ok = S.next(i, pu); pv[i] = ok ? b_dn[(size_t)pu.e * 2048 + pu.pn * 256 + t8] : 0.f; pl[i] = (ok && t8 < pu.nv) ? LIST[pu.e * T + pu.mt * 256 + t8] : 0; }
#pragma unroll
              for (int i = 0; i < EPT_UNITS9; ++i) if (tid < 256) { BT[i * 256 + tid] = pv[i]; LT[i * 256 + tid] = pl[i]; } }
            LBAR();
            EpiDown E{YB, BT, LT};
            pg8::gemm_phase<EpiDown, MoeOrder<false>, 1>(lds, ACT, D, S, E);
        }
    }
    SEAM(9);

    if (IN(10)) {
        LAS float* G2T = (LAS float*)lds; LAS float* LG = G2T + 4 * D; LAS float* LB = LG + D;
        for (int i = tid; i < 4 * D; i += NTHREADS) G2T[i] = MOD[(i / D) * (6 * D) + 5 * D + (i % D)];
        for (int i = tid; i < D; i += NTHREADS) { LG[i] = ln2_g[i]; LB[i] = ln2_b[i]; }
        LBAR();
        for (int m0 = gw; m0 < T; m0 += 2 * NGW) {
            u32x4 hr[2][4]; u32x2 yr[2][4][4]; f32x4 wr4[2];
#pragma unroll
            for (int t2 = 0; t2 < 2; ++t2) { const int m = (m0 + t2 * NGW) < T ? m0 + t2 * NGW : m0;
                wr4[t2] = *(const f32x4*)(TOPW + m * 4);
#pragma unroll
                for (int j = 0; j < 4; ++j) { const int c = 8 * (lane + 64 * j); hr[t2][j] = *(const u32x4*)(H1 + (size_t)m * D + c);
#pragma unroll
                    for (int k = 0; k < 4; ++k) yr[t2][j][k] = *(const u32x2*)(YB + ((size_t)m * 4 + k) * D + c); } }
#pragma unroll
            for (int t2 = 0; t2 < 2; ++t2) { const int m = m0 + t2 * NGW; if (m >= T) break;
                const LAS float* g2 = G2T + (m / SEQ) * D;
                const float w0 = wr4[t2].x, w1 = wr4[t2].y, w2 = wr4[t2].z, w3 = wr4[t2].w;
                float z[4][8]; float s = 0.f;
#pragma unroll
                for (int j = 0; j < 4; ++j) { const int c = 8 * (lane + 64 * j);
                    const u32x4 h = hr[t2][j]; const u32x2 y0 = yr[t2][j][0], y1 = yr[t2][j][1], y2 = yr[t2][j][2], y3 = yr[t2][j][3];
                    const f32x4 ga = *(const LAS f32x4*)(g2 + c), gb = *(const LAS f32x4*)(g2 + c + 4);
                    const unsigned hw[4] = {h.x, h.y, h.z, h.w}, a0[2] = {y0.x, y0.y}, a1[2] = {y1.x, y1.y}, a2[2] = {y2.x, y2.y}, a3[2] = {y3.x, y3.y};
                    const float gg[8] = {ga.x, ga.y, ga.z, ga.w, gb.x, gb.y, gb.z, gb.w};
#pragma unroll
                    for (int q = 0; q < 2; ++q)
#pragma unroll
                        for (int h2 = 0; h2 < 2; ++h2) { const int e0 = 4 * q + 2 * h2;
                            const f32v2 p0 = h2 ? __builtin_amdgcn_cvt_pk_f32_fp8((int)a0[q], true) : __builtin_amdgcn_cvt_pk_f32_fp8((int)a0[q], false), p1 = h2 ? __builtin_amdgcn_cvt_pk_f32_fp8((int)a1[q], true) : __builtin_amdgcn_cvt_pk_f32_fp8((int)a1[q], false);
                            const f32v2 p2 = h2 ? __builtin_amdgcn_cvt_pk_f32_fp8((int)a2[q], true) : __builtin_amdgcn_cvt_pk_f32_fp8((int)a2[q], false), p3 = h2 ? __builtin_amdgcn_cvt_pk_f32_fp8((int)a3[q], true) : __builtin_amdgcn_cvt_pk_f32_fp8((int)a3[q], false);
                            const float flo = (((w0 * p0.x + w1 * p1.x) + w2 * p2.x) + w3 * p3.x) * (1.f / YSC);
                            const float fhi = (((w0 * p0.y + w1 * p1.y) + w2 * p2.y) + w3 * p3.y) * (1.f / YSC);
                            const unsigned hword = hw[e0 >> 1];
                            z[j][e0] = ALPHA * bflo(hword) + gg[e0] * flo; z[j][e0 + 1] = ALPHA * bfhi(hword) + gg[e0 + 1] * fhi; s += z[j][e0] + z[j][e0 + 1]; }
                }
                const float mean = wave_sum(s) * (1.f / D); float s2 = 0.f;
#pragma unroll
                for (int j = 0; j < 4; ++j)
#pragma unroll
                    for (int q = 0; q < 8; ++q) { z[j][q] -= mean; s2 += z[j][q] * z[j][q]; }
                const float rstd = 1.f / sqrtf(wave_sum(s2) * (1.f / D) + LN_EPS);
#pragma unroll
                for (int j = 0; j < 4; ++j) { const int c = 8 * (lane + 64 * j);
                    const f32x4 ga = *(const LAS f32x4*)(LG + c), gb = *(const LAS f32x4*)(LG + c + 4), ba = *(const LAS f32x4*)(LB + c), bb = *(const LAS f32x4*)(LB + c + 4);
                    f32x4 o0, o1; o0.x = z[j][0] * rstd * ga.x + ba.x; o0.y = z[j][1] * rstd * ga.y + ba.y; o0.z = z[j][2] * rstd * ga.z + ba.z; o0.w = z[j][3] * rstd * ga.w + ba.w;
                    o1.x = z[j][4] * rstd * gb.x + bb.x; o1.y = z[j][5] * rstd * gb.y + bb.y; o1.z = z[j][6] * rstd * gb.z + bb.z; o1.w = z[j][7] * rstd * gb.w + bb.w;
                    *(f32x4*)(out + (size_t)m * D + c) = o0; *(f32x4*)(out + (size_t)m * D + c + 4) = o1; }
            }
        }
    }
#undef IN
#undef SEAM
}

extern "C" void kernel_launch(void* const* d_in, const int* in_sizes, int n_in, void* d_out, int out_size, void* d_ws, size_t ws_size, hipStream_t stream) {
    static int grid = 0;
    if (grid == 0) {
        if (n_in != 29 || out_size != T * D || ws_size < WS_END) { fprintf(stderr, "kernel_launch: unexpected shapes (n_in %d, out %d, ws %zu); nothing launched\n", n_in, out_size, ws_size); grid = -1; return; }
        int dev = 0, cus = 0, per_cu = 0;
        if (hipGetDevice(&dev) != hipSuccess || hipDeviceGetAttribute(&cus, hipDeviceAttributeMultiprocessorCount, dev) != hipSuccess) { grid = -1; return; }
        if (hipFuncSetAttribute((const void*)fwd, hipFuncAttributeMaxDynamicSharedMemorySize, LDS_BYTES) != hipSuccess) { fprintf(stderr, "kernel_launch: hipFuncSetAttribute failed\n"); grid = -1; return; }
        if (hipOccupancyMaxActiveBlocksPerMultiprocessor(&per_cu, (const void*)fwd, NTHREADS, LDS_BYTES) != hipSuccess || per_cu < 1) { fprintf(stderr, "kernel_launch: occupancy query says %d\n", per_cu); }
        (void)hipGetLastError();
        grid = cus;
    }
    if (grid < 0) return;
    if (hipMemsetAsync((char*)d_ws + WS_CTL, 0, CTL_BYTES, stream) != hipSuccess) return;
    Args a{};
    for (int i = 0; i < 29; ++i) a.in[i] = (const float*)d_in[i];
    a.out = (float*)d_out; a.ws = (unsigned char*)d_ws;
#if PROBE_DUP >= 0
    a.ph_lo = 0; a.ph_hi = PROBE_DUP + 1; hipLaunchKernelGGL(fwd, dim3(grid), dim3(NTHREADS), LDS_BYTES, stream, a);
    hipMemsetAsync((char*)d_ws + WS_CTL + CW_BAR * 4, 0, XCD_BAR_WORDS * 4, stream);
    a.ph_lo = PROBE_DUP; a.ph_hi = NPHASE; hipLaunchKernelGGL(fwd, dim3(grid), dim3(NTHREADS), LDS_BYTES, stream, a);
#elif MK_ONE_LAUNCH
    a.ph_lo = 0; a.ph_hi = NPHASE;
    hipLaunchKernelGGL(fwd, dim3(grid), dim3(NTHREADS), LDS_BYTES, stream, a);
#else
    for (int p = 0; p < NPHASE; ++p) { a.ph_lo = p; a.ph_hi = p + 1; hipLaunchKernelGGL(fwd, dim3(grid), dim3(NTHREADS), LDS_BYTES, stream, a); }
#endif
}
```

```cpp
#include <hip/hip_runtime.h>
#include <cstdio>
#include <cstdint>

#ifndef PROBE_DUP
#define PROBE_DUP -1
#endif
#ifndef PROBE_CM2
#define PROBE_CM2 0
#endif
#ifndef PROBE_XBAR
#define PROBE_XBAR 0
#endif
#ifndef MK_ONE_LAUNCH
#define MK_ONE_LAUNCH 1
#endif

#define GAS __attribute__((address_space(1)))
#define LAS __attribute__((address_space(3)))
typedef unsigned short bf16;
typedef short bf16x8 __attribute__((ext_vector_type(8)));
typedef float f32x4 __attribute__((ext_vector_type(4)));
typedef unsigned u32x4 __attribute__((ext_vector_type(4)));
typedef unsigned u32x2 __attribute__((ext_vector_type(2)));
#define RLX_AGENT __ATOMIC_RELAXED, __HIP_MEMORY_SCOPE_AGENT
#define LDS_WAIT() asm volatile("s_waitcnt lgkmcnt(0)" ::: "memory")
#define LBAR() do { asm volatile("s_waitcnt lgkmcnt(0)" ::: "memory"); __builtin_amdgcn_s_barrier(); asm volatile("" ::: "memory"); } while (0)

constexpr int D = 2048, NBATCH = 4, SEQ = 4096, T = NBATCH * SEQ, CTX = 256, TC = NBATCH * CTX, MR = T + TC;
constexpr int DIN = 5152, NP = 5120;
constexpr int C_U = 0, C_V = 1024, C_Q = 2048, C_K = 2560, C_VG = 3072, C_GO = 4096;
constexpr int NE = 32, NSLOTMAX = 73728;
constexpr float ALPHA = 1.189207115002721f;
constexpr float LN_EPS = 1e-5f, RMS_EPS = 1e-6f;
constexpr float YSC = 16.0f;
constexpr int NWAVES = 8, NTHREADS = 512;
constexpr int NPHASE = 11;
constexpr int NCVB = 32, CV_GU = 65536, CV_TOT = 98304, CV2 = 20480, CV2X = 4096, CV3 = 0, CV4 = 24576, CV5 = 1536, CV_P0 = CV_GU - CV2 - CV2X - CV3 - CV4 - CV5;

constexpr size_t MiB = 1u << 20;
constexpr size_t WS_CTL = 0, CTL_BYTES = 1 * MiB;
constexpr size_t WS_MOD = 1 * MiB;
constexpr size_t WS_WIN = 4 * MiB;
constexpr size_t WS_WOUT = 26 * MiB;
constexpr size_t WS_WGU = 64 * MiB;
constexpr size_t WS_WDN = 576 * MiB;
constexpr size_t WS_HN = 832 * MiB;
constexpr size_t WS_HM = 900 * MiB;
constexpr size_t WS_P = 968 * MiB;
constexpr size_t WS_LR = 1138 * MiB;
constexpr size_t WS_ACAT = 1142 * MiB;
constexpr size_t WS_OF = 1206 * MiB;
constexpr size_t WS_OB = 1270 * MiB;
constexpr size_t WS_Z = 1334 * MiB;
constexpr size_t WS_H1 = 1462 * MiB;
constexpr size_t WS_HM2 = 1526 * MiB;
constexpr size_t WS_TOPW = 1590 * MiB;
constexpr size_t WS_TOPEP = 1591 * MiB;
constexpr size_t WS_LIST = 1592 * MiB;
constexpr size_t WS_ACT = 1594 * MiB;
constexpr size_t WS_YB = 1882 * MiB;
constexpr size_t WS_HM2LO = 2138 * MiB;
constexpr size_t WS_HM2F8 = 2202 * MiB;
constexpr size_t WS_END = 2234 * MiB;
constexpr int CW_CNT = 1024;
constexpr int CW_MODCNT = 3584;
constexpr int CW_BAR = 4096;

constexpr int LDS_BYTES = 163840;
constexpr int MISC_OFF = 135168 + 320;
constexpr int TBL_OFF = 135168 + 1024;
constexpr int EPT_OFF = 135168 + 2048;
constexpr int EPT_RL = 21, EPT_UNITS9 = 9;

typedef __bf16 bf16v2 __attribute__((ext_vector_type(2)));
typedef float f32v2 __attribute__((ext_vector_type(2)));
__device__ __forceinline__ unsigned pk2(float lo, float hi) { const f32v2 v = {lo, hi}; return __builtin_bit_cast(unsigned, __builtin_convertvector(v, bf16v2)); }
__device__ __forceinline__ unsigned f2bf(float f) { return pk2(f, 0.f) & 0xffffu; }
__device__ __forceinline__ float bf2f(unsigned b) { return __builtin_bit_cast(float, b << 16); }
__device__ __forceinline__ float bflo(unsigned w) { return __builtin_bit_cast(float, w << 16); }
__device__ __forceinline__ float bfhi(unsigned w) { return __builtin_bit_cast(float, w & 0xffff0000u); }
__device__ __forceinline__ float wave_sum(float v) {
#pragma unroll
    for (int o = 1; o < 64; o <<= 1) v += __shfl_xor(v, o);
    return v;
}
__device__ __forceinline__ float wave_max(float v) {
#pragma unroll
    for (int o = 1; o < 64; o <<= 1) v = fmaxf(v, __shfl_xor(v, o));
    return v;
}
__device__ __forceinline__ float gelu_exact(float x) { return 0.5f * x * (1.0f + erff(x * 0.70710678118654752f)); }
__device__ __forceinline__ float siluf(float x) { return x / (1.0f + expf(-x)); }
__device__ __forceinline__ float logsigmoidf(float x) { return fminf(x, 0.f) - log1pf(expf(-fabsf(x))); }

__device__ __forceinline__ unsigned lds_rd_u16(unsigned addr) { unsigned v; asm volatile("ds_read_u16 %0, %1\n\ts_waitcnt lgkmcnt(0)" : "=v"(v) : "v"(addr) : "memory"); return v; }
__device__ __forceinline__ int lds_rd_b32(unsigned addr) { int v; asm volatile("ds_read_b32 %0, %1\n\ts_waitcnt lgkmcnt(0)" : "=v"(v) : "v"(addr) : "memory"); return v; }
__device__ __forceinline__ f32x4 lds_rd_b128(unsigned addr) { f32x4 v; asm volatile("ds_read_b128 %0, %1\n\ts_waitcnt lgkmcnt(0)" : "=v"(v) : "v"(addr) : "memory"); return v; }
#define XB_TMO      128
#define XB_XCNT(j)  (256  + 64 * (j))
#define XB_XSUB(j)  (1280 + 64 * (j))
#define XB_XGEN(j)  (2304 + 64 * (j))
#define XB_TOP      3328
#define XB_TOPGEN   3392
#define XCD_BAR_WORDS 3456
#define XB_SPIN_CAP (1u << 18)
__device__ __forceinline__ unsigned xb_ld(unsigned* p)              { return __hip_atomic_load(p, __ATOMIC_RELAXED, __HIP_MEMORY_SCOPE_AGENT); }
__device__ __forceinline__ unsigned xb_add(unsigned* p, unsigned v) { return __hip_atomic_fetch_add(p, v, __ATOMIC_RELAXED, __HIP_MEMORY_SCOPE_AGENT); }
__device__ __forceinline__ unsigned xb_xcc_id() { return (unsigned)__builtin_amdgcn_s_getreg((3 << 11) | 20) & 0xFu; }
#define XB_SPIN(cond, bar) do { unsigned _sp = 0; while (cond) { __builtin_amdgcn_s_sleep(1); \
    if ((++_sp & 255u) == 0u) { if (xb_ld(&(bar)[XB_TMO])) break; if (_sp > XB_SPIN_CAP) { atomicAdd(&(bar)[XB_TMO], 1u); break; } } } } while (0)
struct XcdBarrier { unsigned* bar; unsigned x; volatile LAS unsigned* st; };
__device__ __forceinline__ XcdBarrier xcd_barrier_post(unsigned* bar, volatile LAS unsigned* st) {
    XcdBarrier b; b.bar = bar; b.x = xb_xcc_id(); b.st = st;
    if (threadIdx.x == 0) (void)xb_add(&bar[XB_XCNT(b.x)], 1u);
    return b;
}
__device__ __forceinline__ void xcd_barrier_complete(unsigned* bar, unsigned x, unsigned& nloc, unsigned& nx) {
    const unsigned G = gridDim.x * gridDim.y * gridDim.z;
    unsigned sum, cnt, mine, sp = 0u;
    for (;;) {
        sum = 0u; cnt = 0u; mine = 0u;
#pragma unroll
        for (unsigned j = 0; j < 16; ++j) { const unsigned c = xb_ld(&bar[XB_XCNT(j)]); sum += c; cnt += (c > 0u) ? 1u : 0u; mine = (j == x) ? c : mine; }
        if (sum == G) break;
        __builtin_amdgcn_s_sleep(1);
        if ((++sp & 255u) == 0u) { if (xb_ld(&bar[XB_TMO])) break; if (sp > XB_SPIN_CAP) { atomicAdd(&bar[XB_TMO], 1u); break; } }
    }
    nloc = mine > 0u ? mine : 1u; nx = cnt > 0u ? cnt : 1u;
}
__device__ __forceinline__ void xcd_barrier(const XcdBarrier& b) {
    asm volatile("s_waitcnt vmcnt(0)" ::: "memory");
    __syncthreads();
    if (threadIdx.x == 0) {
        unsigned* bar = b.bar;
        __builtin_amdgcn_s_waitcnt(0);
        unsigned nloc = b.st[0], nx = b.st[1];
        if (nloc == 0u) { xcd_barrier_complete(bar, b.x, nloc, nx); b.st[0] = nloc; b.st[1] = nx; }
        const unsigned old = xb_add(&bar[XB_XSUB(b.x)], 1u);
        const unsigned gen = old / nloc;
        if (old + 1u == (gen + 1u) * nloc) {
            __builtin_amdgcn_fence(__ATOMIC_RELEASE, "agent");
            asm volatile("s_waitcnt vmcnt(0)" ::: "memory");
            const unsigned og = xb_add(&bar[XB_TOP], 1u);
            const unsigned tg = og / nx;
            if (og + 1u == (tg + 1u) * nx) xb_add(&bar[XB_TOPGEN], 1u);
            else XB_SPIN(xb_ld(&bar[XB_TOPGEN]) == tg, bar);
            __builtin_amdgcn_fence(__ATOMIC_ACQUIRE, "agent");
            xb_add(&bar[XB_XGEN(b.x)], 1u);
            asm volatile("s_waitcnt vmcnt(0)" ::: "memory");
        } else {
            XB_SPIN(xb_ld(&bar[XB_XGEN(b.x)]) == gen, bar);
            __builtin_amdgcn_fence(__ATOMIC_ACQUIRE, "agent");
            asm volatile("s_waitcnt vmcnt(0)" ::: "memory");
        }
    }
    __syncthreads();
}

template <int NB, class AR, class BR, class EP>
__device__ __forceinline__ void wave_gemm32(const AR& arow, const BR& brow, const EP& epi, int K, int lane) {
    const int r = lane & 15, kq = lane >> 4;
    const bf16* a[2]; const bf16* b[NB][2];
#pragma unroll
    for (int m = 0; m < 2; ++m) a[m] = arow(16 * m + r) + 8 * kq;
#pragma unroll
    for (int w = 0; w < NB; ++w)
#pragma unroll
        for (int n = 0; n < 2; ++n) b[w][n] = brow(16 * n + r, w) + 8 * kq;
    f32x4 acc[NB][2][2];
#pragma unroll
    for (int w = 0; w < NB; ++w)
#pragma unroll
        for (int m = 0; m < 2; ++m)
#pragma unroll
            for (int n = 0; n < 2; ++n) acc[w][m][n] = (f32x4){0.f, 0.f, 0.f, 0.f};
#pragma unroll 8
    for (int k = 0; k < K; k += 32) {
        bf16x8 af[2], bfr[NB][2];
#pragma unroll
        for (int m = 0; m < 2; ++m) af[m] = *(const bf16x8*)(a[m] + k);
#pragma unroll
        for (int w = 0; w < NB; ++w)
#pragma unroll
            for (int n = 0; n < 2; ++n) bfr[w][n] = *(const bf16x8*)(b[w][n] + k);
#pragma unroll
        for (int w = 0; w < NB; ++w)
#pragma unroll
            for (int m = 0; m < 2; ++m)
#pragma unroll
                for (int n = 0; n < 2; ++n) acc[w][m][n] = __builtin_amdgcn_mfma_f32_16x16x32_bf16(af[m], bfr[w][n], acc[w][m][n], 0, 0, 0);
    }
#pragma unroll
    for (int m = 0; m < 2; ++m)
#pragma unroll
        for (int n = 0; n < 2; ++n)
#pragma unroll
            for (int q = 0; q < 4; ++q) epi(16 * m + 4 * kq + q, 16 * n + r, acc[0][m][n][q], NB == 2 ? acc[NB - 1][m][n][q] : 0.f);
}

__device__ __forceinline__ void transpose_item(const float* W, int K, int N, bf16* WT, int k0, int n0, int r0, LAS float* scr, int lane) {
#pragma unroll
    for (int i = 0; i < 32; ++i) { const int kk = 2 * i + (lane >> 5); scr[kk * 33 + (lane & 31)] = W[(size_t)(k0 + kk) * N + n0 + (lane & 31)]; }
    LDS_WAIT();
    const int c = lane & 7;
#pragma unroll
    for (int j = 0; j < 4; ++j) { const int n = (lane >> 3) + 8 * j; const LAS float* s = scr + (8 * c) * 33 + n;
        u32x4 o; o.x = pk2(s[0 * 33], s[1 * 33]); o.y = pk2(s[2 * 33], s[3 * 33]); o.z = pk2(s[4 * 33], s[5 * 33]); o.w = pk2(s[6 * 33], s[7 * 33]);
        *(u32x4*)(WT + (size_t)(r0 + n) * K + k0 + 8 * c) = o; }
    LDS_WAIT();
}

namespace pg8 {
typedef unsigned short bf16_t;
constexpr int BM = 256, BK = 64, HALF = 128, HTB = HALF * BK * 2, STAGE_BYTES = 8 * HTB, NXCD = 8;
__device__ __forceinline__ int lds_byte(int r, int c) { const int st = (r >> 4) * 2 + (c >> 5), rr = r & 15, cc = c & 31, ob = rr * 64 + cc * 2; return st * 1024 + (ob ^ (((ob >> 9) & 1) << 5)); }
__device__ __forceinline__ void stage_rc(int b, int& R, int& C) { const int st = b / 1024, sb = b % 1024, swz = sb ^ (((sb >> 9) & 1) << 5); R = (st >> 1) * 16 + swz / 64; C = (st & 1) * 32 + (swz % 64) / 2; }
__device__ __forceinline__ int perm32(int rho) { const int n = rho >> 4, i = rho & 15; return 8 * (i >> 2) + 4 * n + (i & 3); }
struct Unit { int pm, pn, e, mt, nv, ord; };
__device__ __forceinline__ unsigned cvt_pk_bf16(float lo, float hi) { unsigned r; asm volatile("v_cvt_pk_bf16_f32 %0, %1, %2" : "=v"(r) : "v"(lo), "v"(hi)); return r; }
typedef float f32x2 __attribute__((ext_vector_type(2)));
__device__ __forceinline__ f32x2 gelu_pk(f32x2 v) {
    const f32x2 av = __builtin_elementwise_abs(v), d = av * 0.2316418882f + 1.0f;
    f32x2 t; t.x = __builtin_amdgcn_rcpf(d.x); t.y = __builtin_amdgcn_rcpf(d.y);
    f32x2 q = t * 0.5307027145f + (-0.7265760135f); q = q * t + 0.7107068705f; q = q * t + (-0.142248368f); q = q * t + 0.127414796f; q = q * t;
    const f32x2 s = (v * v) * (-0.72134752044f);
    f32x2 e; e.x = __builtin_amdgcn_exp2f(s.x); e.y = __builtin_amdgcn_exp2f(s.y);
    const f32x2 m = v * (q * e), r = v - m;
    f32x2 o; o.x = v.x < 0.f ? m.x : r.x; o.y = v.y < 0.f ? m.y : r.y; return o;
}
typedef int i32x8 __attribute__((ext_vector_type(8)));
typedef int i32x4 __attribute__((ext_vector_type(4)));
template <class Epi, class Sched, int ESZ = 2>
__device__ __forceinline__ void gemm_phase(LAS unsigned char* lds, const void* A, int K, const Sched& S, const Epi& E) {
    const int tid = threadIdx.x, wid = __builtin_amdgcn_readfirstlane(tid >> 6), lane = tid & 63, wr = wid >> 2, wc = wid & 3, fr = lane & 15, fq = lane >> 4;
    const int rowb = K * ESZ, nt = rowb / 128;
    unsigned voffB[2];
#pragma unroll
    for (int i = 0; i < 2; ++i) { int R, C; stage_rc(tid * 16 + i * 8192, R, C); const int Rb = Epi::PERM ? ((R & ~31) + perm32(R & 31)) : R; voffB[i] = (unsigned)(Rb * rowb + C * 2); }
    const size_t kstep = (size_t)128;
    const size_t hstep = (size_t)HALF * rowb;
    const unsigned ldsw = (unsigned)wid * 1024u;
    const int aoff = lds_byte(wr * 64 + fr, fq * 8), boff = lds_byte(wc * 32 + fr, fq * 8);
#define PG8_SA(b, h) (((b) * 2 + (h)) * HTB)
#define PG8_SB(b, h) ((4 + (b) * 2 + (h)) * HTB)
#define PG8_STAGE(bufoff, gbase, voff) do { _Pragma("unroll") for (int _i = 0; _i < 2; ++_i) \
        __builtin_amdgcn_global_load_lds((const unsigned*)((const char*)(gbase) + (voff)[_i]), (LAS unsigned*)(lds + (bufoff) + ldsw + _i * 8192), 16, 0, 0); } while (0)
#define PG8_LDA(dst, b, h) do { _Pragma("unroll") for (int m = 0; m < 4; ++m) _Pragma("unroll") for (int k = 0; k < 2; ++k) dst[m][k] = *(const LAS bf16x8*)(lds + PG8_SA(b, h) + aoff + m * 2048 + k * 1024); } while (0)
#define PG8_LDB(dst, b, h) do { _Pragma("unroll") for (int n = 0; n < 2; ++n) _Pragma("unroll") for (int k = 0; k < 2; ++k) dst[n][k] = *(const LAS bf16x8*)(lds + PG8_SB(b, h) + boff + n * 2048 + k * 1024); } while (0)
#define PG8_CAT(x) __builtin_shufflevector(__builtin_bit_cast(i32x4, x[0]), __builtin_bit_cast(i32x4, x[1]), 0, 1, 2, 3, 4, 5, 6, 7)
#define PG8_MMA(ai, bj, At, Bt) do { __builtin_amdgcn_s_setprio(1); if constexpr (ESZ == 2) { _Pragma("unroll") for (int m = 0; m < 4; ++m) _Pragma("unroll") for (int n = 0; n < 2; ++n) _Pragma("unroll") for (int k = 0; k < 2; ++k) \
        acc[ai][bj][m][n] = __builtin_amdgcn_mfma_f32_16x16x32_bf16(Bt[n][k], At[m][k], acc[ai][bj][m][n], 0, 0, 0); } else { _Pragma("unroll") for (int m = 0; m < 4; ++m) _Pragma("unroll") for (int n = 0; n < 2; ++n) \
        acc[ai][bj][m][n] = __builtin_amdgcn_mfma_scale_f32_16x16x128_f8f6f4(PG8_CAT(Bt[n]), PG8_CAT(At[m]), acc[ai][bj][m][n], 0, 0, 0, 0x77777777, 0, 0x7f7f7f7f); } __builtin_amdgcn_s_setprio(0); } while (0)
#define PG8_WAIT_V(n) asm volatile("s_waitcnt vmcnt(" #n ")" ::: "memory")
#define PG8_WAIT_L(n) asm volatile("s_waitcnt lgkmcnt(" #n ")" ::: "memory")
#define PG8_BAR __builtin_amdgcn_s_barrier()
#define PG8_SCHED __builtin_amdgcn_sched_barrier(0)
#define PG8_ROWS(dst, u) do { int _t = threadIdx.x; asm volatile("" : "+v"(_t)); _Pragma("unroll") for (int _i = 0; _i < 2; ++_i) { int _R, _C; stage_rc(_t * 16 + _i * 8192, _R, _C); \
        _Pragma("unroll") for (int _h = 0; _h < 2; ++_h) dst[_h][_i] = (unsigned)(S.a_row(u, _h * HALF + _R) * rowb + _C * 2); } } while (0)
    Unit cur, nxt; int ui = 0;
    if (!S.next(0, cur)) return;
    f32x4 acc[2][2][4][2];
#pragma unroll
    for (int a = 0; a < 2; ++a)
#pragma unroll
        for (int b = 0; b < 2; ++b)
#pragma unroll
            for (int m = 0; m < 4; ++m)
#pragma unroll
                for (int n = 0; n < 2; ++n) acc[a][b][m][n] = (f32x4){0.f, 0.f, 0.f, 0.f};
    bf16x8 At[4][2], B0[2][2], B1[2][2];
    unsigned va[2][2], vn[2][2];
    PG8_ROWS(va, cur);
    const char* cA = (const char*)A; const char* cB = S.b_base(cur);
    PG8_WAIT_V(0);
    PG8_STAGE(PG8_SB(0, 0), cB, voffB); PG8_STAGE(PG8_SB(0, 1), cB + hstep, voffB); PG8_STAGE(PG8_SA(0, 0), cA, va[0]); PG8_STAGE(PG8_SA(0, 1), cA, va[1]);
    if (wr == 1) PG8_BAR;
    PG8_WAIT_V(2); PG8_BAR;
    PG8_STAGE(PG8_SB(1, 0), cB + kstep, voffB); PG8_STAGE(PG8_SA(1, 0), cA + kstep, va[0]); PG8_STAGE(PG8_SB(1, 1), cB + hstep + kstep, voffB);
    PG8_WAIT_V(6); PG8_BAR;
    for (;;) {
        const bool has_next = S.next(ui + 1, nxt);
        if (has_next) { PG8_ROWS(vn, nxt); }
        else {
#pragma unroll
            for (int h = 0; h < 2; ++h)
#pragma unroll
                for (int i = 0; i < 2; ++i) vn[h][i] = va[h][i]; }
        const char* nB = has_next ? S.b_base(nxt) : cB;
        for (int t = 0; t < nt; t += 2) {
            const bool last = (t == nt - 2);
            const char* a1 = cA + (size_t)(t + 1) * kstep;
            const char* a2 = last ? cA : cA + (size_t)(t + 2) * kstep; const char* b2 = last ? nB : cB + (size_t)(t + 2) * kstep;
            const char* a3 = a2 + kstep; const char* b3 = b2 + kstep;
            PG8_LDB(B0, 0, 0); PG8_LDB(B1, 0, 1); PG8_SCHED; PG8_LDA(At, 0, 0); PG8_STAGE(PG8_SA(1, 1), a1, va[1]);
            if (last) {
#pragma unroll
                for (int h = 0; h < 2; ++h)
#pragma unroll
                    for (int i = 0; i < 2; ++i) va[h][i] = vn[h][i]; }
            PG8_WAIT_V(8); PG8_WAIT_L(0); PG8_BAR; PG8_MMA(0, 0, At, B0); PG8_MMA(0, 1, At, B1); PG8_BAR; PG8_SCHED;
            PG8_LDA(At, 0, 1); PG8_STAGE(PG8_SB(0, 0), b2, voffB); PG8_STAGE(PG8_SB(0, 1), b2 + hstep, voffB); PG8_STAGE(PG8_SA(0, 0), a2, va[0]);
            PG8_WAIT_V(8); PG8_WAIT_L(0); PG8_BAR; PG8_MMA(1, 0, At, B0); PG8_MMA(1, 1, At, B1); PG8_BAR; PG8_SCHED;
            PG8_LDB(B0, 1, 0); PG8_LDB(B1, 1, 1); PG8_SCHED; PG8_LDA(At, 1, 0); PG8_STAGE(PG8_SA(0, 1), a2, va[1]);
            PG8_WAIT_V(8); PG8_WAIT_L(0); PG8_BAR; PG8_MMA(0, 0, At, B0); PG8_MMA(0, 1, At, B1); PG8_BAR; PG8_SCHED;
            PG8_LDA(At, 1, 1); PG8_STAGE(PG8_SB(1, 0), b3, voffB); PG8_STAGE(PG8_SB(1, 1), b3 + hstep, voffB); PG8_STAGE(PG8_SA(1, 0), a3, va[0]);
            PG8_WAIT_V(8); PG8_WAIT_L(0); PG8_BAR; PG8_MMA(1, 0, At, B0); PG8_MMA(1, 1, At, B1); PG8_BAR; PG8_SCHED;
        }
        if (wr == 0) PG8_BAR;
        E(acc, cur, wr, wc, fr, fq, ui);
        if (!has_next) break;
#pragma unroll
        for (int a = 0; a < 2; ++a)
#pragma unroll
            for (int b = 0; b < 2; ++b)
#pragma unroll
                for (int m = 0; m < 4; ++m)
#pragma unroll
                    for (int n = 0; n < 2; ++n) acc[a][b][m][n] = (f32x4){0.f, 0.f, 0.f, 0.f};
        cur = nxt; cB = nB; ++ui;
        if (wr == 1) PG8_BAR;
    }
    PG8_WAIT_V(0);
    PG8_BAR;
#undef PG8_SA
#undef PG8_SB
#undef PG8_STAGE
#undef PG8_LDA
#undef PG8_LDB
#undef PG8_MMA
#undef PG8_CAT
#undef PG8_WAIT_V
#undef PG8_WAIT_L
#undef PG8_BAR
#undef PG8_SCHED
#undef PG8_ROWS
}

struct DenseOrder {
    int nM, nN, nwg, G, c; const bf16_t* Bt; int K;
    __device__ __forceinline__ void init(int M, int N, int G_, int c_, const bf16_t* Bt_, int K_) { nM = M / BM; nN = N / BM; nwg = nM * nN; G = G_; c = c_; Bt = Bt_; K = K_; }
    __device__ __forceinline__ bool next(int i, Unit& u) const {
        const long L = (long)i * G + c; if (L >= nwg) return false;
        int wgid = (int)L; { const int q = nwg / NXCD, r = nwg % NXCD, xcd = wgid % NXCD, off = wgid / NXCD; wgid = (xcd < r ? xcd * (q + 1) : r * (q + 1) + (xcd - r) * q) + off; }
        const int nig = 8 * nN, gid = wgid / nig, fm = gid * 8, gsz = (nM - fm) < 8 ? (nM - fm) : 8;
        u.pm = fm + ((wgid % nig) % gsz); u.pn = (wgid % nig) / gsz; u.e = 0; u.mt = u.pm; u.nv = 256; u.ord = 0; return true;
    }
    __device__ __forceinline__ const char* b_base(const Unit& u) const { return (const char*)Bt + (size_t)u.pn * 256 * K * 2; }
    __device__ __forceinline__ int a_row(const Unit& u, int r) const { return u.pm * 256 + r; }
};
}

struct EpiInProj {
    static constexpr bool PERM = true;
    bf16* P;
    __device__ __forceinline__ void operator()(const f32x4 (&acc)[2][2][4][2], const pg8::Unit& u, int wr, int wc, int fr, int fq, int ui) const {
        asm volatile("" : "+v"(fr), "+v"(fq));
        const int row0 = u.pm * 256 + wr * 64 + fr, col0 = u.pn * 256 + wc * 32 + 8 * fq; const bool act = u.pn < 8;
#pragma unroll
        for (int ai = 0; ai < 2; ++ai)
#pragma unroll
            for (int m = 0; m < 4; ++m) { bf16* rowp = P + (size_t)(row0 + ai * 128 + m * 16) * NP + col0;
#pragma unroll
                for (int bj = 0; bj < 2; ++bj) { f32x4 v0 = acc[ai][bj][m][0], v1 = acc[ai][bj][m][1];
                    if (act) { pg8::f32x2 a = pg8::gelu_pk((pg8::f32x2){v0[0], v0[1]}), b = pg8::gelu_pk((pg8::f32x2){v0[2], v0[3]}), c = pg8::gelu_pk((pg8::f32x2){v1[0], v1[1]}), d = pg8::gelu_pk((pg8::f32x2){v1[2], v1[3]});
                        v0 = (f32x4){a.x, a.y, b.x, b.y}; v1 = (f32x4){c.x, c.y, d.x, d.y}; }
                    u32x4 w; w.x = pg8::cvt_pk_bf16(v0[0], v0[1]); w.y = pg8::cvt_pk_bf16(v0[2], v0[3]); w.z = pg8::cvt_pk_bf16(v1[0], v1[1]); w.w = pg8::cvt_pk_bf16(v1[2], v1[3]);
                    *(u32x4*)(rowp + bj * 128) = w; } }
    }
};
struct EpiOutProj {
    static constexpr bool PERM = true;
    bf16* Z; const bf16* HN; const float* MOD;
    __device__ __forceinline__ void operator()(const f32x4 (&acc)[2][2][4][2], const pg8::Unit& u, int wr, int wc, int fr, int fq, int ui) const {
        asm volatile("" : "+v"(fr), "+v"(fq));
        const int row0 = u.pm * 256 + wr * 64 + fr, col0 = u.pn * 256 + wc * 32 + 8 * fq;
        const float* g1 = MOD + ((u.pm * 256) / SEQ) * (6 * D) + 2 * D;
        f32x4 gv[2][2];
#pragma unroll
        for (int bj = 0; bj < 2; ++bj)
#pragma unroll
            for (int n = 0; n < 2; ++n) gv[bj][n] = *(const f32x4*)(g1 + col0 + bj * 128 + 4 * n);
#pragma unroll
        for (int ai = 0; ai < 2; ++ai)
#pragma unroll
            for (int m = 0; m < 4; ++m) { const size_t ro = (size_t)(row0 + ai * 128 + m * 16) * D + col0;
#pragma unroll
                for (int bj = 0; bj < 2; ++bj) { const u32x4 h = *(const u32x4*)(HN + ro + bj * 128); const f32x4 a0 = acc[ai][bj][m][0], a1 = acc[ai][bj][m][1], g0 = gv[bj][0], g1v = gv[bj][1];
                    u32x4 o; o.x = pk2(ALPHA * bflo(h.x) + g0.x * a0.x, ALPHA * bfhi(h.x) + g0.y * a0.y); o.y = pk2(ALPHA * bflo(h.y) + g0.z * a0.z, ALPHA * bfhi(h.y) + g0.w * a0.w);
                    o.z = pk2(ALPHA * bflo(h.z) + g1v.x * a1.x, ALPHA * bfhi(h.z) + g1v.y * a1.y); o.w = pk2(ALPHA * bflo(h.w) + g1v.z * a1.z, ALPHA * bfhi(h.w) + g1v.w * a1.w);
                    *(u32x4*)(Z + ro + bj * 128) = o; } }
    }
};
struct EpiGateUp {
    static constexpr bool PERM = true;
    unsigned char* ACT; const LAS bf16* BT;
    __device__ __forceinline__ void operator()(const f32x4 (&acc)[2][2][4][2], const pg8::Unit& u, int wr, int wc, int fr, int fq, int ui) const {
        asm volatile("" : "+v"(fr), "+v"(fq));
        const int j0 = u.pn * 128 + wc * 32 + 8 * fq;
        const unsigned bt = (unsigned)(size_t)BT + (unsigned)(ui * 256 + wc * 32 + 8 * fq) * 2u;
        const f32x4 rg = lds_rd_b128(bt), ru = lds_rd_b128(bt + 256);
        const u32x4 rgu = __builtin_bit_cast(u32x4, rg), ruu = __builtin_bit_cast(u32x4, ru);
        const f32x4 bg0 = {bflo(rgu.x), bfhi(rgu.x), bflo(rgu.y), bfhi(rgu.y)}, bg1 = {bflo(rgu.z), bfhi(rgu.z), bflo(rgu.w), bfhi(rgu.w)};
        const f32x4 bu0 = {bflo(ruu.x), bfhi(ruu.x), bflo(ruu.y), bfhi(ruu.y)}, bu1 = {bflo(ruu.z), bfhi(ruu.z), bflo(ruu.w), bfhi(ruu.w)};
#pragma unroll
        for (int ai = 0; ai < 2; ++ai)
#pragma unroll
            for (int m = 0; m < 4; ++m) { const int i = ai * 128 + wr * 64 + m * 16 + fr;
                f32x4 g0 = acc[ai][0][m][0] + bg0, g1 = acc[ai][0][m][1] + bg1, u0 = acc[ai][1][m][0] + bu0, u1 = acc[ai][1][m][1] + bu1; float r[8];
#pragma unroll
                for (int q = 0; q < 4; ++q) { float g = fminf(g0[q], 7.f), up = fminf(fmaxf(u0[q], -7.f), 7.f); r[q] = (up + 1.f) * g * __builtin_amdgcn_rcpf(1.f + __builtin_amdgcn_exp2f(-2.4554669595930156f * g));
                    g = fminf(g1[q], 7.f); up = fminf(fmaxf(u1[q], -7.f), 7.f); r[4 + q] = (up + 1.f) * g * __builtin_amdgcn_rcpf(1.f + __builtin_amdgcn_exp2f(-2.4554669595930156f * g)); }
                int w0 = __builtin_amdgcn_cvt_pk_fp8_f32(r[0], r[1], 0, false); w0 = __builtin_amdgcn_cvt_pk_fp8_f32(r[2], r[3], w0, true);
                int w1 = __builtin_amdgcn_cvt_pk_fp8_f32(r[4], r[5], 0, false); w1 = __builtin_amdgcn_cvt_pk_fp8_f32(r[6], r[7], w1, true);
                u32x2 w; w.x = (unsigned)w0; w.y = (unsigned)w1;
                if (i < u.nv) *(u32x2*)(ACT + ((size_t)u.pm * 256 + i) * D + j0) = w; }
    }
};
struct EpiDown {
    static constexpr bool PERM = true;
    unsigned char* YB; const LAS float* BT; const LAS int* LT;
    __device__ __forceinline__ void operator()(const f32x4 (&acc)[2][2][4][2], const pg8::Unit& u, int wr, int wc, int fr, int fq, int ui) const {
        asm volatile("" : "+v"(fr), "+v"(fq));
        const int col0 = u.pn * 256 + wc * 32 + 8 * fq;
        f32x4 bv[2][2];
#pragma unroll
        for (int bj = 0; bj < 2; ++bj)
#pragma unroll
            for (int n = 0; n < 2; ++n) bv[bj][n] = lds_rd_b128((unsigned)(size_t)BT + (unsigned)(ui * 256 + wc * 32 + 8 * fq + bj * 128 + 4 * n) * 4u);
#pragma unroll
        for (int ai = 0; ai < 2; ++ai)
#pragma unroll
            for (int m = 0; m < 4; ++m) { const int i = ai * 128 + wr * 64 + m * 16 + fr;
                if (i < u.nv) { const int flat = lds_rd_b32((unsigned)(size_t)LT + (unsigned)(ui * 256 + i) * 4u); unsigned char* rowp = YB + (size_t)flat * D + col0;
#pragma unroll
                    for (int bj = 0; bj < 2; ++bj) { const f32x4 v0 = (acc[ai][bj][m][0] + bv[bj][0]) * YSC, v1 = (acc[ai][bj][m][1] + bv[bj][1]) * YSC;
                        int w0 = __builtin_amdgcn_cvt_pk_fp8_f32(v0[0], v0[1], 0, false); w0 = __builtin_amdgcn_cvt_pk_fp8_f32(v0[2], v0[3], w0, true);
                        int w1 = __builtin_amdgcn_cvt_pk_fp8_f32(v1[0], v1[1], 0, false); w1 = __builtin_amdgcn_cvt_pk_fp8_f32(v1[2], v1[3], w1, true);
                        u32x2 w; w.x = (unsigned)w0; w.y = (unsigned)w1;
                        *(u32x2*)(rowp + bj * 128) = w; } } }
    }
};
struct InProjOrder {
    int G, c; const bf16* Bt;
    __device__ __forceinline__ bool next(int i, pg8::Unit& u) const {
        const int L = i * G + c; if (L >= 1304) return false;
        if (L < 1280) { int wgid = L; { const int q = 1280 / 8, xcd = wgid % 8, off = wgid / 8; wgid = xcd * q + off; }
            const int nig = 8 * 20, gid = wgid / nig, fm = gid * 8; u.pm = fm + ((wgid % nig) % 8); u.pn = (wgid % nig) / 8; }
        else { const int j = L - 1280; u.pm = 64 + j / 6; u.pn = 10 + j % 6; }
        u.e = 0; u.mt = u.pm; u.nv = 256; u.ord = 0; return true;
    }
    __device__ __forceinline__ const char* b_base(const pg8::Unit& u) const { return (const char*)Bt + (size_t)u.pn * 256 * D * 2; }
    __device__ __forceinline__ int a_row(const pg8::Unit& u, int r) const { return u.pm * 256 + r; }
};
template <bool GATHER> struct MoeOrder {
    const LAS int* tb; const LAS int* cn; int NT, G, c; const void* Bt; size_t estride; const int* LIST; int rowb;
    const LAS int* UT;
    const LAS unsigned short* RL;
    __device__ __forceinline__ bool search(int i, pg8::Unit& u) const {
        const int nwg = tb[NE] * NT; const long L = (long)i * G + c; if (L >= nwg) return false;
        int v = (int)L; { const int q = nwg / 8, r = nwg % 8, xcd = v % 8, off = v / 8; v = (xcd < r ? xcd * (q + 1) : r * (q + 1) + (xcd - r) * q) + off; }
        int e = 0; while (v >= tb[e + 1] * NT) ++e;
        const int local = v - tb[e] * NT, mte = tb[e + 1] - tb[e];
        u.e = e; u.mt = local % mte; u.pn = local / mte; u.pm = tb[e] + u.mt; const int rem = cn[e] - u.mt * 256; u.nv = rem < 256 ? rem : 256; return true;
    }
    __device__ __forceinline__ void build(LAS int* ut, int tid) const {
        if (tid < 32) { pg8::Unit u; const bool ok = search(tid, u); ut[4 * tid] = ok ? u.e : -1; ut[4 * tid + 1] = u.mt; ut[4 * tid + 2] = u.pn; ut[4 * tid + 3] = u.nv; }
    }
    int utv;
    int utp;
    __device__ __forceinline__ void pack(int lane) { const int l = lane & 31; const int e = UT[4 * l]; utv = e < 0 ? -1 : (e | (UT[4 * l + 2] << 5) | (UT[4 * l + 1] << 9) | (UT[4 * l + 3] << 16)); utp = e < 0 ? 0 : tb[e] + UT[4 * l + 1]; }
    __device__ __forceinline__ bool next(int i, pg8::Unit& u) const {
        if (i >= 32) return false;
        const int w = __builtin_amdgcn_readlane(utv, i); if (w < 0) return false;
        u.e = w & 31; u.pn = (w >> 5) & 15; u.mt = (w >> 9) & 127; u.nv = (w >> 16) & 511; u.pm = __builtin_amdgcn_readlane(utp, i); u.ord = i; return true;
    }
    __device__ __forceinline__ const char* b_base(const pg8::Unit& u) const { return (const char*)Bt + (size_t)u.e * estride + (size_t)u.pn * 256 * rowb; }
    __device__ __forceinline__ int a_row(const pg8::Unit& u, int r) const {
        if constexpr (GATHER) return (int)lds_rd_u16((unsigned)(size_t)RL + (unsigned)(u.ord * 256 + (r < u.nv ? r : 0)) * 2u);
        else return u.pm * 256 + r;
    }
};

__device__ __forceinline__ void item8_load(const float* W, int N, int k0, int n0, int lane, f32x4 (&rg)[16]) {
#pragma unroll
    for (int i = 0; i < 16; ++i) rg[i] = __builtin_nontemporal_load((const f32x4*)(W + (size_t)(k0 + 8 * i + (lane >> 3)) * N + n0 + 4 * (lane & 7)));
}
__device__ __forceinline__ void item8_finish(int K, unsigned char* WT, int k0, int r0, LAS float* scr, int lane, const f32x4 (&rg)[16]) {
#pragma unroll
    for (int i = 0; i < 16; ++i) { LAS float* d = scr + (8 * i + (lane >> 3)) * 33 + 4 * (lane & 7); d[0] = rg[i].x; d[1] = rg[i].y; d[2] = rg[i].z; d[3] = rg[i].w; }
    LDS_WAIT();
    const int c = lane & 7;
#pragma unroll
    for (int j = 0; j < 4; ++j) { const int n = (lane >> 3) + 8 * j; const LAS float* sp = scr + (16 * c) * 33 + n; int w[4];
#pragma unroll
        for (int q = 0; q < 4; ++q) { w[q] = __builtin_amdgcn_cvt_pk_fp8_f32(sp[(4 * q) * 33] * 256.f, sp[(4 * q + 1) * 33] * 256.f, 0, false); w[q] = __builtin_amdgcn_cvt_pk_fp8_f32(sp[(4 * q + 2) * 33] * 256.f, sp[(4 * q + 3) * 33] * 256.f, w[q], true); }
        u32x4 o; o.x = (unsigned)w[0]; o.y = (unsigned)w[1]; o.z = (unsigned)w[2]; o.w = (unsigned)w[3];
        *(u32x4*)(WT + (size_t)(r0 + n) * K + k0 + 16 * c) = o; }
    LDS_WAIT();
}

struct Args { const float* in[29]; float* out; unsigned char* ws; int ph_lo, ph_hi; };

__global__ void __launch_bounds__(NTHREADS, 2) fwd(Args args) {
    extern __shared__ __attribute__((aligned(16))) unsigned char lds_raw[];
    LAS unsigned char* lds = (LAS unsigned char*)lds_raw;
    volatile LAS unsigned* MISC = (volatile LAS unsigned*)(lds + MISC_OFF);
    const int tid = threadIdx.x, lane = tid & 63, wave = __builtin_amdgcn_readfirstlane(tid >> 6);
    const int G = gridDim.x, bid = blockIdx.x;
    const int gw = bid * NWAVES + wave, NGW = G * NWAVES;
    unsigned char* ws = args.ws;
    unsigned* ctl = (unsigned*)(ws + WS_CTL);
    const float* x = args.in[0]; const float* cvec = args.in[1]; const float* ctx = args.in[2]; const float* c_ctx = args.in[3];
    const float* ln_in_g = args.in[4]; const float* ln_in_b = args.in[5]; const float* w_ada = args.in[6]; const float* b_ada = args.in[7];
    const float* w_in = args.in[8]; const float* cm_norm_g = args.in[9]; const float* cm_norm_b = args.in[10]; const float* cm_w_s = args.in[11];
    const float* cm_b_s = args.in[12]; const float* wgk_f = args.in[13]; const float* bgk_f = args.in[14]; const float* wgk_b = args.in[15];
    const float* bgk_b = args.in[16]; const float* gla_norm_g = args.in[17]; const float* w_out = args.in[18]; const float* ln1_g = args.in[19];
    const float* ln1_b = args.in[20]; const float* w_router = args.in[21]; const float* b_router = args.in[22]; const float* w_gu = args.in[23];
    const float* b_gu = args.in[24]; const float* w_dn = args.in[25]; const float* b_dn = args.in[26]; const float* ln2_g = args.in[27]; const float* ln2_b = args.in[28];
    float* out = args.out;
    float* MOD = (float*)(ws + WS_MOD);
    bf16* WinT = (bf16*)(ws + WS_WIN); bf16* WoutT = (bf16*)(ws + WS_WOUT); unsigned char* WguT = (unsigned char*)(ws + WS_WGU); unsigned char* WdnT = (unsigned char*)(ws + WS_WDN);
    bf16* HN = (bf16*)(ws + WS_HN); bf16* HM = (bf16*)(ws + WS_HM); bf16* P = (bf16*)(ws + WS_P); float* LR = (float*)(ws + WS_LR);
    bf16* ACAT = (bf16*)(ws + WS_ACAT); float* OF = (float*)(ws + WS_OF); float* OB = (float*)(ws + WS_OB); bf16* Z = (bf16*)(ws + WS_Z);
    bf16* H1 = (bf16*)(ws + WS_H1); bf16* HM2 = (bf16*)(ws + WS_HM2); float* TOPW = (float*)(ws + WS_TOPW); unsigned* TOPEP = (unsigned*)(ws + WS_TOPEP);
    int* LIST = (int*)(ws + WS_LIST); unsigned char* ACT = (unsigned char*)(ws + WS_ACT); unsigned char* YB = ws + WS_YB;
    unsigned* CNT = ctl + CW_CNT;
    unsigned char* HM2F8 = ws + WS_HM2F8;
    bf16* HM2LO = (bf16*)(ws + WS_HM2LO); bf16* WRH = (bf16*)(ws + WS_MOD + 512 * 1024); bf16* WRL = (bf16*)(ws + WS_MOD + 640 * 1024);
    bf16* QEF = (bf16*)(ws + WS_ACT); bf16* QEB = (bf16*)(ws + WS_ACT + 18 * MiB); bf16* KDF = (bf16*)(ws + WS_ACT + 36 * MiB); bf16* KDB = (bf16*)(ws + WS_ACT + 54 * MiB);
    bf16* VTg = (bf16*)(ws + WS_ACT + 72 * MiB); float* DECF = (float*)(ws + WS_ACT + 108 * MiB); float* DECB = (float*)(ws + WS_ACT + 109 * MiB); float* OI = (float*)(ws + WS_ACT + 110 * MiB);

    for (int u = tid; u < (LDS_BYTES - 131072) / 4; u += NTHREADS) ((LAS unsigned*)(lds + 131072))[u] = 0u;
    LBAR();
    XcdBarrier bar; bar.bar = ctl + CW_BAR; bar.x = 0; bar.st = nullptr;
    if (MK_ONE_LAUNCH) bar = xcd_barrier_post(ctl + CW_BAR, MISC + 8);
    const int lo = args.ph_lo, hi = args.ph_hi;
#define IN(k) (lo <= (k) && (k) < hi)
#define SEAM(k) do { if (IN(k) && IN((k) + 1)) xcd_barrier(bar); } while (0)
#define MOE_LOAD(r_, RG) do { int rr_ = (r_); \
        if (rr_ < 65536) { const int e_ = rr_ / 2048, q_ = rr_ % 2048; item8_load(w_gu + (size_t)e_ * 2048 * 4096, 4096, 128 * (q_ / 128), 32 * (q_ % 128), lane, RG); } \
        else { rr_ -= 65536; const int e_ = rr_ / 1024, q_ = rr_ % 1024; item8_load(w_dn + (size_t)e_ * 2048 * 2048, D, 128 * (q_ / 64), 32 * (q_ % 64), lane, RG); } } while (0)
#define MOE_FIN(r_, RG) do { LAS float* scr_ = (LAS float*)(lds + wave * 16896); int rr_ = (r_); \
        if (rr_ < 65536) { const int e_ = rr_ / 2048, q_ = rr_ % 2048, n0_ = 32 * (q_ % 128), half_ = n0_ / 2048, j0_ = n0_ % 2048; \
            item8_finish(D, WguT + (size_t)e_ * 4096 * 2048, 128 * (q_ / 128), 256 * (j0_ / 128) + 128 * half_ + (j0_ % 128), scr_, lane, RG); } \
        else { rr_ -= 65536; const int e_ = rr_ / 1024, q_ = rr_ % 1024; item8_finish(D, WdnT + (size_t)e_ * 2048 * 2048, 128 * (q_ / 64), 32 * (q_ % 64), scr_, lane, RG); } } while (0)
#define MOE_RANGE(first_, end_, stride_) do { f32x4 rgA_[16], rgB_[16]; int ia_ = (first_); if (ia_ < (end_)) MOE_LOAD(ia_, rgA_); \
        while (ia_ < (end_)) { const int ib_ = ia_ + (stride_); if (ib_ < (end_)) MOE_LOAD(ib_, rgB_); MOE_FIN(ia_, rgA_); if (ib_ >= (end_)) break; \
            ia_ = ib_ + (stride_); if (ia_ < (end_)) MOE_LOAD(ia_, rgA_); MOE_FIN(ib_, rgB_); } } while (0)
    const int Gc = G - NCVB; const bool is_conv = bid >= Gc;
    const int NGWc = Gc * NWAVES;
#define CONV_SLICE(first_, count_) MOE_RANGE((first_) + (bid - Gc) * NWAVES + wave, (first_) + (count_), NCVB * NWAVES)

    if (IN(0)) {
        {
            LAS float* sc = (LAS float*)lds;
            LAS float* red = (LAS float*)(lds + 40960);
            if (bid < 192) {
                for (int i = tid; i < 5 * D; i += NTHREADS) { const int r = i / D, k = i % D; const float v = r < 4 ? cvec[r * D + k] : c_ctx[k]; sc[i] = siluf(v); }
                LBAR();
            }
            for (int u = bid; u < 192; u += G) {
                const int cg = tid & 15, kg = tid >> 4, n0 = u * 64 + cg * 4;
                float acc[5][4];
#pragma unroll
                for (int r = 0; r < 5; ++r)
#pragma unroll
                    for (int j = 0; j < 4; ++j) acc[r][j] = 0.f;
#pragma unroll 16
                for (int kk = 0; kk < 64; ++kk) { const int k = kg * 64 + kk; const f32x4 w = *(const f32x4*)(w_ada + (size_t)k * (6 * D) + n0);
#pragma unroll
                    for (int r = 0; r < 5; ++r) { const float s = sc[r * D + k]; acc[r][0] += s * w.x; acc[r][1] += s * w.y; acc[r][2] += s * w.z; acc[r][3] += s * w.w; } }
#pragma unroll
                for (int r = 0; r < 5; ++r)
#pragma unroll
                    for (int j = 0; j < 4; ++j) red[(kg * 5 + r) * 64 + cg * 4 + j] = acc[r][j];
                LBAR();
                if (tid < 320) { const int r = tid / 64, cidx = tid % 64; float s = 0.f;
                    for (int g2 = 0; g2 < 32; ++g2) s += red[(g2 * 5 + r) * 64 + cidx];
                    MOD[r * (6 * D) + u * 64 + cidx] = s + b_ada[u * 64 + cidx]; }
                LBAR();
            }
            LBAR();
            asm volatile("s_waitcnt vmcnt(0)" ::: "memory"); __syncthreads();
            if (tid == 0 && bid < 192) { __builtin_amdgcn_fence(__ATOMIC_RELEASE, "agent"); asm volatile("s_waitcnt vmcnt(0)" ::: "memory"); __hip_atomic_fetch_add(ctl + CW_MODCNT, 1u, RLX_AGENT); }
        }
        {
            LAS float* scr = (LAS float*)(lds + wave * 16896);
            constexpr int I_IN = 32 * 161, I_OUT = 32 * 64;
            for (int it = gw; it < I_IN + I_OUT; it += NGW) {
                int r = it;
                if (r < I_IN) { const int kb = r / 161, nb = r % 161; transpose_item(w_in, D, DIN, WinT, 64 * kb, 32 * nb, 32 * nb, scr, lane); continue; } r -= I_IN;
                { const int kb = r / 64, nb = r % 64; transpose_item(w_out, D, D, WoutT, 64 * kb, 32 * nb, 32 * nb, scr, lane); }
            }
            MOE_RANGE(gw, CV_P0, NGW);
        }
        for (int i = gw * 64 + lane; i < D * NE; i += NGW * 64) { const int k = i >> 5, e = i & 31; const float w = w_router[i]; const unsigned hi = f2bf(w); WRH[(size_t)e * D + k] = (bf16)hi; WRL[(size_t)e * D + k] = (bf16)f2bf(w - bf2f(hi)); }
        if (tid == 0) { const unsigned want = G < 192 ? (unsigned)G : 192u; unsigned sp = 0;
            while (__hip_atomic_load(ctl + CW_MODCNT, RLX_AGENT) < want) { __builtin_amdgcn_s_sleep(2); if (++sp > (1u << 22)) break; }
            __builtin_amdgcn_fence(__ATOMIC_ACQUIRE, "agent"); asm volatile("s_waitcnt vmcnt(0)" ::: "memory"); }
        __syncthreads();
        for (int m0 = gw; m0 < MR; m0 += 2 * NGW) {
            f32x4 vv[2][8];
#pragma unroll
            for (int t2 = 0; t2 < 2; ++t2) { const int m = (m0 + t2 * NGW) < MR ? m0 + t2 * NGW : m0; const float* xr = m < T ? x + (size_t)m * D : ctx + (size_t)(m - T) * D;
#pragma unroll
                for (int j = 0; j < 8; ++j) vv[t2][j] = *(const f32x4*)(xr + 4 * (lane + 64 * j)); }
#pragma unroll
            for (int t2 = 0; t2 < 2; ++t2) { const int m = m0 + t2 * NGW; if (m >= MR) break;
                const float* shp = MOD + (m < T ? m / SEQ : 4) * (6 * D); const float* scp = shp + D;
                f32x4 v[8]; float s = 0.f;
#pragma unroll
                for (int j = 0; j < 8; ++j) { v[j] = vv[t2][j]; s += (v[j].x + v[j].y) + (v[j].z + v[j].w); }
                const float mean = wave_sum(s) * (1.f / D); float s2 = 0.f;
#pragma unroll
                for (int j = 0; j < 8; ++j) { v[j] = v[j] - mean; s2 += (v[j].x * v[j].x + v[j].y * v[j].y) + (v[j].z * v[j].z + v[j].w * v[j].w); }
                const float rstd = 1.f / sqrtf(wave_sum(s2) * (1.f / D) + LN_EPS);
#pragma unroll
                for (int j = 0; j < 8; ++j) { const int c = 4 * (lane + 64 * j); const f32x4 g = *(const f32x4*)(ln_in_g + c), bb = *(const f32x4*)(ln_in_b + c);
                    f32x4 hh; hh.x = v[j].x * rstd * g.x + bb.x; hh.y = v[j].y * rstd * g.y + bb.y; hh.z = v[j].z * rstd * g.z + bb.z; hh.w = v[j].w * rstd * g.w + bb.w;
                    u32x2 o; o.x = pk2(hh.x, hh.y); o.y = pk2(hh.z, hh.w);
                    *(u32x2*)(HN + (size_t)m * D + c) = o;
                    const f32x4 s4 = *(const f32x4*)(shp + c), c4 = *(const f32x4*)(scp + c);
                    o.x = pk2(hh.x * (1.f + c4.x) + s4.x, hh.y * (1.f + c4.y) + s4.y); o.y = pk2(hh.z * (1.f + c4.z) + s4.z, hh.w * (1.f + c4.w) + s4.w);
                    *(u32x2*)(HM + (size_t)m * D + c) = o; }
            }
        }
    }
    SEAM(0);


    if (IN(2) && is_conv) CONV_SLICE(CV_P0, CV2);
    if (IN(2) && !is_conv) {
        for (int u = gw; u < MR / 32; u += NGWc) {
            const int row0 = u * 32;
            auto arow = [=](int i) { return HM + (size_t)(row0 + i) * D; };
            auto brow = [=](int j, int) { return WinT + (size_t)(NP + j) * D; };
            auto epi = [=](int i, int j, float v, float) { LR[(size_t)(row0 + i) * 32 + j] = v; };
            wave_gemm32<1>(arow, brow, epi, D, lane);
        }
        asm volatile("s_waitcnt vmcnt(0)" ::: "memory"); LBAR();
        InProjOrder S{Gc, bid, WinT};
        EpiInProj E{P};
        pg8::gemm_phase<EpiInProj, InProjOrder>(lds, HM, D, S, E);
        if (bid >= 1304 - 5 * Gc) MOE_RANGE(CV_P0 + CV2 + (bid - (1304 - 5 * Gc)) * NWAVES + wave, CV_P0 + CV2 + CV2X, (6 * Gc - 1304) * NWAVES);
    }
    SEAM(2);

    if (IN(3)) {
        LAS float* LRs = (LAS float*)lds;
        LAS float* PART = (LAS float*)(lds + 8192);
        LAS bf16* QEs = (LAS bf16*)(lds + 10240);
        LAS bf16* KEs = (LAS bf16*)(lds + 27648);
        LAS bf16* ATTs = (LAS bf16*)(lds + 45056);
        LAS bf16* VTs = (LAS bf16*)(lds + 54272);
        LAS bf16* Qs = (LAS bf16*)(lds + 91136);
        LAS bf16* Ks = (LAS bf16*)(lds + 108544);
        for (int u = bid; u < NBATCH * 68 * 4; u += G) {
            const int h = u & 3, bc = u >> 2, b = bc / 68, c = bc % 68; const bool lat = c >= 4;
            const int row0 = lat ? b * SEQ + (c - 4) * 64 : T + b * CTX + c * 64;
            const int d = tid & 127, tq = tid >> 7;
            const f32x4 lr4 = *(const f32x4*)(LR + (size_t)(row0 + (tid >> 3)) * 32 + (tid & 7) * 4);
            u32x4 vraw[4];
#pragma unroll
            for (int i = 0; i < 4; ++i) { const int ch = tid + 512 * i, sx = ch & 63, e8 = ch >> 6; vraw[i] = *(const u32x4*)(P + (size_t)(row0 + sx) * NP + C_VG + h * 256 + e8 * 8); }
            u32x4 qk4[4];
#pragma unroll
            for (int i = 0; i < 2; ++i) { const int ch = tid + 512 * i, t = ch >> 4, c16 = ch & 15; const bf16* pr = P + (size_t)(row0 + t) * NP + h * 128 + c16 * 8; qk4[i] = *(const u32x4*)(pr + C_Q); qk4[2 + i] = *(const u32x4*)(pr + C_K); }
            float wg[2][16], bias2[2];
#pragma unroll
            for (int r = 0; r < 16; ++r) { wg[0][r] = wgk_f[r * 512 + h * 128 + d]; wg[1][r] = wgk_b[r * 512 + h * 128 + d]; }
            bias2[0] = bgk_f[h * 128 + d]; bias2[1] = bgk_b[h * 128 + d];
            *(LAS f32x4*)(LRs + (tid >> 3) * 32 + (tid & 7) * 4) = lr4;
#pragma unroll
            for (int i = 0; i < 2; ++i) { const int ch = tid + 512 * i, t = ch >> 4, c16 = ch & 15; *(LAS u32x4*)(Qs + t * 136 + c16 * 8) = qk4[i]; *(LAS u32x4*)(Ks + t * 136 + c16 * 8) = qk4[2 + i]; }
#pragma unroll
            for (int i = 0; i < 4; ++i) { const int ch = tid + 512 * i, sx = ch & 63, e8 = ch >> 6; const unsigned ww[4] = {vraw[i].x, vraw[i].y, vraw[i].z, vraw[i].w};
#pragma unroll
                for (int j = 0; j < 4; ++j) { VTs[(e8 * 8 + 2 * j) * 72 + sx] = (bf16)(ww[j] & 0xffffu); VTs[(e8 * 8 + 2 * j + 1) * 72 + sx] = (bf16)(ww[j] >> 16); } }
            LBAR();
#pragma unroll
            for (int i = 0; i < 4; ++i) { const int ch = tid + 512 * i, e = ch >> 3, c8 = ch & 7; *(u32x4*)(VTg + ((size_t)u * 256 + e) * 64 + c8 * 8) = *(const LAS u32x4*)(VTs + e * 72 + c8 * 8); }
            bf16 qraw[16], kraw[16];
#pragma unroll
            for (int i = 0; i < 16; ++i) { qraw[i] = Qs[(16 * tq + i) * 136 + d]; kraw[i] = Ks[(16 * tq + i) * 136 + d]; }
            f32x4 att[2]; att[0] = (f32x4){0.f, 0.f, 0.f, 0.f}; att[1] = att[0];
#pragma unroll
            for (int dir = 0; dir < 2; ++dir) {
                bf16* QEg = dir ? QEB : QEF; bf16* KDg = dir ? KDB : KDF; float* DECg = dir ? DECB : DECF;
                const float (&w)[16] = wg[dir]; const float bias = bias2[dir];
                float cs[16];
#pragma unroll
                for (int i = 0; i < 16; ++i) { const LAS float* lr = LRs + (16 * tq + i) * 32 + dir * 16; float pre = bias;
#pragma unroll
                    for (int r4 = 0; r4 < 4; ++r4) { const f32x4 l4 = *(const LAS f32x4*)(lr + 4 * r4); pre += l4.x * w[4 * r4] + l4.y * w[4 * r4 + 1] + l4.z * w[4 * r4 + 2] + l4.w * w[4 * r4 + 3]; }
                    cs[i] = (fminf(pre, 0.f) - __logf(1.f + __expf(-fabsf(pre)))) * (1.f / 16.f); }
                if (dir == 0) {
#pragma unroll
                    for (int i = 1; i < 16; ++i) cs[i] += cs[i - 1];
                    PART[tq * 128 + d] = cs[15];
                } else {
#pragma unroll
                    for (int i = 14; i >= 0; --i) cs[i] += cs[i + 1];
                    PART[tq * 128 + d] = cs[0];
                }
                LBAR();
                const float p0 = PART[d], p1 = PART[128 + d], p2 = PART[256 + d], p3 = PART[384 + d]; const float blast = (p0 + p1) + (p2 + p3);
                float off;
                if (dir == 0) off = (tq > 0 ? p0 : 0.f) + (tq > 1 ? p1 : 0.f) + (tq > 2 ? p2 : 0.f);
                else off = (tq < 3 ? p3 : 0.f) + (tq < 2 ? p2 : 0.f) + (tq < 1 ? p1 : 0.f);
                unsigned kdp[8];
#pragma unroll
                for (int i = 0; i < 16; ++i) { const int t = 16 * tq + i; const float bcm = off + cs[i];
                    const float q = bf2f(qraw[i]) * 0.08838834764831845f, k = bf2f(kraw[i]);
                    const unsigned qe = f2bf(q * __expf(bcm)), ke = f2bf(k * __expf(-bcm)), kd = f2bf(k * __expf(blast - bcm));
                    QEs[t * 136 + d] = (bf16)qe; KEs[t * 136 + d] = (bf16)ke;
                    if (i & 1) kdp[i >> 1] |= kd << 16; else kdp[i >> 1] = kd; }
                { u32x4 k0, k1; k0.x = kdp[0]; k0.y = kdp[1]; k0.z = kdp[2]; k0.w = kdp[3]; k1.x = kdp[4]; k1.y = kdp[5]; k1.z = kdp[6]; k1.w = kdp[7];
                  bf16* kr = KDg + ((size_t)u * 128 + d) * 64 + 16 * tq; *(u32x4*)kr = k0; *(u32x4*)(kr + 8) = k1; }
                if (tq == 0) DECg[(size_t)u * 128 + d] = expf(blast);
                LBAR();
                if (lat) {
#pragma unroll
                    for (int i = 0; i < 2; ++i) { const int ch = tid + 512 * i, t = ch >> 4, c8 = ch & 15, g16 = c8 >> 1, hh2 = c8 & 1;
                        const u32x2 lo = *(const LAS u32x2*)(QEs + t * 136 + 16 * g16 + 4 * hh2), hi = *(const LAS u32x2*)(QEs + t * 136 + 16 * g16 + 8 + 4 * hh2);
                        u32x4 o; o.x = lo.x; o.y = lo.y; o.z = hi.x; o.w = hi.y; *(u32x4*)(QEg + ((size_t)u * 64 + t) * 128 + c8 * 8) = o; }
                    const int tr = wave >> 1, tc0 = 2 * (wave & 1), r16 = lane & 15, q4 = lane >> 4;
                    f32x4 tmp[2]; tmp[0] = (f32x4){0.f, 0.f, 0.f, 0.f}; tmp[1] = tmp[0];
#pragma unroll
                    for (int ks = 0; ks < 4; ++ks) { const bf16x8 a = *(const LAS bf16x8*)(QEs + (16 * tr + r16) * 136 + 32 * ks + 8 * q4);
#pragma unroll
                        for (int n = 0; n < 2; ++n) { const bf16x8 bb = *(const LAS bf16x8*)(KEs + (16 * (tc0 + n) + r16) * 136 + 32 * ks + 8 * q4);
                            tmp[n] = __builtin_amdgcn_mfma_f32_16x16x32_bf16(a, bb, tmp[n], 0, 0, 0); } }
#pragma unroll
                    for (int n = 0; n < 2; ++n)
#pragma unroll
                        for (int rg = 0; rg < 4; ++rg) { const int t = 16 * tr + 4 * q4 + rg, sx = 16 * (tc0 + n) + r16; const bool keep = dir == 0 ? sx <= t : sx >= t; att[n][rg] += keep ? tmp[n][rg] : 0.f; }
                }
                LBAR();
            }
            if (lat) {
                { const int tr = wave >> 1, tc0 = 2 * (wave & 1), r16 = lane & 15, q4 = lane >> 4;
#pragma unroll
                  for (int n = 0; n < 2; ++n)
#pragma unroll
                      for (int rg = 0; rg < 4; ++rg) ATTs[(16 * tr + 4 * q4 + rg) * 72 + 16 * (tc0 + n) + r16] = (bf16)f2bf(att[n][rg]); }
                LBAR();
                const int r16 = lane & 15, q4 = lane >> 4;
                f32x4 oa[4][2];
#pragma unroll
                for (int tr = 0; tr < 4; ++tr) { oa[tr][0] = (f32x4){0.f, 0.f, 0.f, 0.f}; oa[tr][1] = oa[tr][0]; }
#pragma unroll
                for (int ks = 0; ks < 2; ++ks) { bf16x8 bb[2];
#pragma unroll
                    for (int n = 0; n < 2; ++n) bb[n] = *(const LAS bf16x8*)(VTs + (16 * (2 * wave + n) + r16) * 72 + 32 * ks + 8 * q4);
#pragma unroll
                    for (int tr = 0; tr < 4; ++tr) { const bf16x8 a = *(const LAS bf16x8*)(ATTs + (16 * tr + r16) * 72 + 32 * ks + 8 * q4);
#pragma unroll
                        for (int n = 0; n < 2; ++n) oa[tr][n] = __builtin_amdgcn_mfma_f32_16x16x32_bf16(a, bb[n], oa[tr][n], 0, 0, 0); } }
#pragma unroll
                for (int tr = 0; tr < 4; ++tr)
#pragma unroll
                    for (int n = 0; n < 2; ++n)
#pragma unroll
                        for (int rg = 0; rg < 4; ++rg) OI[(size_t)(row0 + 16 * tr + 4 * q4 + rg) * 1024 + h * 256 + 16 * (2 * wave + n) + r16] = oa[tr][n][rg];
            }
            LBAR();
        }
            LAS float* stat = (LAS float*)lds;
            LAS float* gn = (LAS float*)(lds + 1024);
            LAS float* bn = (LAS float*)(lds + 5120);
            LAS float* bsl = (LAS float*)(lds + 9216);
            LAS bf16* Ws = (LAS bf16*)(lds + 13312);
            LAS bf16* VnT = (LAS bf16*)(lds + 48128);
            {
                for (int i = tid; i < 1024; i += NTHREADS) { gn[i] = cm_norm_g[i]; bn[i] = cm_norm_b[i]; bsl[i] = cm_b_s[i]; }
                LBAR();
                for (int u = bid; u < NBATCH * 32 * 2; u += G) {
                    const int r0 = (u >> 1) * 128, h0 = (u & 1) * 4, r16 = lane & 15, q4 = lane >> 4;
#pragma unroll 1
                    for (int qb = 0; qb < 16; qb += 8) {
                        u32x4 ra[8], rb[8];
#pragma unroll
                        for (int j = 0; j < 8; ++j) { const bf16* vr = P + (size_t)(r0 + wave * 16 + qb + j) * NP + C_V + 16 * lane; ra[j] = *(const u32x4*)vr; rb[j] = *(const u32x4*)(vr + 8); }
#pragma unroll
                        for (int j = 0; j < 8; ++j) {
                            const float f[16] = {bflo(ra[j].x), bfhi(ra[j].x), bflo(ra[j].y), bfhi(ra[j].y), bflo(ra[j].z), bfhi(ra[j].z), bflo(ra[j].w), bfhi(ra[j].w), bflo(rb[j].x), bfhi(rb[j].x), bflo(rb[j].y), bfhi(rb[j].y), bflo(rb[j].z), bfhi(rb[j].z), bflo(rb[j].w), bfhi(rb[j].w)};
                            float sm = 0.f;
#pragma unroll
                            for (int i = 0; i < 16; ++i) sm += f[i];
                            const float mean = wave_sum(sm) * (1.f / 1024.f); float s2 = 0.f;
#pragma unroll
                            for (int i = 0; i < 16; ++i) { const float dl = f[i] - mean; s2 += dl * dl; }
                            const float rstd = 1.f / sqrtf(wave_sum(s2) * (1.f / 1024.f) + LN_EPS);
                            if (lane == 0) { stat[2 * (wave * 16 + qb + j)] = mean; stat[2 * (wave * 16 + qb + j) + 1] = rstd; }
                        }
                    }
                    f32x4 wreg[8]; u32x4 vreg[4]; u32x2 ureg[8];
#define CM_LOAD(h_) do { int t_ = tid; asm volatile("" : "+v"(t_)); _Pragma("unroll") for (int i_ = 0; i_ < 8; ++i_) { const int ch_ = t_ + 512 * i_; wreg[i_] = *(const f32x4*)(cm_w_s + ((size_t)(h_) * 128 + (ch_ >> 5)) * 128 + 4 * (ch_ & 31)); } \
                        _Pragma("unroll") for (int i_ = 0; i_ < 4; ++i_) { const int ch_ = t_ + 512 * i_; vreg[i_] = *(const u32x4*)(P + (size_t)(r0 + (ch_ & 127)) * NP + C_V + (h_) * 128 + (ch_ >> 7) * 8); } } while (0)
                    CM_LOAD(h0);
                    LBAR();
#pragma unroll 1
                    for (int h = h0; h < h0 + 4; ++h) {
#pragma unroll
                        for (int tp = 0; tp < 8; ++tp) ureg[tp] = *(const u32x2*)(P + (size_t)(r0 + 16 * tp + r16) * NP + C_U + h * 128 + 16 * wave + 4 * q4);
#pragma unroll
                        for (int i = 0; i < 8; ++i) { const int ch = tid + 512 * i; u32x2 o; o.x = pk2(wreg[i].x, wreg[i].y); o.y = pk2(wreg[i].z, wreg[i].w); *(LAS u32x2*)(Ws + (ch >> 5) * 136 + 4 * (ch & 31)) = o; }
#pragma unroll
                        for (int i = 0; i < 4; ++i) { const int ch = tid + 512 * i, q = ch & 127, e8 = ch >> 7; const u32x4 w = vreg[i];
                            const float mean = stat[2 * q], rstd = stat[2 * q + 1]; const LAS float* gp = gn + h * 128 + e8 * 8; const LAS float* bp = bn + h * 128 + e8 * 8;
                            const f32x4 g0 = *(const LAS f32x4*)gp, g1 = *(const LAS f32x4*)(gp + 4), b0 = *(const LAS f32x4*)bp, b1 = *(const LAS f32x4*)(bp + 4);
                            const float vv[8] = {bflo(w.x), bfhi(w.x), bflo(w.y), bfhi(w.y), bflo(w.z), bfhi(w.z), bflo(w.w), bfhi(w.w)};
                            const float gg[8] = {g0.x, g0.y, g0.z, g0.w, g1.x, g1.y, g1.z, g1.w}, bb[8] = {b0.x, b0.y, b0.z, b0.w, b1.x, b1.y, b1.z, b1.w};
#pragma unroll
                            for (int j = 0; j < 8; ++j) VnT[(e8 * 8 + j) * 136 + q] = (bf16)f2bf((vv[j] - mean) * rstd * gg[j] + bb[j]); }
                        if (h + 1 < h0 + 4) CM_LOAD(h + 1);
                        LBAR();
                        f32x4 acc[8];
#pragma unroll
                        for (int tp = 0; tp < 8; ++tp) acc[tp] = (f32x4){0.f, 0.f, 0.f, 0.f};
#pragma unroll
                        for (int ks = 0; ks < 4; ++ks) { const bf16x8 a = *(const LAS bf16x8*)(VnT + (16 * wave + r16) * 136 + 32 * ks + 8 * q4);
#pragma unroll
                            for (int tp = 0; tp < 8; ++tp) { const bf16x8 bq = *(const LAS bf16x8*)(Ws + (16 * tp + r16) * 136 + 32 * ks + 8 * q4);
                                acc[tp] = __builtin_amdgcn_mfma_f32_16x16x32_bf16(a, bq, acc[tp], 0, 0, 0); } }
#pragma unroll
                        for (int tp = 0; tp < 8; ++tp) { const int pp = 16 * tp + r16, e0 = 16 * wave + 4 * q4; const float bs = bsl[h * 128 + pp]; const u32x2 uu = ureg[tp];
                            u32x2 o; o.x = pk2(bflo(uu.x) * (acc[tp][0] + bs), bfhi(uu.x) * (acc[tp][1] + bs)); o.y = pk2(bflo(uu.y) * (acc[tp][2] + bs), bfhi(uu.y) * (acc[tp][3] + bs));
                            *(u32x2*)(ACAT + (size_t)(r0 + pp) * D + h * 128 + e0) = o; }
                        LBAR();
                    }
#undef CM_LOAD
                }
            }
    }
    SEAM(3);

    if (IN(4)) {
        if (bid < 64) {
            const int bhd = bid >> 1, eh = bid & 1, b = bhd >> 3, h = (bhd >> 1) & 3, dir = bhd & 1;
            const bf16* QEg = dir ? QEB : QEF; const bf16* KDg = dir ? KDB : KDF; const float* DECg = dir ? DECB : DECF; float* O = dir ? OB : OF;
            constexpr int GBUF = 55296;
            if (wave >= 4) {
                const int pt = tid - 256;
                u32x4 R0_[13], R1_[13], R2_[13];
#define G2_PLOAD(R, n) do { const int c_ = dir ? ((n) < 4 ? 3 - (n) : 71 - (n)) : (n); const size_t u_ = (size_t)(b * 68 + c_) * 4 + h; \
                    _Pragma("unroll") for (int i_ = 0; i_ < 4; ++i_) { const int q_ = pt + 256 * i_; R[i_] = c_ >= 4 ? *(const u32x4*)(QEg + u_ * 8192 + (size_t)q_ * 8) : (u32x4){0u, 0u, 0u, 0u}; \
                        R[4 + i_] = *(const u32x4*)(KDg + u_ * 8192 + (size_t)q_ * 8); R[8 + i_] = *(const u32x4*)(VTg + (u_ * 256 + eh * 128) * 64 + (size_t)q_ * 8); } \
                    R[12] = *(const u32x4*)(DECg + u_ * 128 + (pt & 31) * 4); } while (0)
#define G2_PSTORE(R, bb) do { LAS unsigned char* base_ = lds + (bb) * GBUF; \
                    _Pragma("unroll") for (int i_ = 0; i_ < 4; ++i_) { const int q_ = pt + 256 * i_; *(LAS u32x4*)(base_ + (q_ >> 4) * 272 + (q_ & 15) * 16) = R[i_]; \
                        *(LAS u32x4*)(base_ + 17408 + (q_ >> 3) * 144 + (q_ & 7) * 16) = R[4 + i_]; *(LAS u32x4*)(base_ + 36352 + (q_ >> 3) * 144 + (q_ & 7) * 16) = R[8 + i_]; } \
                    if (pt < 32) *(LAS u32x4*)(base_ + 35840 + pt * 16) = R[12]; } while (0)
                G2_PLOAD(R0_, 0); G2_PLOAD(R1_, 1); G2_PLOAD(R2_, 2); G2_PSTORE(R0_, 0); G2_PLOAD(R0_, 3);
                LBAR();
#pragma unroll 1
                for (int n = 0; n < 66; n += 3) {
                    G2_PSTORE(R1_, (n + 1) & 1); if (n + 4 < 68) G2_PLOAD(R1_, n + 4); LBAR();
                    G2_PSTORE(R2_, (n + 2) & 1); if (n + 5 < 68) G2_PLOAD(R2_, n + 5); LBAR();
                    G2_PSTORE(R0_, (n + 3) & 1); if (n + 6 < 68) G2_PLOAD(R0_, n + 6); LBAR();
                }
                G2_PSTORE(R1_, 1); LBAR();
                LBAR();
#undef G2_PLOAD
#undef G2_PSTORE
            } else {
                const int ws = eh * 4 + wave, r = lane & 31, hh = lane >> 5;
                __builtin_amdgcn_s_setprio(2);
                typedef float f32x16 __attribute__((ext_vector_type(16)));
                f32x16 S[4];
#pragma unroll
                for (int dt = 0; dt < 4; ++dt)
#pragma unroll
                    for (int i = 0; i < 16; ++i) S[dt][i] = 0.f;
                LBAR();
#pragma unroll 1
                for (int n = 0; n < 68; ++n) {
                    const int c = dir ? (n < 4 ? 3 - n : 71 - n) : n;
                    const LAS unsigned char* base = lds + (n & 1) * GBUF;
                    if (c >= 4) {
                        f32x16 o[2];
#pragma unroll
                        for (int i = 0; i < 16; ++i) { o[0][i] = 0.f; o[1][i] = 0.f; }
#pragma unroll
                        for (int dt = 0; dt < 4; ++dt)
#pragma unroll
                            for (int s2 = 0; s2 < 2; ++s2) {
                                u32x4 pk; pk.x = pk2(S[dt][8 * s2], S[dt][8 * s2 + 1]); pk.y = pk2(S[dt][8 * s2 + 2], S[dt][8 * s2 + 3]); pk.z = pk2(S[dt][8 * s2 + 4], S[dt][8 * s2 + 5]); pk.w = pk2(S[dt][8 * s2 + 6], S[dt][8 * s2 + 7]);
                                const bf16x8 bs = __builtin_bit_cast(bf16x8, pk);
#pragma unroll
                                for (int tt = 0; tt < 2; ++tt) { const bf16x8 a = *(const LAS bf16x8*)(base + (32 * tt + r) * 272 + (32 * dt + 16 * s2 + 8 * hh) * 2);
                                    o[tt] = __builtin_amdgcn_mfma_f32_32x32x16_bf16(a, bs, o[tt], 0, 0, 0); }
                            }
                        float* orow = O + (size_t)(b * SEQ + (c - 4) * 64) * 1024 + h * 256 + 32 * ws + r;
#pragma unroll
                        for (int tt = 0; tt < 2; ++tt)
#pragma unroll
                            for (int i = 0; i < 16; ++i) orow[(size_t)(32 * tt + (i & 3) + 8 * (i >> 2) + 4 * hh) * 1024] = o[tt][i];
                    }
                    bf16x8 vt[4];
#pragma unroll
                    for (int s4 = 0; s4 < 4; ++s4) vt[s4] = *(const LAS bf16x8*)(base + 36352 + (32 * wave + r) * 144 + (16 * s4 + 8 * hh) * 2);
#pragma unroll
                    for (int dt = 0; dt < 4; ++dt)
#pragma unroll
                        for (int g4 = 0; g4 < 4; ++g4) { const f32x4 dc = *(const LAS f32x4*)(base + 35840 + (32 * dt + 8 * g4 + 4 * hh) * 4);
                            S[dt][4 * g4] *= dc.x; S[dt][4 * g4 + 1] *= dc.y; S[dt][4 * g4 + 2] *= dc.z; S[dt][4 * g4 + 3] *= dc.w; }
#pragma unroll
                    for (int s4 = 0; s4 < 4; ++s4)
#pragma unroll
                        for (int dt = 0; dt < 4; ++dt) { const bf16x8 a = *(const LAS bf16x8*)(base + 17408 + (32 * dt + r) * 144 + (16 * s4 + 8 * hh) * 2);
                            S[dt] = __builtin_amdgcn_mfma_f32_32x32x16_bf16(a, vt[s4], S[dt], 0, 0, 0); }
                    LBAR();
                }
                __builtin_amdgcn_s_setprio(0);
            }
        } else {
            if (wave < 2) MOE_RANGE(CV_P0 + CV2 + CV2X + CV3 + (bid - 64) * 2 + wave, CV_P0 + CV2 + CV2X + CV3 + CV4, (G - 64) * 2);
        }
    }
    SEAM(4);

    if (IN(5) && is_conv) CONV_SLICE(CV_P0 + CV2 + CV2X + CV3 + CV4, CV5);
    if (IN(5) && !is_conv) {
        const int c0 = 16 * lane; float ng[16];
#pragma unroll
        for (int j = 0; j < 4; ++j) { const f32x4 g4 = *(const f32x4*)(gla_norm_g + ((c0 + 4 * j) & 255)); ng[4 * j] = g4.x; ng[4 * j + 1] = g4.y; ng[4 * j + 2] = g4.z; ng[4 * j + 3] = g4.w; }
        for (int m0 = gw; m0 < T; m0 += 2 * NGWc) {
            f32x4 ra[2][4], rb[2][4], ri[2][4]; u32x4 rg[2][2];
#pragma unroll
            for (int t2 = 0; t2 < 2; ++t2) { const int m = (m0 + t2 * NGWc) < T ? m0 + t2 * NGWc : m0;
#pragma unroll
                for (int j = 0; j < 4; ++j) { ra[t2][j] = *(const f32x4*)(OF + (size_t)m * 1024 + c0 + 4 * j); rb[t2][j] = *(const f32x4*)(OB + (size_t)m * 1024 + c0 + 4 * j); ri[t2][j] = *(const f32x4*)(OI + (size_t)m * 1024 + c0 + 4 * j); }
                rg[t2][0] = *(const u32x4*)(P + (size_t)m * NP + C_GO + c0); rg[t2][1] = *(const u32x4*)(P + (size_t)m * NP + C_GO + c0 + 8); }
#pragma unroll
            for (int t2 = 0; t2 < 2; ++t2) { const int m = m0 + t2 * NGWc; if (m >= T) break;
                float o[16];
#pragma unroll
                for (int j = 0; j < 4; ++j) { const f32x4 a = ra[t2][j], b2 = rb[t2][j], i3 = ri[t2][j];
                    o[4 * j] = (a.x + b2.x) + i3.x; o[4 * j + 1] = (a.y + b2.y) + i3.y; o[4 * j + 2] = (a.z + b2.z) + i3.z; o[4 * j + 3] = (a.w + b2.w) + i3.w; }
                float ss = 0.f;
#pragma unroll
                for (int j = 0; j < 16; ++j) ss += o[j] * o[j];
                ss += __shfl_xor(ss, 1); ss += __shfl_xor(ss, 2); ss += __shfl_xor(ss, 4); ss += __shfl_xor(ss, 8);
                const float rms = 1.f / sqrtf(ss * (1.f / 256.f) + RMS_EPS);
                const unsigned gw8[8] = {rg[t2][0].x, rg[t2][0].y, rg[t2][0].z, rg[t2][0].w, rg[t2][1].x, rg[t2][1].y, rg[t2][1].z, rg[t2][1].w};
                float r[16];
#pragma unroll
                for (int j = 0; j < 8; ++j) { const float g0 = bflo(gw8[j]), g1 = bfhi(gw8[j]);
                    r[2 * j] = o[2 * j] * rms * ng[2 * j] * g0 * __builtin_amdgcn_rcpf(1.f + __expf(-g0)); r[2 * j + 1] = o[2 * j + 1] * rms * ng[2 * j + 1] * g1 * __builtin_amdgcn_rcpf(1.f + __expf(-g1)); }
                u32x4 w0, w1; w0.x = pk2(r[0], r[1]); w0.y = pk2(r[2], r[3]); w0.z = pk2(r[4], r[5]); w0.w = pk2(r[6], r[7]);
                w1.x = pk2(r[8], r[9]); w1.y = pk2(r[10], r[11]); w1.z = pk2(r[12], r[13]); w1.w = pk2(r[14], r[15]);
                *(u32x4*)(ACAT + (size_t)m * D + 1024 + c0) = w0; *(u32x4*)(ACAT + (size_t)m * D + 1024 + c0 + 8) = w1; }
        }
    }
    SEAM(5);

    if (IN(6)) {
        pg8::DenseOrder S; S.init(T, D, G, bid, WoutT, D);
        EpiOutProj E{Z, HN, MOD};
        pg8::gemm_phase<EpiOutProj, pg8::DenseOrder>(lds, ACAT, D, S, E);
    }
    SEAM(6);

    if (IN(7)) {
        LAS float* part = (LAS float*)lds;
        LAS float* lgt = (LAS float*)(lds + 32768);
        LAS int* selE = (LAS int*)(lds + 36864);
        LAS unsigned* lcnt = (LAS unsigned*)(lds + 36864 + 512);
        LAS unsigned* gbs = lcnt + 32;
        if (tid < 32) lcnt[tid] = 0u;
        typedef float f32x16 __attribute__((ext_vector_type(16)));
        LAS float* LG1 = (LAS float*)(lds + 40960); LAS float* LB1 = LG1 + D; LAS float* SH2 = LB1 + D; LAS float* SC2 = SH2 + D;
        for (int i = tid; i < D; i += NTHREADS) { LG1[i] = ln1_g[i]; LB1[i] = ln1_b[i]; }
        for (int g0 = bid * 32; g0 < T; g0 += G * 32) {
            { const float* sh2g = MOD + (g0 / SEQ) * (6 * D) + 3 * D; for (int i = tid; i < D; i += NTHREADS) { SH2[i] = sh2g[i]; SC2[i] = sh2g[D + i]; } }
            LBAR();
            u32x4 zc[4], zn[4];
#pragma unroll
            for (int j2 = 0; j2 < 4; ++j2) zc[j2] = *(const u32x4*)(Z + (size_t)(g0 + wave * 4) * D + 8 * (lane + 64 * j2));
#pragma unroll
            for (int j4 = 0; j4 < 4; ++j4) {
                const int m = g0 + wave * 4 + j4;
                if (j4 + 1 < 4) {
#pragma unroll
                    for (int j2 = 0; j2 < 4; ++j2) zn[j2] = *(const u32x4*)(Z + (size_t)(m + 1) * D + 8 * (lane + 64 * j2)); }
                f32x4 v[8]; float s = 0.f;
#pragma unroll
                for (int j2 = 0; j2 < 4; ++j2) { const u32x4 zz = zc[j2];
                    v[2 * j2] = (f32x4){bflo(zz.x), bfhi(zz.x), bflo(zz.y), bfhi(zz.y)}; v[2 * j2 + 1] = (f32x4){bflo(zz.z), bfhi(zz.z), bflo(zz.w), bfhi(zz.w)}; }
#pragma unroll
                for (int j = 0; j < 8; ++j) s += (v[j].x + v[j].y) + (v[j].z + v[j].w);
                const float mean = wave_sum(s) * (1.f / D); float s2 = 0.f;
#pragma unroll
                for (int j = 0; j < 8; ++j) { v[j] = v[j] - mean; s2 += (v[j].x * v[j].x + v[j].y * v[j].y) + (v[j].z * v[j].z + v[j].w * v[j].w); }
                const float rstd = 1.f / sqrtf(wave_sum(s2) * (1.f / D) + LN_EPS);
#pragma unroll
                for (int j = 0; j < 8; ++j) { const int c = 8 * (lane + 64 * (j >> 1)) + 4 * (j & 1); const f32x4 g = *(const LAS f32x4*)(LG1 + c), bb = *(const LAS f32x4*)(LB1 + c), a = *(const LAS f32x4*)(SH2 + c), sc = *(const LAS f32x4*)(SC2 + c);
                    f32x4 h; h.x = v[j].x * rstd * g.x + bb.x; h.y = v[j].y * rstd * g.y + bb.y; h.z = v[j].z * rstd * g.z + bb.z; h.w = v[j].w * rstd * g.w + bb.w;
                    u32x2 o; o.x = pk2(h.x, h.y); o.y = pk2(h.z, h.w); *(u32x2*)(H1 + (size_t)m * D + c) = o;
                    f32x4 hm; hm.x = h.x * (1.f + sc.x) + a.x; hm.y = h.y * (1.f + sc.y) + a.y; hm.z = h.z * (1.f + sc.z) + a.z; hm.w = h.w * (1.f + sc.w) + a.w;
                    o.x = pk2(hm.x, hm.y); o.y = pk2(hm.z, hm.w); *(u32x2*)(HM2 + (size_t)m * D + c) = o;
                    u32x2 l; l.x = pk2(hm.x - bflo(o.x), hm.y - bfhi(o.x)); l.y = pk2(hm.z - bflo(o.y), hm.w - bfhi(o.y)); *(u32x2*)(HM2LO + (size_t)m * D + c) = l;
                    int f8 = __builtin_amdgcn_cvt_pk_fp8_f32(hm.x, hm.y, 0, false); f8 = __builtin_amdgcn_cvt_pk_fp8_f32(hm.z, hm.w, f8, true); *(int*)(HM2F8 + (size_t)m * D + c) = f8; }
#pragma unroll
                for (int j2 = 0; j2 < 4; ++j2) zc[j2] = zn[j2];
            }
            asm volatile("s_waitcnt vmcnt(0)" ::: "memory"); __syncthreads();
            {
                const int r = lane & 31, hh = lane >> 5; f32x16 acc;
#pragma unroll
                for (int i = 0; i < 16; ++i) acc[i] = 0.f;
#pragma unroll 4
                for (int ks = 0; ks < 16; ++ks) { const int kk = 256 * wave + 16 * ks + 8 * hh;
                    const bf16x8 ahi = *(const bf16x8*)(HM2 + (size_t)(g0 + r) * D + kk), alo = *(const bf16x8*)(HM2LO + (size_t)(g0 + r) * D + kk);
                    const bf16x8 bhi = *(const bf16x8*)(WRH + (size_t)r * D + kk), blo = *(const bf16x8*)(WRL + (size_t)r * D + kk);
                    acc = __builtin_amdgcn_mfma_f32_32x32x16_bf16(ahi, bhi, acc, 0, 0, 0); acc = __builtin_amdgcn_mfma_f32_32x32x16_bf16(alo, bhi, acc, 0, 0, 0); acc = __builtin_amdgcn_mfma_f32_32x32x16_bf16(ahi, blo, acc, 0, 0, 0); }
#pragma unroll
                for (int i = 0; i < 16; ++i) part[(wave * 32 + (i & 3) + 8 * (i >> 2) + 4 * hh) * 32 + r] = acc[i];
            }
            LBAR();
#pragma unroll
            for (int j = 0; j < 2; ++j) { const int idx = tid + 512 * j; float sum = b_router[idx & 31];
#pragma unroll
                for (int w8 = 0; w8 < 8; ++w8) sum += part[w8 * 1024 + idx];
                lgt[idx] = sum; }
            LBAR();
#pragma unroll 1
            for (int j4 = 0; j4 < 4; ++j4) {
                const int tok = wave * 4 + j4, m = g0 + tok;
                float val = lane < 32 ? lgt[tok * 32 + lane] : -INFINITY; float tv[4]; int ti[4];
#pragma unroll
                for (int k = 0; k < 4; ++k) { const float mx = wave_max(val); const unsigned long long bm = __ballot(val == mx); const int idx = __ffsll((long long)bm) - 1;
                    tv[k] = mx; ti[k] = idx; if (lane == idx) val = -INFINITY; }
                const float e1 = expf(tv[1] - tv[0]), e2 = expf(tv[2] - tv[0]), e3 = expf(tv[3] - tv[0]); const float inv = 1.f / (1.f + e1 + e2 + e3);
                if (lane < 4) { const int ex = lane == 0 ? ti[0] : lane == 1 ? ti[1] : lane == 2 ? ti[2] : ti[3]; const float w = (lane == 0 ? 1.f : lane == 1 ? e1 : lane == 2 ? e2 : e3) * inv;
                    selE[tok * 4 + lane] = ex; TOPW[m * 4 + lane] = w; }
            }
            LBAR();
            int ex = 0; unsigned lpos = 0;
            if (tid < 128) { ex = selE[tid]; lpos = __hip_atomic_fetch_add(lcnt + ex, 1u, __ATOMIC_RELAXED, __HIP_MEMORY_SCOPE_WORKGROUP); }
            LBAR();
            if (tid < 32) { const unsigned c = lcnt[tid]; gbs[tid] = c ? atomicAdd(CNT + tid * 64, c) : 0u; lcnt[tid] = 0u; }
            LBAR();
            if (tid < 128) { const unsigned pos = gbs[ex] + lpos; const int m = g0 + (tid >> 2); LIST[ex * T + pos] = m * 4 + (tid & 3); TOPEP[m * 4 + (tid & 3)] = ((unsigned)ex << 16) | pos; }
        }
    }
    SEAM(7);

    if (IN(8) || IN(9)) {
        LAS int* tb = (LAS int*)(lds + TBL_OFF);
        LAS int* cn = tb + 64;
        LBAR();
        if (tid == 0) { int a = 0; for (int e = 0; e < NE; ++e) { const int c = (int)CNT[e * 64]; cn[e] = c; tb[e] = a; a += (c + 255) / 256; } tb[NE] = a; }
        LBAR();
        if (IN(8) && is_conv) CONV_SLICE(CV_GU, CV_TOT - CV_GU);
        if (IN(8) && !is_conv) {
            LAS int* UT = (LAS int*)(lds + TBL_OFF + 512);
            LAS bf16* BT = (LAS bf16*)(lds + EPT_OFF); LAS unsigned short* RL = (LAS unsigned short*)(lds + EPT_OFF + EPT_RL * 512);
            MoeOrder<true> S{tb, cn, 16, Gc, bid, WguT, (size_t)4096 * 2048, LIST, D, UT, RL};
            S.build(UT, tid); LBAR(); S.pack(lane);
            { int pr[EPT_RL]; float pv[EPT_RL]; const int t8 = tid & 255;
#pragma unroll
              for (int i = 0; i < EPT_RL; ++i) { pg8::Unit pu; const bool ok = S.next(i, pu); pr[i] = (ok && t8 < pu.nv) ? LIST[pu.e * T + pu.mt * 256 + t8] >> 2 : 0;
                  pv[i] = ok ? b_gu[(size_t)pu.e * 4096 + (t8 >> 7) * 2048 + pu.pn * 128 + (t8 & 127)] : 0.f; }
#pragma unroll
              for (int i = 0; i < EPT_RL; ++i) if (tid < 256) { RL[i * 256 + tid] = (unsigned short)pr[i]; BT[i * 256 + tid] = (bf16)f2bf(pv[i]); } }
            LBAR();
            EpiGateUp E{ACT, BT};
            pg8::gemm_phase<EpiGateUp, MoeOrder<true>, 1>(lds, HM2F8, D, S, E);
        }
        if (IN(8) && IN(9)) xcd_barrier(bar);
        if (IN(9)) {
            LAS int* UT = (LAS int*)(lds + TBL_OFF + 512);
            MoeOrder<false> S{tb, cn, 8, G, bid, WdnT, (size_t)2048 * 2048, LIST, D, UT, nullptr};
            S.build(UT, tid); LBAR(); S.pack(lane);
            LAS float* BT = (LAS float*)(lds + EPT_OFF); LAS int* LT = (LAS int*)(lds + EPT_OFF + EPT_UNITS9 * 1024);
            { float pv[EPT_UNITS9]; int pl[EPT_UNITS9]; const int t8 = tid & 255;
#pragma unroll
              for (int i = 0; i < EPT_UNITS9; ++i) { pg8::Unit pu; const bool ok = S.next(i, pu); pv[i] = ok ? b_dn[(size_t)pu.e * 2048 + pu.pn * 256 + t8] : 0.f; pl[i] = (ok && t8 < pu.nv) ? LIST[pu.e * T + pu.mt * 256 + t8] : 0; }
#pragma unroll
              for (int i = 0; i < EPT_UNITS9; ++i) if (tid < 256) { BT[i * 256 + tid] = pv[i]; LT[i * 256 + tid] = pl[i]; } }
            LBAR();
            EpiDown E{YB, BT, LT};
            pg8::gemm_phase<EpiDown, MoeOrder<false>, 1>(lds, ACT, D, S, E);
        }
    }
    SEAM(9);

    if (IN(10)) {
        LAS float* G2T = (LAS float*)lds; LAS float* LG = G2T + 4 * D; LAS float* LB = LG + D;
        for (int i = tid; i < 4 * D; i += NTHREADS) G2T[i] = MOD[(i / D) * (6 * D) + 5 * D + (i % D)];
        for (int i = tid; i < D; i += NTHREADS) { LG[i] = ln2_g[i]; LB[i] = ln2_b[i]; }
        LBAR();
        for (int m0 = gw; m0 < T; m0 += 2 * NGW) {
            u32x4 hr[2][4]; u32x2 yr[2][4][4]; f32x4 wr4[2];
#pragma unroll
            for (int t2 = 0; t2 < 2; ++t2) { const int m = (m0 + t2 * NGW) < T ? m0 + t2 * NGW : m0;
                wr4[t2] = *(const f32x4*)(TOPW + m * 4);
#pragma unroll
                for (int j = 0; j < 4; ++j) { const int c = 8 * (lane + 64 * j); hr[t2][j] = *(const u32x4*)(H1 + (size_t)m * D + c);
#pragma unroll
                    for (int k = 0; k < 4; ++k) yr[t2][j][k] = *(const u32x2*)(YB + ((size_t)m * 4 + k) * D + c); } }
#pragma unroll
            for (int t2 = 0; t2 < 2; ++t2) { const int m = m0 + t2 * NGW; if (m >= T) break;
                const LAS float* g2 = G2T + (m / SEQ) * D;
                const float w0 = wr4[t2].x, w1 = wr4[t2].y, w2 = wr4[t2].z, w3 = wr4[t2].w;
                float z[4][8]; float s = 0.f;
#pragma unroll
                for (int j = 0; j < 4; ++j) { const int c = 8 * (lane + 64 * j);
                    const u32x4 h = hr[t2][j]; const u32x2 y0 = yr[t2][j][0], y1 = yr[t2][j][1], y2 = yr[t2][j][2], y3 = yr[t2][j][3];
                    const f32x4 ga = *(const LAS f32x4*)(g2 + c), gb = *(const LAS f32x4*)(g2 + c + 4);
                    const unsigned hw[4] = {h.x, h.y, h.z, h.w}, a0[2] = {y0.x, y0.y}, a1[2] = {y1.x, y1.y}, a2[2] = {y2.x, y2.y}, a3[2] = {y3.x, y3.y};
                    const float gg[8] = {ga.x, ga.y, ga.z, ga.w, gb.x, gb.y, gb.z, gb.w};
#pragma unroll
                    for (int q = 0; q < 2; ++q)
#pragma unroll
                        for (int h2 = 0; h2 < 2; ++h2) { const int e0 = 4 * q + 2 * h2;
                            const f32v2 p0 = h2 ? __builtin_amdgcn_cvt_pk_f32_fp8((int)a0[q], true) : __builtin_amdgcn_cvt_pk_f32_fp8((int)a0[q], false), p1 = h2 ? __builtin_amdgcn_cvt_pk_f32_fp8((int)a1[q], true) : __builtin_amdgcn_cvt_pk_f32_fp8((int)a1[q], false);
                            const f32v2 p2 = h2 ? __builtin_amdgcn_cvt_pk_f32_fp8((int)a2[q], true) : __builtin_amdgcn_cvt_pk_f32_fp8((int)a2[q], false), p3 = h2 ? __builtin_amdgcn_cvt_pk_f32_fp8((int)a3[q], true) : __builtin_amdgcn_cvt_pk_f32_fp8((int)a3[q], false);
                            const float flo = (((w0 * p0.x + w1 * p1.x) + w2 * p2.x) + w3 * p3.x) * (1.f / YSC);
                            const float fhi = (((w0 * p0.y + w1 * p1.y) + w2 * p2.y) + w3 * p3.y) * (1.f / YSC);
                            const unsigned hword = hw[e0 >> 1];
                            z[j][e0] = ALPHA * bflo(hword) + gg[e0] * flo; z[j][e0 + 1] = ALPHA * bfhi(hword) + gg[e0 + 1] * fhi; s += z[j][e0] + z[j][e0 + 1]; }
                }
                const float mean = wave_sum(s) * (1.f / D); float s2 = 0.f;
#pragma unroll
                for (int j = 0; j < 4; ++j)
#pragma unroll
                    for (int q = 0; q < 8; ++q) { z[j][q] -= mean; s2 += z[j][q] * z[j][q]; }
                const float rstd = 1.f / sqrtf(wave_sum(s2) * (1.f / D) + LN_EPS);
#pragma unroll
                for (int j = 0; j < 4; ++j) { const int c = 8 * (lane + 64 * j);
                    const f32x4 ga = *(const LAS f32x4*)(LG + c), gb = *(const LAS f32x4*)(LG + c + 4), ba = *(const LAS f32x4*)(LB + c), bb = *(const LAS f32x4*)(LB + c + 4);
                    f32x4 o0, o1; o0.x = z[j][0] * rstd * ga.x + ba.x; o0.y = z[j][1] * rstd * ga.y + ba.y; o0.z = z[j][2] * rstd * ga.z + ba.z; o0.w = z[j][3] * rstd * ga.w + ba.w;
                    o1.x = z[j][4] * rstd * gb.x + bb.x; o1.y = z[j][5] * rstd * gb.y + bb.y; o1.z = z[j][6] * rstd * gb.z + bb.z; o1.w = z[j][7] * rstd * gb.w + bb.w;
                    *(f32x4*)(out + (size_t)m * D + c) = o0; *(f32x4*)(out + (size_t)m * D + c + 4) = o1; }
            }
        }
    }
#undef IN
#undef SEAM
}

extern "C" void kernel_launch(void* const* d_in, const int* in_sizes, int n_in, void* d_out, int out_size, void* d_ws, size_t ws_size, hipStream_t stream) {
    static int grid = 0;
    if (grid == 0) {
        if (n_in != 29 || out_size != T * D || ws_size < WS_END) { fprintf(stderr, "kernel_launch: unexpected shapes (n_in %d, out %d, ws %zu); nothing launched\n", n_in, out_size, ws_size); grid = -1; return; }
        int dev = 0, cus = 0, per_cu = 0;
        if (hipGetDevice(&dev) != hipSuccess || hipDeviceGetAttribute(&cus, hipDeviceAttributeMultiprocessorCount, dev) != hipSuccess) { grid = -1; return; }
        if (hipFuncSetAttribute((const void*)fwd, hipFuncAttributeMaxDynamicSharedMemorySize, LDS_BYTES) != hipSuccess) { fprintf(stderr, "kernel_launch: hipFuncSetAttribute failed\n"); grid = -1; return; }
        if (hipOccupancyMaxActiveBlocksPerMultiprocessor(&per_cu, (const void*)fwd, NTHREADS, LDS_BYTES) != hipSuccess || per_cu < 1) { fprintf(stderr, "kernel_launch: occupancy query says %d\n", per_cu); }
        (void)hipGetLastError();
        grid = cus;
    }
    if (grid < 0) return;
    if (hipMemsetAsync((char*)d_ws + WS_CTL, 0, CTL_BYTES, stream) != hipSuccess) return;
    Args a{};
    for (int i = 0; i < 29; ++i) a.in[i] = (const float*)d_in[i];
    a.out = (float*)d_out; a.ws = (unsigned char*)d_ws;
#if PROBE_DUP >= 0
    a.ph_lo = 0; a.ph_hi = PROBE_DUP + 1; hipLaunchKernelGGL(fwd, dim3(grid), dim3(NTHREADS), LDS_BYTES, stream, a);
    hipMemsetAsync((char*)d_ws + WS_CTL + CW_BAR * 4, 0, XCD_BAR_WORDS * 4, stream);
    a.ph_lo = PROBE_DUP; a.ph_hi = NPHASE; hipLaunchKernelGGL(fwd, dim3(grid), dim3(NTHREADS), LDS_BYTES, stream, a);
#elif MK_ONE_LAUNCH
    a.ph_lo = 0; a.ph_hi = NPHASE;
    hipLaunchKernelGGL(fwd, dim3(grid), dim3(NTHREADS), LDS_BYTES, stream, a);
#else
    for (int p = 0; p < NPHASE; ++p) { a.ph_lo = p; a.ph_hi = p + 1; hipLaunchKernelGGL(fwd, dim3(grid), dim3(NTHREADS), LDS_BYTES, stream, a); }
#endif
}
```

```cpp
#include <hip/hip_runtime.h>
#include <cstdio>
#include <cstdint>

#ifndef PROBE_DUP
#define PROBE_DUP -1
#endif
#ifndef PROBE_CM2
#define PROBE_CM2 0
#endif
#ifndef PROBE_XBAR
#define PROBE_XBAR 0
#endif
#ifndef MK_ONE_LAUNCH
#define MK_ONE_LAUNCH 1
#endif

#define GAS __attribute__((address_space(1)))
#define LAS __attribute__((address_space(3)))
typedef unsigned short bf16;
typedef short bf16x8 __attribute__((ext_vector_type(8)));
typedef float f32x4 __attribute__((ext_vector_type(4)));
typedef unsigned u32x4 __attribute__((ext_vector_type(4)));
typedef unsigned u32x2 __attribute__((ext_vector_type(2)));
#define RLX_AGENT __ATOMIC_RELAXED, __HIP_MEMORY_SCOPE_AGENT
#define LDS_WAIT() asm volatile("s_waitcnt lgkmcnt(0)" ::: "memory")
#define LBAR() do { asm volatile("s_waitcnt lgkmcnt(0)" ::: "memory"); __builtin_amdgcn_s_barrier(); asm volatile("" ::: "memory"); } while (0)

constexpr int D = 2048, NBATCH = 4, SEQ = 4096, T = NBATCH * SEQ, CTX = 256, TC = NBATCH * CTX, MR = T + TC;
constexpr int DIN = 5152, NP = 5120;
constexpr int C_U = 0, C_V = 1024, C_Q = 2048, C_K = 2560, C_VG = 3072, C_GO = 4096;
constexpr int NE = 32, NSLOTMAX = 73728;
constexpr float ALPHA = 1.189207115002721f;
constexpr float LN_EPS = 1e-5f, RMS_EPS = 1e-6f;
constexpr float YSC = 16.0f;
constexpr int NWAVES = 8, NTHREADS = 512;
constexpr int NPHASE = 11;
constexpr int NCVB = 32, CV_GU = 65536, CV_TOT = 98304, CV2 = 20480, CV2X = 4096, CV3 = 0, CV4 = 24576, CV5 = 1536, CV_P0 = CV_GU - CV2 - CV2X - CV3 - CV4 - CV5;

constexpr size_t MiB = 1u << 20;
constexpr size_t WS_CTL = 0, CTL_BYTES = 1 * MiB;
constexpr size_t WS_MOD = 1 * MiB;
constexpr size_t WS_WIN = 4 * MiB;
constexpr size_t WS_WOUT = 26 * MiB;
constexpr size_t WS_WGU = 64 * MiB;
constexpr size_t WS_WDN = 576 * MiB;
constexpr size_t WS_HN = 832 * MiB;
constexpr size_t WS_HM = 900 * MiB;
constexpr size_t WS_P = 968 * MiB;
constexpr size_t WS_LR = 1138 * MiB;
constexpr size_t WS_ACAT = 1142 * MiB;
constexpr size_t WS_OF = 1206 * MiB;
constexpr size_t WS_OB = 1270 * MiB;
constexpr size_t WS_Z = 1334 * MiB;
constexpr size_t WS_H1 = 1462 * MiB;
constexpr size_t WS_HM2 = 1526 * MiB;
constexpr size_t WS_TOPW = 1590 * MiB;
constexpr size_t WS_TOPEP = 1591 * MiB;
constexpr size_t WS_LIST = 1592 * MiB;
constexpr size_t WS_ACT = 1594 * MiB;
constexpr size_t WS_YB = 1882 * MiB;
constexpr size_t WS_HM2LO = 2138 * MiB;
constexpr size_t WS_HM2F8 = 2202 * MiB;
constexpr size_t WS_END = 2234 * MiB;
constexpr int CW_CNT = 1024;
constexpr int CW_MODCNT = 3584;
constexpr int CW_BAR = 4096;

constexpr int LDS_BYTES = 163840;
constexpr int MISC_OFF = 135168 + 320;
constexpr int TBL_OFF = 135168 + 1024;
constexpr int EPT_OFF = 135168 + 2048;
constexpr int EPT_RL = 21, EPT_UNITS9 = 9;

typedef __bf16 bf16v2 __attribute__((ext_vector_type(2)));
typedef float f32v2 __attribute__((ext_vector_type(2)));
__device__ __forceinline__ unsigned pk2(float lo, float hi) { const f32v2 v = {lo, hi}; return __builtin_bit_cast(unsigned, __builtin_convertvector(v, bf16v2)); }
__device__ __forceinline__ unsigned f2bf(float f) { return pk2(f, 0.f) & 0xffffu; }
__device__ __forceinline__ float bf2f(unsigned b) { return __builtin_bit_cast(float, b << 16); }
__device__ __forceinline__ float bflo(unsigned w) { return __builtin_bit_cast(float, w << 16); }
__device__ __forceinline__ float bfhi(unsigned w) { return __builtin_bit_cast(float, w & 0xffff0000u); }
__device__ __forceinline__ float wave_sum(float v) {
#pragma unroll
    for (int o = 1; o < 64; o <<= 1) v += __shfl_xor(v, o);
    return v;
}
__device__ __forceinline__ float wave_max(float v) {
#pragma unroll
    for (int o = 1; o < 64; o <<= 1) v = fmaxf(v, __shfl_xor(v, o));
    return v;
}
__device__ __forceinline__ float gelu_exact(float x) { return 0.5f * x * (1.0f + erff(x * 0.70710678118654752f)); }
__device__ __forceinline__ float siluf(float x) { return x / (1.0f + expf(-x)); }
__device__ __forceinline__ float logsigmoidf(float x) { return fminf(x, 0.f) - log1pf(expf(-fabsf(x))); }

__device__ __forceinline__ unsigned lds_rd_u16(unsigned addr) { unsigned v; asm volatile("ds_read_u16 %0, %1\n\ts_waitcnt lgkmcnt(0)" : "=v"(v) : "v"(addr) : "memory"); return v; }
__device__ __forceinline__ int lds_rd_b32(unsigned addr) { int v; asm volatile("ds_read_b32 %0, %1\n\ts_waitcnt lgkmcnt(0)" : "=v"(v) : "v"(addr) : "memory"); return v; }
__device__ __forceinline__ f32x4 lds_rd_b128(unsigned addr) { f32x4 v; asm volatile("ds_read_b128 %0, %1\n\ts_waitcnt lgkmcnt(0)" : "=v"(v) : "v"(addr) : "memory"); return v; }
#define XB_TMO      128
#define XB_XCNT(j)  (256  + 64 * (j))
#define XB_XSUB(j)  (1280 + 64 * (j))
#define XB_XGEN(j)  (2304 + 64 * (j))
#define XB_TOP      3328
#define XB_TOPGEN   3392
#define XCD_BAR_WORDS 3456
#define XB_SPIN_CAP (1u << 18)
__device__ __forceinline__ unsigned xb_ld(unsigned* p)              { return __hip_atomic_load(p, __ATOMIC_RELAXED, __HIP_MEMORY_SCOPE_AGENT); }
__device__ __forceinline__ unsigned xb_add(unsigned* p, unsigned v) { return __hip_atomic_fetch_add(p, v, __ATOMIC_RELAXED, __HIP_MEMORY_SCOPE_AGENT); }
__device__ __forceinline__ unsigned xb_xcc_id() { return (unsigned)__builtin_amdgcn_s_getreg((3 << 11) | 20) & 0xFu; }
#define XB_SPIN(cond, bar) do { unsigned _sp = 0; while (cond) { __builtin_amdgcn_s_sleep(1); \
    if ((++_sp & 255u) == 0u) { if (xb_ld(&(bar)[XB_TMO])) break; if (_sp > XB_SPIN_CAP) { atomicAdd(&(bar)[XB_TMO], 1u); break; } } } } while (0)
struct XcdBarrier { unsigned* bar; unsigned x; volatile LAS unsigned* st; };
__device__ __forceinline__ XcdBarrier xcd_barrier_post(unsigned* bar, volatile LAS unsigned* st) {
    XcdBarrier b; b.bar = bar; b.x = xb_xcc_id(); b.st = st;
    if (threadIdx.x == 0) (void)xb_add(&bar[XB_XCNT(b.x)], 1u);
    return b;
}
__device__ __forceinline__ void xcd_barrier_complete(unsigned* bar, unsigned x, unsigned& nloc, unsigned& nx) {
    const unsigned G = gridDim.x * gridDim.y * gridDim.z;
    unsigned sum, cnt, mine, sp = 0u;
    for (;;) {
        sum = 0u; cnt = 0u; mine = 0u;
#pragma unroll
        for (unsigned j = 0; j < 16; ++j) { const unsigned c = xb_ld(&bar[XB_XCNT(j)]); sum += c; cnt += (c > 0u) ? 1u : 0u; mine = (j == x) ? c : mine; }
        if (sum == G) break;
        __builtin_amdgcn_s_sleep(1);
        if ((++sp & 255u) == 0u) { if (xb_ld(&bar[XB_TMO])) break; if (sp > XB_SPIN_CAP) { atomicAdd(&bar[XB_TMO], 1u); break; } }
    }
    nloc = mine > 0u ? mine : 1u; nx = cnt > 0u ? cnt : 1u;
}
__device__ __forceinline__ void xcd_barrier(const XcdBarrier& b) {
    asm volatile("s_waitcnt vmcnt(0)" ::: "memory");
    __syncthreads();
    if (threadIdx.x == 0) {
        unsigned* bar = b.bar;
        __builtin_amdgcn_s_waitcnt(0);
        unsigned nloc = b.st[0], nx = b.st[1];
        if (nloc == 0u) { xcd_barrier_complete(bar, b.x, nloc, nx); b.st[0] = nloc; b.st[1] = nx; }
        const unsigned old = xb_add(&bar[XB_XSUB(b.x)], 1u);
        const unsigned gen = old / nloc;
        if (old + 1u == (gen + 1u) * nloc) {
            __builtin_amdgcn_fence(__ATOMIC_RELEASE, "agent");
            asm volatile("s_waitcnt vmcnt(0)" ::: "memory");
            const unsigned og = xb_add(&bar[XB_TOP], 1u);
            const unsigned tg = og / nx;
            if (og + 1u == (tg + 1u) * nx) xb_add(&bar[XB_TOPGEN], 1u);
            else XB_SPIN(xb_ld(&bar[XB_TOPGEN]) == tg, bar);
            __builtin_amdgcn_fence(__ATOMIC_ACQUIRE, "agent");
            xb_add(&bar[XB_XGEN(b.x)], 1u);
            asm volatile("s_waitcnt vmcnt(0)" ::: "memory");
        } else {
            XB_SPIN(xb_ld(&bar[XB_XGEN(b.x)]) == gen, bar);
            __builtin_amdgcn_fence(__ATOMIC_ACQUIRE, "agent");
            asm volatile("s_waitcnt vmcnt(0)" ::: "memory");
        }
    }
    __syncthreads();
}

template <int NB, class AR, class BR, class EP>
__device__ __forceinline__ void wave_gemm32(const AR& arow, const BR& brow, const EP& epi, int K, int lane) {
    const int r = lane & 15, kq = lane >> 4;
    const bf16* a[2]; const bf16* b[NB][2];
#pragma unroll
    for (int m = 0; m < 2; ++m) a[m] = arow(16 * m + r) + 8 * kq;
#pragma unroll
    for (int w = 0; w < NB; ++w)
#pragma unroll
        for (int n = 0; n < 2; ++n) b[w][n] = brow(16 * n + r, w) + 8 * kq;
    f32x4 acc[NB][2][2];
#pragma unroll
    for (int w = 0; w < NB; ++w)
#pragma unroll
        for (int m = 0; m < 2; ++m)
#pragma unroll
            for (int n = 0; n < 2; ++n) acc[w][m][n] = (f32x4){0.f, 0.f, 0.f, 0.f};
#pragma unroll 8
    for (int k = 0; k < K; k += 32) {
        bf16x8 af[2], bfr[NB][2];
#pragma unroll
        for (int m = 0; m < 2; ++m) af[m] = *(const bf16x8*)(a[m] + k);
#pragma unroll
        for (int w = 0; w < NB; ++w)
#pragma unroll
            for (int n = 0; n < 2; ++n) bfr[w][n] = *(const bf16x8*)(b[w][n] + k);
#pragma unroll
        for (int w = 0; w < NB; ++w)
#pragma unroll
            for (int m = 0; m < 2; ++m)
#pragma unroll
                for (int n = 0; n < 2; ++n) acc[w][m][n] = __builtin_amdgcn_mfma_f32_16x16x32_bf16(af[m], bfr[w][n], acc[w][m][n], 0, 0, 0);
    }
#pragma unroll
    for (int m = 0; m < 2; ++m)
#pragma unroll
        for (int n = 0; n < 2; ++n)
#pragma unroll
            for (int q = 0; q < 4; ++q) epi(16 * m + 4 * kq + q, 16 * n + r, acc[0][m][n][q], NB == 2 ? acc[NB - 1][m][n][q] : 0.f);
}

__device__ __forceinline__ void transpose_item(const float* W, int K, int N, bf16* WT, int k0, int n0, int r0, LAS float* scr, int lane) {
#pragma unroll
    for (int i = 0; i < 32; ++i) { const int kk = 2 * i + (lane >> 5); scr[kk * 33 + (lane & 31)] = W[(size_t)(k0 + kk) * N + n0 + (lane & 31)]; }
    LDS_WAIT();
    const int c = lane & 7;
#pragma unroll
    for (int j = 0; j < 4; ++j) { const int n = (lane >> 3) + 8 * j; const LAS float* s = scr + (8 * c) * 33 + n;
        u32x4 o; o.x = pk2(s[0 * 33], s[1 * 33]); o.y = pk2(s[2 * 33], s[3 * 33]); o.z = pk2(s[4 * 33], s[5 * 33]); o.w = pk2(s[6 * 33], s[7 * 33]);
        *(u32x4*)(WT + (size_t)(r0 + n) * K + k0 + 8 * c) = o; }
    LDS_WAIT();
}

namespace pg8 {
typedef unsigned short bf16_t;
constexpr int BM = 256, BK = 64, HALF = 128, HTB = HALF * BK * 2, STAGE_BYTES = 8 * HTB, NXCD = 8;
__device__ __forceinline__ int lds_byte(int r, int c) { const int st = (r >> 4) * 2 + (c >> 5), rr = r & 15, cc = c & 31, ob = rr * 64 + cc * 2; return st * 1024 + (ob ^ (((ob >> 9) & 1) << 5)); }
__device__ __forceinline__ void stage_rc(int b, int& R, int& C) { const int st = b / 1024, sb = b % 1024, swz = sb ^ (((sb >> 9) & 1) << 5); R = (st >> 1) * 16 + swz / 64; C = (st & 1) * 32 + (swz % 64) / 2; }
__device__ __forceinline__ int perm32(int rho) { const int n = rho >> 4, i = rho & 15; return 8 * (i >> 2) + 4 * n + (i & 3); }
struct Unit { int pm, pn, e, mt, nv, ord; };
__device__ __forceinline__ unsigned cvt_pk_bf16(float lo, float hi) { unsigned r; asm volatile("v_cvt_pk_bf16_f32 %0, %1, %2" : "=v"(r) : "v"(lo), "v"(hi)); return r; }
typedef float f32x2 __attribute__((ext_vector_type(2)));
__device__ __forceinline__ f32x2 gelu_pk(f32x2 v) {
    const f32x2 av = __builtin_elementwise_abs(v), d = av * 0.2316418882f + 1.0f;
    f32x2 t; t.x = __builtin_amdgcn_rcpf(d.x); t.y = __builtin_amdgcn_rcpf(d.y);
    f32x2 q = t * 0.5307027145f + (-0.7265760135f); q = q * t + 0.7107068705f; q = q * t + (-0.142248368f); q = q * t + 0.127414796f; q = q * t;
    const f32x2 s = (v * v) * (-0.72134752044f);
    f32x2 e; e.x = __builtin_amdgcn_exp2f(s.x); e.y = __builtin_amdgcn_exp2f(s.y);
    const f32x2 m = v * (q * e), r = v - m;
    f32x2 o; o.x = v.x < 0.f ? m.x : r.x; o.y = v.y < 0.f ? m.y : r.y; return o;
}
typedef int i32x8 __attribute__((ext_vector_type(8)));
typedef int i32x4 __attribute__((ext_vector_type(4)));
template <class Epi, class Sched, int ESZ = 2>
__device__ __forceinline__ void gemm_phase(LAS unsigned char* lds, const void* A, int K, const Sched& S, const Epi& E) {
    const int tid = threadIdx.x, wid = __builtin_amdgcn_readfirstlane(tid >> 6), lane = tid & 63, wr = wid >> 2, wc = wid & 3, fr = lane & 15, fq = lane >> 4;
    const int rowb = K * ESZ, nt = rowb / 128;
    unsigned voffB[2];
#pragma unroll
    for (int i = 0; i < 2; ++i) { int R, C; stage_rc(tid * 16 + i * 8192, R, C); const int Rb = Epi::PERM ? ((R & ~31) + perm32(R & 31)) : R; voffB[i] = (unsigned)(Rb * rowb + C * 2); }
    const size_t kstep = (size_t)128;
    const size_t hstep = (size_t)HALF * rowb;
    const unsigned ldsw = (unsigned)wid * 1024u;
    const int aoff = lds_byte(wr * 64 + fr, fq * 8), boff = lds_byte(wc * 32 + fr, fq * 8);
#define PG8_SA(b, h) (((b) * 2 + (h)) * HTB)
#define PG8_SB(b, h) ((4 + (b) * 2 + (h)) * HTB)
#define PG8_STAGE(bufoff, gbase, voff) do { _Pragma("unroll") for (int _i = 0; _i < 2; ++_i) \
        __builtin_amdgcn_global_load_lds((const unsigned*)((const char*)(gbase) + (voff)[_i]), (LAS unsigned*)(lds + (bufoff) + ldsw + _i * 8192), 16, 0, 0); } while (0)
#define PG8_LDA(dst, b, h) do { _Pragma("unroll") for (int m = 0; m < 4; ++m) _Pragma("unroll") for (int k = 0; k < 2; ++k) dst[m][k] = *(const LAS bf16x8*)(lds + PG8_SA(b, h) + aoff + m * 2048 + k * 1024); } while (0)
#define PG8_LDB(dst, b, h) do { _Pragma("unroll") for (int n = 0; n < 2; ++n) _Pragma("unroll") for (int k = 0; k < 2; ++k) dst[n][k] = *(const LAS bf16x8*)(lds + PG8_SB(b, h) + boff + n * 2048 + k * 1024); } while (0)
#define PG8_CAT(x) __builtin_shufflevector(__builtin_bit_cast(i32x4, x[0]), __builtin_bit_cast(i32x4, x[1]), 0, 1, 2, 3, 4, 5, 6, 7)
#define PG8_MMA(ai, bj, At, Bt) do { __builtin_amdgcn_s_setprio(1); if constexpr (ESZ == 2) { _Pragma("unroll") for (int m = 0; m < 4; ++m) _Pragma("unroll") for (int n = 0; n < 2; ++n) _Pragma("unroll") for (int k = 0; k < 2; ++k) \
        acc[ai][bj][m][n] = __builtin_amdgcn_mfma_f32_16x16x32_bf16(Bt[n][k], At[m][k], acc[ai][bj][m][n], 0, 0, 0); } else { _Pragma("unroll") for (int m = 0; m < 4; ++m) _Pragma("unroll") for (int n = 0; n < 2; ++n) \
        acc[ai][bj][m][n] = __builtin_amdgcn_mfma_scale_f32_16x16x128_f8f6f4(PG8_CAT(Bt[n]), PG8_CAT(At[m]), acc[ai][bj][m][n], 0, 0, 0, 0x77777777, 0, 0x7f7f7f7f); } __builtin_amdgcn_s_setprio(0); } while (0)
#define PG8_WAIT_V(n) asm volatile("s_waitcnt vmcnt(" #n ")" ::: "memory")
#define PG8_WAIT_L(n) asm volatile("s_waitcnt lgkmcnt(" #n ")" ::: "memory")
#define PG8_BAR __builtin_amdgcn_s_barrier()
#define PG8_SCHED __builtin_amdgcn_sched_barrier(0)
#define PG8_ROWS(dst, u) do { int _t = threadIdx.x; asm volatile("" : "+v"(_t)); _Pragma("unroll") for (int _i = 0; _i < 2; ++_i) { int _R, _C; stage_rc(_t * 16 + _i * 8192, _R, _C); \
        _Pragma("unroll") for (int _h = 0; _h < 2; ++_h) dst[_h][_i] = (unsigned)(S.a_row(u, _h * HALF + _R) * rowb + _C * 2); } } while (0)
    Unit cur, nxt; int ui = 0;
    if (!S.next(0, cur)) return;
    f32x4 acc[2][2][4][2];
#pragma unroll
    for (int a = 0; a < 2; ++a)
#pragma unroll
        for (int b = 0; b < 2; ++b)
#pragma unroll
            for (int m = 0; m < 4; ++m)
#pragma unroll
                for (int n = 0; n < 2; ++n) acc[a][b][m][n] = (f32x4){0.f, 0.f, 0.f, 0.f};
    bf16x8 At[4][2], B0[2][2], B1[2][2];
    unsigned va[2][2], vn[2][2];
    PG8_ROWS(va, cur);
    const char* cA = (const char*)A; const char* cB = S.b_base(cur);
    PG8_WAIT_V(0);
    PG8_STAGE(PG8_SB(0, 0), cB, voffB); PG8_STAGE(PG8_SB(0, 1), cB + hstep, voffB); PG8_STAGE(PG8_SA(0, 0), cA, va[0]); PG8_STAGE(PG8_SA(0, 1), cA, va[1]);
    if (wr == 1) PG8_BAR;
    PG8_WAIT_V(2); PG8_BAR;
    PG8_STAGE(PG8_SB(1, 0), cB + kstep, voffB); PG8_STAGE(PG8_SA(1, 0), cA + kstep, va[0]); PG8_STAGE(PG8_SB(1, 1), cB + hstep + kstep, voffB);
    PG8_WAIT_V(6); PG8_BAR;
    for (;;) {
        const bool has_next = S.next(ui + 1, nxt);
        if (has_next) { PG8_ROWS(vn, nxt); }
        else {
#pragma unroll
            for (int h = 0; h < 2; ++h)
#pragma unroll
                for (int i = 0; i < 2; ++i) vn[h][i] = va[h][i]; }
        const char* nB = has_next ? S.b_base(nxt) : cB;
        for (int t = 0; t < nt; t += 2) {
            const bool last = (t == nt - 2);
            const char* a1 = cA + (size_t)(t + 1) * kstep;
            const char* a2 = last ? cA : cA + (size_t)(t + 2) * kstep; const char* b2 = last ? nB : cB + (size_t)(t + 2) * kstep;
            const char* a3 = a2 + kstep; const char* b3 = b2 + kstep;
            PG8_LDB(B0, 0, 0); PG8_LDB(B1, 0, 1); PG8_SCHED; PG8_LDA(At, 0, 0); PG8_STAGE(PG8_SA(1, 1), a1, va[1]);
            if (last) {
#pragma unroll
                for (int h = 0; h < 2; ++h)
#pragma unroll
                    for (int i = 0; i < 2; ++i) va[h][i] = vn[h][i]; }
            PG8_WAIT_V(8); PG8_WAIT_L(0); PG8_BAR; PG8_MMA(0, 0, At, B0); PG8_MMA(0, 1, At, B1); PG8_BAR; PG8_SCHED;
            PG8_LDA(At, 0, 1); PG8_STAGE(PG8_SB(0, 0), b2, voffB); PG8_STAGE(PG8_SB(0, 1), b2 + hstep, voffB); PG8_STAGE(PG8_SA(0, 0), a2, va[0]);
            PG8_WAIT_V(8); PG8_WAIT_L(0); PG8_BAR; PG8_MMA(1, 0, At, B0); PG8_MMA(1, 1, At, B1); PG8_BAR; PG8_SCHED;
            PG8_LDB(B0, 1, 0); PG8_LDB(B1, 1, 1); PG8_SCHED; PG8_LDA(At, 1, 0); PG8_STAGE(PG8_SA(0, 1), a2, va[1]);
            PG8_WAIT_V(8); PG8_WAIT_L(0); PG8_BAR; PG8_MMA(0, 0, At, B0); PG8_MMA(0, 1, At, B1); PG8_BAR; PG8_SCHED;
            PG8_LDA(At, 1, 1); PG8_STAGE(PG8_SB(1, 0), b3, voffB); PG8_STAGE(PG8_SB(1, 1), b3 + hstep, voffB); PG8_STAGE(PG8_SA(1, 0), a3, va[0]);
            PG8_WAIT_V(8); PG8_WAIT_L(0); PG8_BAR; PG8_MMA(1, 0, At, B0); PG8_MMA(1, 1, At, B1); PG8_BAR; PG8_SCHED;
        }
        if (wr == 0) PG8_BAR;
        E(acc, cur, wr, wc, fr, fq, ui);
        if (!has_next) break;
#pragma unroll
        for (int a = 0; a < 2; ++a)
#pragma unroll
            for (int b = 0; b < 2; ++b)
#pragma unroll
                for (int m = 0; m < 4; ++m)
#pragma unroll
                    for (int n = 0; n < 2; ++n) acc[a][b][m][n] = (f32x4){0.f, 0.f, 0.f, 0.f};
        cur = nxt; cB = nB; ++ui;
        if (wr == 1) PG8_BAR;
    }
    PG8_WAIT_V(0);
    PG8_BAR;
#undef PG8_SA
#undef PG8_SB
#undef PG8_STAGE
#undef PG8_LDA
#undef PG8_LDB
#undef PG8_MMA
#undef PG8_CAT
#undef PG8_WAIT_V
#undef PG8_WAIT_L
#undef PG8_BAR
#undef PG8_SCHED
#undef PG8_ROWS
}

struct DenseOrder {
    int nM, nN, nwg, G, c; const bf16_t* Bt; int K;
    __device__ __forceinline__ void init(int M, int N, int G_, int c_, const bf16_t* Bt_, int K_) { nM = M / BM; nN = N / BM; nwg = nM * nN; G = G_; c = c_; Bt = Bt_; K = K_; }
    __device__ __forceinline__ bool next(int i, Unit& u) const {
        const long L = (long)i * G + c; if (L >= nwg) return false;
        int wgid = (int)L; { const int q = nwg / NXCD, r = nwg % NXCD, xcd = wgid % NXCD, off = wgid / NXCD; wgid = (xcd < r ? xcd * (q + 1) : r * (q + 1) + (xcd - r) * q) + off; }
        const int nig = 8 * nN, gid = wgid / nig, fm = gid * 8, gsz = (nM - fm) < 8 ? (nM - fm) : 8;
        u.pm = fm + ((wgid % nig) % gsz); u.pn = (wgid % nig) / gsz; u.e = 0; u.mt = u.pm; u.nv = 256; u.ord = 0; return true;
    }
    __device__ __forceinline__ const char* b_base(const Unit& u) const { return (const char*)Bt + (size_t)u.pn * 256 * K * 2; }
    __device__ __forceinline__ int a_row(const Unit& u, int r) const { return u.pm * 256 + r; }
};
}

struct EpiInProj {
    static constexpr bool PERM = true;
    bf16* P;
    __device__ __forceinline__ void operator()(const f32x4 (&acc)[2][2][4][2], const pg8::Unit& u, int wr, int wc, int fr, int fq, int ui) const {
        asm volatile("" : "+v"(fr), "+v"(fq));
        const int row0 = u.pm * 256 + wr * 64 + fr, col0 = u.pn * 256 + wc * 32 + 8 * fq; const bool act = u.pn < 8;
#pragma unroll
        for (int ai = 0; ai < 2; ++ai)
#pragma unroll
            for (int m = 0; m < 4; ++m) { bf16* rowp = P + (size_t)(row0 + ai * 128 + m * 16) * NP + col0;
#pragma unroll
                for (int bj = 0; bj < 2; ++bj) { f32x4 v0 = acc[ai][bj][m][0], v1 = acc[ai][bj][m][1];
                    if (act) { pg8::f32x2 a = pg8::gelu_pk((pg8::f32x2){v0[0], v0[1]}), b = pg8::gelu_pk((pg8::f32x2){v0[2], v0[3]}), c = pg8::gelu_pk((pg8::f32x2){v1[0], v1[1]}), d = pg8::gelu_pk((pg8::f32x2){v1[2], v1[3]});
                        v0 = (f32x4){a.x, a.y, b.x, b.y}; v1 = (f32x4){c.x, c.y, d.x, d.y}; }
                    u32x4 w; w.x = pg8::cvt_pk_bf16(v0[0], v0[1]); w.y = pg8::cvt_pk_bf16(v0[2], v0[3]); w.z = pg8::cvt_pk_bf16(v1[0], v1[1]); w.w = pg8::cvt_pk_bf16(v1[2], v1[3]);
                    *(u32x4*)(rowp + bj * 128) = w; } }
    }
};
struct EpiOutProj {
    static constexpr bool PERM = true;
    bf16* Z; const bf16* HN; const float* MOD;
    __device__ __forceinline__ void operator()(const f32x4 (&acc)[2][2][4][2], const pg8::Unit& u, int wr, int wc, int fr, int fq, int ui) const {
        asm volatile("" : "+v"(fr), "+v"(fq));
        const int row0 = u.pm * 256 + wr * 64 + fr, col0 = u.pn * 256 + wc * 32 + 8 * fq;
        const float* g1 = MOD + ((u.pm * 256) / SEQ) * (6 * D) + 2 * D;
        f32x4 gv[2][2];
#pragma unroll
        for (int bj = 0; bj < 2; ++bj)
#pragma unroll
            for (int n = 0; n < 2; ++n) gv[bj][n] = *(const f32x4*)(g1 + col0 + bj * 128 + 4 * n);
#pragma unroll
        for (int ai = 0; ai < 2; ++ai)
#pragma unroll
            for (int m = 0; m < 4; ++m) { const size_t ro = (size_t)(row0 + ai * 128 + m * 16) * D + col0;
#pragma unroll
                for (int bj = 0; bj < 2; ++bj) { const u32x4 h = *(const u32x4*)(HN + ro + bj * 128); const f32x4 a0 = acc[ai][bj][m][0], a1 = acc[ai][bj][m][1], g0 = gv[bj][0], g1v = gv[bj][1];
                    u32x4 o; o.x = pk2(ALPHA * bflo(h.x) + g0.x * a0.x, ALPHA * bfhi(h.x) + g0.y * a0.y); o.y = pk2(ALPHA * bflo(h.y) + g0.z * a0.z, ALPHA * bfhi(h.y) + g0.w * a0.w);
                    o.z = pk2(ALPHA * bflo(h.z) + g1v.x * a1.x, ALPHA * bfhi(h.z) + g1v.y * a1.y); o.w = pk2(ALPHA * bflo(h.w) + g1v.z * a1.z, ALPHA * bfhi(h.w) + g1v.w * a1.w);
                    *(u32x4*)(Z + ro + bj * 128) = o; } }
    }
};
struct EpiGateUp {
    static constexpr bool PERM = true;
    unsigned char* ACT; const LAS bf16* BT;
    __device__ __forceinline__ void operator()(const f32x4 (&acc)[2][2][4][2], const pg8::Unit& u, int wr, int wc, int fr, int fq, int ui) const {
        asm volatile("" : "+v"(fr), "+v"(fq));
        const int j0 = u.pn * 128 + wc * 32 + 8 * fq;
        const unsigned bt = (unsigned)(size_t)BT + (unsigned)(ui * 256 + wc * 32 + 8 * fq) * 2u;
        const f32x4 rg = lds_rd_b128(bt), ru = lds_rd_b128(bt + 256);
        const u32x4 rgu = __builtin_bit_cast(u32x4, rg), ruu = __builtin_bit_cast(u32x4, ru);
        const f32x4 bg0 = {bflo(rgu.x), bfhi(rgu.x), bflo(rgu.y), bfhi(rgu.y)}, bg1 = {bflo(rgu.z), bfhi(rgu.z), bflo(rgu.w), bfhi(rgu.w)};
        const f32x4 bu0 = {bflo(ruu.x), bfhi(ruu.x), bflo(ruu.y), bfhi(ruu.y)}, bu1 = {bflo(ruu.z), bfhi(ruu.z), bflo(ruu.w), bfhi(ruu.w)};
#pragma unroll
        for (int ai = 0; ai < 2; ++ai)
#pragma unroll
            for (int m = 0; m < 4; ++m) { const int i = ai * 128 + wr * 64 + m * 16 + fr;
                f32x4 g0 = acc[ai][0][m][0] + bg0, g1 = acc[ai][0][m][1] + bg1, u0 = acc[ai][1][m][0] + bu0, u1 = acc[ai][1][m][1] + bu1; float r[8];
#pragma unroll
                for (int q = 0; q < 4; ++q) { float g = fminf(g0[q], 7.f), up = fminf(fmaxf(u0[q], -7.f), 7.f); r[q] = (up + 1.f) * g * __builtin_amdgcn_rcpf(1.f + __builtin_amdgcn_exp2f(-2.4554669595930156f * g));
                    g = fminf(g1[q], 7.f); up = fminf(fmaxf(u1[q], -7.f), 7.f); r[4 + q] = (up + 1.f) * g * __builtin_amdgcn_rcpf(1.f + __builtin_amdgcn_exp2f(-2.4554669595930156f * g)); }
                int w0 = __builtin_amdgcn_cvt_pk_fp8_f32(r[0], r[1], 0, false); w0 = __builtin_amdgcn_cvt_pk_fp8_f32(r[2], r[3], w0, true);
                int w1 = __builtin_amdgcn_cvt_pk_fp8_f32(r[4], r[5], 0, false); w1 = __builtin_amdgcn_cvt_pk_fp8_f32(r[6], r[7], w1, true);
                u32x2 w; w.x = (unsigned)w0; w.y = (unsigned)w1;
                if (i < u.nv) *(u32x2*)(ACT + ((size_t)u.pm * 256 + i) * D + j0) = w; }
    }
};
struct EpiDown {
    static constexpr bool PERM = true;
    unsigned char* YB; const LAS float* BT; const LAS int* LT;
    __device__ __forceinline__ void operator()(const f32x4 (&acc)[2][2][4][2], const pg8::Unit& u, int wr, int wc, int fr, int fq, int ui) const {
        asm volatile("" : "+v"(fr), "+v"(fq));
        const int col0 = u.pn * 256 + wc * 32 + 8 * fq;
        f32x4 bv[2][2];
#pragma unroll
        for (int bj = 0; bj < 2; ++bj)
#pragma unroll
            for (int n = 0; n < 2; ++n) bv[bj][n] = lds_rd_b128((unsigned)(size_t)BT + (unsigned)(ui * 256 + wc * 32 + 8 * fq + bj * 128 + 4 * n) * 4u);
#pragma unroll
        for (int ai = 0; ai < 2; ++ai)
#pragma unroll
            for (int m = 0; m < 4; ++m) { const int i = ai * 128 + wr * 64 + m * 16 + fr;
                if (i < u.nv) { const int flat = lds_rd_b32((unsigned)(size_t)LT + (unsigned)(ui * 256 + i) * 4u); unsigned char* rowp = YB + (size_t)flat * D + col0;
#pragma unroll
                    for (int bj = 0; bj < 2; ++bj) { const f32x4 v0 = (acc[ai][bj][m][0] + bv[bj][0]) * YSC, v1 = (acc[ai][bj][m][1] + bv[bj][1]) * YSC;
                        int w0 = __builtin_amdgcn_cvt_pk_fp8_f32(v0[0], v0[1], 0, false); w0 = __builtin_amdgcn_cvt_pk_fp8_f32(v0[2], v0[3], w0, true);
                        int w1 = __builtin_amdgcn_cvt_pk_fp8_f32(v1[0], v1[1], 0, false); w1 = __builtin_amdgcn_cvt_pk_fp8_f32(v1[2], v1[3], w1, true);
                        u32x2 w; w.x = (unsigned)w0; w.y = (unsigned)w1;
                        *(u32x2*)(rowp + bj * 128) = w; } } }
    }
};
struct InProjOrder {
    int G, c; const bf16* Bt;
    __device__ __forceinline__ bool next(int i, pg8::Unit& u) const {
        const int L = i * G + c; if (L >= 1304) return false;
        if (L < 1280) { int wgid = L; { const int q = 1280 / 8, xcd = wgid % 8, off = wgid / 8; wgid = xcd * q + off; }
            const int nig = 8 * 20, gid = wgid / nig, fm = gid * 8; u.pm = fm + ((wgid % nig) % 8); u.pn = (wgid % nig) / 8; }
        else { const int j = L - 1280; u.pm = 64 + j / 6; u.pn = 10 + j % 6; }
        u.e = 0; u.mt = u.pm; u.nv = 256; u.ord = 0; return true;
    }
    __device__ __forceinline__ const char* b_base(const pg8::Unit& u) const { return (const char*)Bt + (size_t)u.pn * 256 * D * 2; }
    __device__ __forceinline__ int a_row(const pg8::Unit& u, int r) const { return u.pm * 256 + r; }
};
template <bool GATHER> struct MoeOrder {
    const LAS int* tb; const LAS int* cn; int NT, G, c; const void* Bt; size_t estride; const int* LIST; int rowb;
    const LAS int* UT;
    const LAS unsigned short* RL;
    __device__ __forceinline__ bool search(int i, pg8::Unit& u) const {
        const int nwg = tb[NE] * NT; const long L = (long)i * G + c; if (L >= nwg) return false;
        int v = (int)L; { const int q = nwg / 8, r = nwg % 8, xcd = v % 8, off = v / 8; v = (xcd < r ? xcd * (q + 1) : r * (q + 1) + (xcd - r) * q) + off; }
        int e = 0; while (v >= tb[e + 1] * NT) ++e;
        const int local = v - tb[e] * NT, mte = tb[e + 1] - tb[e];
        u.e = e; u.mt = local % mte; u.pn = local / mte; u.pm = tb[e] + u.mt; const int rem = cn[e] - u.mt * 256; u.nv = rem < 256 ? rem : 256; return true;
    }
    __device__ __forceinline__ void build(LAS int* ut, int tid) const {
        if (tid < 32) { pg8::Unit u; const bool ok = search(tid, u); ut[4 * tid] = ok ? u.e : -1; ut[4 * tid + 1] = u.mt; ut[4 * tid + 2] = u.pn; ut[4 * tid + 3] = u.nv; }
    }
    int utv;
    int utp;
    __device__ __forceinline__ void pack(int lane) { const int l = lane & 31; const int e = UT[4 * l]; utv = e < 0 ? -1 : (e | (UT[4 * l + 2] << 5) | (UT[4 * l + 1] << 9) | (UT[4 * l + 3] << 16)); utp = e < 0 ? 0 : tb[e] + UT[4 * l + 1]; }
    __device__ __forceinline__ bool next(int i, pg8::Unit& u) const {
        if (i >= 32) return false;
        const int w = __builtin_amdgcn_readlane(utv, i); if (w < 0) return false;
        u.e = w & 31; u.pn = (w >> 5) & 15; u.mt = (w >> 9) & 127; u.nv = (w >> 16) & 511; u.pm = __builtin_amdgcn_readlane(utp, i); u.ord = i; return true;
    }
    __device__ __forceinline__ const char* b_base(const pg8::Unit& u) const { return (const char*)Bt + (size_t)u.e * estride + (size_t)u.pn * 256 * rowb; }
    __device__ __forceinline__ int a_row(const pg8::Unit& u, int r) const {
        if constexpr (GATHER) return (int)lds_rd_u16((unsigned)(size_t)RL + (unsigned)(u.ord * 256 + (r < u.nv ? r : 0)) * 2u);
        else return u.pm * 256 + r;
    }
};

__device__ __forceinline__ void item8_load(const float* W, int N, int k0, int n0, int lane, f32x4 (&rg)[16]) {
#pragma unroll
    for (int i = 0; i < 16; ++i) rg[i] = __builtin_nontemporal_load((const f32x4*)(W + (size_t)(k0 + 8 * i + (lane >> 3)) * N + n0 + 4 * (lane & 7)));
}
__device__ __forceinline__ void item8_finish(int K, unsigned char* WT, int k0, int r0, LAS float* scr, int lane, const f32x4 (&rg)[16]) {
#pragma unroll
    for (int i = 0; i < 16; ++i) { LAS float* d = scr + (8 * i + (lane >> 3)) * 33 + 4 * (lane & 7); d[0] = rg[i].x; d[1] = rg[i].y; d[2] = rg[i].z; d[3] = rg[i].w; }
    LDS_WAIT();
    const int c = lane & 7;
#pragma unroll
    for (int j = 0; j < 4; ++j) { const int n = (lane >> 3) + 8 * j; const LAS float* sp = scr + (16 * c) * 33 + n; int w[4];
#pragma unroll
        for (int q = 0; q < 4; ++q) { w[q] = __builtin_amdgcn_cvt_pk_fp8_f32(sp[(4 * q) * 33] * 256.f, sp[(4 * q + 1) * 33] * 256.f, 0, false); w[q] = __builtin_amdgcn_cvt_pk_fp8_f32(sp[(4 * q + 2) * 33] * 256.f, sp[(4 * q + 3) * 33] * 256.f, w[q], true); }
        u32x4 o; o.x = (unsigned)w[0]; o.y = (unsigned)w[1]; o.z = (unsigned)w[2]; o.w = (unsigned)w[3];
        *(u32x4*)(WT + (size_t)(r0 + n) * K + k0 + 16 * c) = o; }
    LDS_WAIT();
}

struct Args { const float* in[29]; float* out; unsigned char* ws; int ph_lo, ph_hi; };

__global__ void __launch_bounds__(NTHREADS, 2) fwd(Args args) {
    extern __shared__ __attribute__((aligned(16))) unsigned char lds_raw[];
    LAS unsigned char* lds = (LAS unsigned char*)lds_raw;
    volatile LAS unsigned* MISC = (volatile LAS unsigned*)(lds + MISC_OFF);
    const int tid = threadIdx.x, lane = tid & 63, wave = __builtin_amdgcn_readfirstlane(tid >> 6);
    const int G = gridDim.x, bid = blockIdx.x;
    const int gw = bid * NWAVES + wave, NGW = G * NWAVES;
    unsigned char* ws = args.ws;
    unsigned* ctl = (unsigned*)(ws + WS_CTL);
    const float* x = args.in[0]; const float* cvec = args.in[1]; const float* ctx = args.in[2]; const float* c_ctx = args.in[3];
    const float* ln_in_g = args.in[4]; const float* ln_in_b = args.in[5]; const float* w_ada = args.in[6]; const float* b_ada = args.in[7];
    const float* w_in = args.in[8]; const float* cm_norm_g = args.in[9]; const float* cm_norm_b = args.in[10]; const float* cm_w_s = args.in[11];
    const float* cm_b_s = args.in[12]; const float* wgk_f = args.in[13]; const float* bgk_f = args.in[14]; const float* wgk_b = args.in[15];
    const float* bgk_b = args.in[16]; const float* gla_norm_g = args.in[17]; const float* w_out = args.in[18]; const float* ln1_g = args.in[19];
    const float* ln1_b = args.in[20]; const float* w_router = args.in[21]; const float* b_router = args.in[22]; const float* w_gu = args.in[23];
    const float* b_gu = args.in[24]; const float* w_dn = args.in[25]; const float* b_dn = args.in[26]; const float* ln2_g = args.in[27]; const float* ln2_b = args.in[28];
    float* out = args.out;
    float* MOD = (float*)(ws + WS_MOD);
    bf16* WinT = (bf16*)(ws + WS_WIN); bf16* WoutT = (bf16*)(ws + WS_WOUT); unsigned char* WguT = (unsigned char*)(ws + WS_WGU); unsigned char* WdnT = (unsigned char*)(ws + WS_WDN);
    bf16* HN = (bf16*)(ws + WS_HN); bf16* HM = (bf16*)(ws + WS_HM); bf16* P = (bf16*)(ws + WS_P); float* LR = (float*)(ws + WS_LR);
    bf16* ACAT = (bf16*)(ws + WS_ACAT); float* OF = (float*)(ws + WS_OF); float* OB = (float*)(ws + WS_OB); bf16* Z = (bf16*)(ws + WS_Z);
    bf16* H1 = (bf16*)(ws + WS_H1); bf16* HM2 = (bf16*)(ws + WS_HM2); float* TOPW = (float*)(ws + WS_TOPW); unsigned* TOPEP = (unsigned*)(ws + WS_TOPEP);
    int* LIST = (int*)(ws + WS_LIST); unsigned char* ACT = (unsigned char*)(ws + WS_ACT); unsigned char* YB = ws + WS_YB;
    unsigned* CNT = ctl + CW_CNT;
    unsigned char* HM2F8 = ws + WS_HM2F8;
    bf16* HM2LO = (bf16*)(ws + WS_HM2LO); bf16* WRH = (bf16*)(ws + WS_MOD + 512 * 1024); bf16* WRL = (bf16*)(ws + WS_MOD + 640 * 1024);
    bf16* QEF = (bf16*)(ws + WS_ACT); bf16* QEB = (bf16*)(ws + WS_ACT + 18 * MiB); bf16* KDF = (bf16*)(ws + WS_ACT + 36 * MiB); bf16* KDB = (bf16*)(ws + WS_ACT + 54 * MiB);
    bf16* VTg = (bf16*)(ws + WS_ACT + 72 * MiB); float* DECF = (float*)(ws + WS_ACT + 108 * MiB); float* DECB = (float*)(ws + WS_ACT + 109 * MiB); float* OI = (float*)(ws + WS_ACT + 110 * MiB);

    for (int u = tid; u < (LDS_BYTES - 131072) / 4; u += NTHREADS) ((LAS unsigned*)(lds + 131072))[u] = 0u;
    LBAR();
    XcdBarrier bar; bar.bar = ctl + CW_BAR; bar.x = 0; bar.st = nullptr;
    if (MK_ONE_LAUNCH) bar = xcd_barrier_post(ctl + CW_BAR, MISC + 8);
    const int lo = args.ph_lo, hi = args.ph_hi;
#define IN(k) (lo <= (k) && (k) < hi)
#define SEAM(k) do { if (IN(k) && IN((k) + 1)) xcd_barrier(bar); } while (0)
#define MOE_LOAD(r_, RG) do { int rr_ = (r_); \
        if (rr_ < 65536) { const int e_ = rr_ / 2048, q_ = rr_ % 2048; item8_load(w_gu + (size_t)e_ * 2048 * 4096, 4096, 128 * (q_ / 128), 32 * (q_ % 128), lane, RG); } \
        else { rr_ -= 65536; const int e_ = rr_ / 1024, q_ = rr_ % 1024; item8_load(w_dn + (size_t)e_ * 2048 * 2048, D, 128 * (q_ / 64), 32 * (q_ % 64), lane, RG); } } while (0)
#define MOE_FIN(r_, RG) do { LAS float* scr_ = (LAS float*)(lds + wave * 16896); int rr_ = (r_); \
        if (rr_ < 65536) { const int e_ = rr_ / 2048, q_ = rr_ % 2048, n0_ = 32 * (q_ % 128), half_ = n0_ / 2048, j0_ = n0_ % 2048; \
            item8_finish(D, WguT + (size_t)e_ * 4096 * 2048, 128 * (q_ / 128), 256 * (j0_ / 128) + 128 * half_ + (j0_ % 128), scr_, lane, RG); } \
        else { rr_ -= 65536; const int e_ = rr_ / 1024, q_ = rr_ % 1024; item8_finish(D, WdnT + (size_t)e_ * 2048 * 2048, 128 * (q_ / 64), 32 * (q_ % 64), scr_, lane, RG); } } while (0)
#define MOE_RANGE(first_, end_, stride_) do { f32x4 rgA_[16], rgB_[16]; int ia_ = (first_); if (ia_ < (end_)) MOE_LOAD(ia_, rgA_); \
        while (ia_ < (end_)) { const int ib_ = ia_ + (stride_); if (ib_ < (end_)) MOE_LOAD(ib_, rgB_); MOE_FIN(ia_, rgA_); if (ib_ >= (end_)) break; \
            ia_ = ib_ + (stride_); if (ia_ < (end_)) MOE_LOAD(ia_, rgA_); MOE_FIN(ib_, rgB_); } } while (0)
    const int Gc = G - NCVB; const bool is_conv = bid >= Gc;
    const int NGWc = Gc * NWAVES;
#define CONV_SLICE(first_, count_) MOE_RANGE((first_) + (bid - Gc) * NWAVES + wave, (first_) + (count_), NCVB * NWAVES)

    if (IN(0)) {
        {
            LAS float* sc = (LAS float*)lds;
            LAS float* red = (LAS float*)(lds + 40960);
            if (bid < 192) {
                for (int i = tid; i < 5 * D; i += NTHREADS) { const int r = i / D, k = i % D; const float v = r < 4 ? cvec[r * D + k] : c_ctx[k]; sc[i] = siluf(v); }
                LBAR();
            }
            for (int u = bid; u < 192; u += G) {
                const int cg = tid & 15, kg = tid >> 4, n0 = u * 64 + cg * 4;
                float acc[5][4];
#pragma unroll
                for (int r = 0; r < 5; ++r)
#pragma unroll
                    for (int j = 0; j < 4; ++j) acc[r][j] = 0.f;
#pragma unroll 16
                for (int kk = 0; kk < 64; ++kk) { const int k = kg * 64 + kk; const f32x4 w = *(const f32x4*)(w_ada + (size_t)k * (6 * D) + n0);
#pragma unroll
                    for (int r = 0; r < 5; ++r) { const float s = sc[r * D + k]; acc[r][0] += s * w.x; acc[r][1] += s * w.y; acc[r][2] += s * w.z; acc[r][3] += s * w.w; } }
#pragma unroll
                for (int r = 0; r < 5; ++r)
#pragma unroll
                    for (int j = 0; j < 4; ++j) red[(kg * 5 + r) * 64 + cg * 4 + j] = acc[r][j];
                LBAR();
                if (tid < 320) { const int r = tid / 64, cidx = tid % 64; float s = 0.f;
                    for (int g2 = 0; g2 < 32; ++g2) s += red[(g2 * 5 + r) * 64 + cidx];
                    MOD[r * (6 * D) + u * 64 + cidx] = s + b_ada[u * 64 + cidx]; }
                LBAR();
            }
            LBAR();
            asm volatile("s_waitcnt vmcnt(0)" ::: "memory"); __syncthreads();
            if (tid == 0 && bid < 192) { __builtin_amdgcn_fence(__ATOMIC_RELEASE, "agent"); asm volatile("s_waitcnt vmcnt(0)" ::: "memory"); __hip_atomic_fetch_add(ctl + CW_MODCNT, 1u, RLX_AGENT); }
        }
        {
            LAS float* scr = (LAS float*)(lds + wave * 16896);
            constexpr int I_IN = 32 * 161, I_OUT = 32 * 64;
            for (int it = gw; it < I_IN + I_OUT; it += NGW) {
                int r = it;
                if (r < I_IN) { const int kb = r / 161, nb = r % 161; transpose_item(w_in, D, DIN, WinT, 64 * kb, 32 * nb, 32 * nb, scr, lane); continue; } r -= I_IN;
                { const int kb = r / 64, nb = r % 64; transpose_item(w_out, D, D, WoutT, 64 * kb, 32 * nb, 32 * nb, scr, lane); }
            }
            MOE_RANGE(gw, CV_P0, NGW);
        }
        for (int i = gw * 64 + lane; i < D * NE; i += NGW * 64) { const int k = i >> 5, e = i & 31; const float w = w_router[i]; const unsigned hi = f2bf(w); WRH[(size_t)e * D + k] = (bf16)hi; WRL[(size_t)e * D + k] = (bf16)f2bf(w - bf2f(hi)); }
        if (tid == 0) { const unsigned want = G < 192 ? (unsigned)G : 192u; unsigned sp = 0;
            while (__hip_atomic_load(ctl + CW_MODCNT, RLX_AGENT) < want) { __builtin_amdgcn_s_sleep(2); if (++sp > (1u << 22)) break; }
            __builtin_amdgcn_fence(__ATOMIC_ACQUIRE, "agent"); asm volatile("s_waitcnt vmcnt(0)" ::: "memory"); }
        __syncthreads();
        for (int m0 = gw; m0 < MR; m0 += 2 * NGW) {
            f32x4 vv[2][8];
#pragma unroll
            for (int t2 = 0; t2 < 2; ++t2) { const int m = (m0 + t2 * NGW) < MR ? m0 + t2 * NGW : m0; const float* xr = m < T ? x + (size_t)m * D : ctx + (size_t)(m - T) * D;
#pragma unroll
                for (int j = 0; j < 8; ++j) vv[t2][j] = *(const f32x4*)(xr + 4 * (lane + 64 * j)); }
#pragma unroll
            for (int t2 = 0; t2 < 2; ++t2) { const int m = m0 + t2 * NGW; if (m >= MR) break;
                const float* shp = MOD + (m < T ? m / SEQ : 4) * (6 * D); const float* scp = shp + D;
                f32x4 v[8]; float s = 0.f;
#pragma unroll
                for (int j = 0; j < 8; ++j) { v[j] = vv[t2][j]; s += (v[j].x + v[j].y) + (v[j].z + v[j].w); }
                const float mean = wave_sum(s) * (1.f / D); float s2 = 0.f;
#pragma unroll
                for (int j = 0; j < 8; ++j) { v[j] = v[j] - mean; s2 += (v[j].x * v[j].x + v[j].y * v[j].y) + (v[j].z * v[j].z + v[j].w * v[j].w); }
                const float rstd = 1.f / sqrtf(wave_sum(s2) * (1.f / D) + LN_EPS);
#pragma unroll
                for (int j = 0; j < 8; ++j) { const int c = 4 * (lane + 64 * j); const f32x4 g = *(const f32x4*)(ln_in_g + c), bb = *(const f32x4*)(ln_in_b + c);
                    f32x4 hh; hh.x = v[j].x * rstd * g.x + bb.x; hh.y = v[j].y * rstd * g.y + bb.y; hh.z = v[j].z * rstd * g.z + bb.z; hh.w = v[j].w * rstd * g.w + bb.w;
                    u32x2 o; o.x = pk2(hh.x, hh.y); o.y = pk2(hh.z, hh.w);
                    *(u32x2*)(HN + (size_t)m * D + c) = o;
                    const f32x4 s4 = *(const f32x4*)(shp + c), c4 = *(const f32x4*)(scp + c);
                    o.x = pk2(hh.x * (1.f + c4.x) + s4.x, hh.y * (1.f + c4.y) + s4.y); o.y = pk2(hh.z * (1.f + c4.z) + s4.z, hh.w * (1.f + c4.w) + s4.w);
                    *(u32x2*)(HM + (size_t)m * D + c) = o; }
            }
        }
    }
    SEAM(0);


    if (IN(2) && is_conv) CONV_SLICE(CV_P0, CV2);
    if (IN(2) && !is_conv) {
        for (int u = gw; u < MR / 32; u += NGWc) {
            const int row0 = u * 32;
            auto arow = [=](int i) { return HM + (size_t)(row0 + i) * D; };
            auto brow = [=](int j, int) { return WinT + (size_t)(NP + j) * D; };
            auto epi = [=](int i, int j, float v, float) { LR[(size_t)(row0 + i) * 32 + j] = v; };
            wave_gemm32<1>(arow, brow, epi, D, lane);
        }
        asm volatile("s_waitcnt vmcnt(0)" ::: "memory"); LBAR();
        InProjOrder S{Gc, bid, WinT};
        EpiInProj E{P};
        pg8::gemm_phase<EpiInProj, InProjOrder>(lds, HM, D, S, E);
        if (bid >= 1304 - 5 * Gc) MOE_RANGE(CV_P0 + CV2 + (bid - (1304 - 5 * Gc)) * NWAVES + wave, CV_P0 + CV2 + CV2X, (6 * Gc - 1304) * NWAVES);
    }
    SEAM(2);

    if (IN(3)) {
        LAS float* LRs = (LAS float*)lds;
        LAS float* PART = (LAS float*)(lds + 8192);
        LAS bf16* QEs = (LAS bf16*)(lds + 10240);
        LAS bf16* KEs = (LAS bf16*)(lds + 27648);
        LAS bf16* ATTs = (LAS bf16*)(lds + 45056);
        LAS bf16* VTs = (LAS bf16*)(lds + 54272);
        LAS bf16* Qs = (LAS bf16*)(lds + 91136);
        LAS bf16* Ks = (LAS bf16*)(lds + 108544);
        for (int u = bid; u < NBATCH * 68 * 4; u += G) {
            const int h = u & 3, bc = u >> 2, b = bc / 68, c = bc % 68; const bool lat = c >= 4;
            const int row0 = lat ? b * SEQ + (c - 4) * 64 : T + b * CTX + c * 64;
            const int d = tid & 127, tq = tid >> 7;
            const f32x4 lr4 = *(const f32x4*)(LR + (size_t)(row0 + (tid >> 3)) * 32 + (tid & 7) * 4);
            u32x4 vraw[4];
#pragma unroll
            for (int i = 0; i < 4; ++i) { const int ch = tid + 512 * i, sx = ch & 63, e8 = ch >> 6; vraw[i] = *(const u32x4*)(P + (size_t)(row0 + sx) * NP + C_VG + h * 256 + e8 * 8); }
            u32x4 qk4[4];
#pragma unroll
            for (int i = 0; i < 2; ++i) { const int ch = tid + 512 * i, t = ch >> 4, c16 = ch & 15; const bf16* pr = P + (size_t)(row0 + t) * NP + h * 128 + c16 * 8; qk4[i] = *(const u32x4*)(pr + C_Q); qk4[2 + i] = *(const u32x4*)(pr + C_K); }
            float wg[2][16], bias2[2];
#pragma unroll
            for (int r = 0; r < 16; ++r) { wg[0][r] = wgk_f[r * 512 + h * 128 + d]; wg[1][r] = wgk_b[r * 512 + h * 128 + d]; }
            bias2[0] = bgk_f[h * 128 + d]; bias2[1] = bgk_b[h * 128 + d];
            *(LAS f32x4*)(LRs + (tid >> 3) * 32 + (tid & 7) * 4) = lr4;
#pragma unroll
            for (int i = 0; i < 2; ++i) { const int ch = tid + 512 * i, t = ch >> 4, c16 = ch & 15; *(LAS u32x4*)(Qs + t * 136 + c16 * 8) = qk4[i]; *(LAS u32x4*)(Ks + t * 136 + c16 * 8) = qk4[2 + i]; }
#pragma unroll
            for (int i = 0; i < 4; ++i) { const int ch = tid + 512 * i, sx = ch & 63, e8 = ch >> 6; const unsigned ww[4] = {vraw[i].x, vraw[i].y, vraw[i].z, vraw[i].w};
#pragma unroll
                for (int j = 0; j < 4; ++j) { VTs[(e8 * 8 + 2 * j) * 72 + sx] = (bf16)(ww[j] & 0xffffu); VTs[(e8 * 8 + 2 * j + 1) * 72 + sx] = (bf16)(ww[j] >> 16); } }
            LBAR();
#pragma unroll
            for (int i = 0; i < 4; ++i) { const int ch = tid + 512 * i, e = ch >> 3, c8 = ch & 7; *(u32x4*)(VTg + ((size_t)u * 256 + e) * 64 + c8 * 8) = *(const LAS u32x4*)(VTs + e * 72 + c8 * 8); }
            bf16 qraw[16], kraw[16];
#pragma unroll
            for (int i = 0; i < 16; ++i) { qraw[i] = Qs[(16 * tq + i) * 136 + d]; kraw[i] = Ks[(16 * tq + i) * 136 + d]; }
            f32x4 att[2]; att[0] = (f32x4){0.f, 0.f, 0.f, 0.f}; att[1] = att[0];
#pragma unroll
            for (int dir = 0; dir < 2; ++dir) {
                bf16* QEg = dir ? QEB : QEF; bf16* KDg = dir ? KDB : KDF; float* DECg = dir ? DECB : DECF;
                const float (&w)[16] = wg[dir]; const float bias = bias2[dir];
                float cs[16];
#pragma unroll
                for (int i = 0; i < 16; ++i) { const LAS float* lr = LRs + (16 * tq + i) * 32 + dir * 16; float pre = bias;
#pragma unroll
                    for (int r4 = 0; r4 < 4; ++r4) { const f32x4 l4 = *(const LAS f32x4*)(lr + 4 * r4); pre += l4.x * w[4 * r4] + l4.y * w[4 * r4 + 1] + l4.z * w[4 * r4 + 2] + l4.w * w[4 * r4 + 3]; }
                    cs[i] = (fminf(pre, 0.f) - __logf(1.f + __expf(-fabsf(pre)))) * (1.f / 16.f); }
                if (dir == 0) {
#pragma unroll
                    for (int i = 1; i < 16; ++i) cs[i] += cs[i - 1];
                    PART[tq * 128 + d] = cs[15];
                } else {
#pragma unroll
                    for (int i = 14; i >= 0; --i) cs[i] += cs[i + 1];
                    PART[tq * 128 + d] = cs[0];
                }
                LBAR();
                const float p0 = PART[d], p1 = PART[128 + d], p2 = PART[256 + d], p3 = PART[384 + d]; const float blast = (p0 + p1) + (p2 + p3);
                float off;
                if (dir == 0) off = (tq > 0 ? p0 : 0.f) + (tq > 1 ? p1 : 0.f) + (tq > 2 ? p2 : 0.f);
                else off = (tq < 3 ? p3 : 0.f) + (tq < 2 ? p2 : 0.f) + (tq < 1 ? p1 : 0.f);
                unsigned kdp[8];
#pragma unroll
                for (int i = 0; i < 16; ++i) { const int t = 16 * tq + i; const float bcm = off + cs[i];
                    const float q = bf2f(qraw[i]) * 0.08838834764831845f, k = bf2f(kraw[i]);
                    const unsigned qe = f2bf(q * __expf(bcm)), ke = f2bf(k * __expf(-bcm)), kd = f2bf(k * __expf(blast - bcm));
                    QEs[t * 136 + d] = (bf16)qe; KEs[t * 136 + d] = (bf16)ke;
                    if (i & 1) kdp[i >> 1] |= kd << 16; else kdp[i >> 1] = kd; }
                { u32x4 k0, k1; k0.x = kdp[0]; k0.y = kdp[1]; k0.z = kdp[2]; k0.w = kdp[3]; k1.x = kdp[4]; k1.y = kdp[5]; k1.z = kdp[6]; k1.w = kdp[7];
                  bf16* kr = KDg + ((size_t)u * 128 + d) * 64 + 16 * tq; *(u32x4*)kr = k0; *(u32x4*)(kr + 8) = k1; }
                if (tq == 0) DECg[(size_t)u * 128 + d] = expf(blast);
                LBAR();
                if (lat) {
#pragma unroll
                    for (int i = 0; i < 2; ++i) { const int ch = tid + 512 * i, t = ch >> 4, c8 = ch & 15, g16 = c8 >> 1, hh2 = c8 & 1;
                        const u32x2 lo = *(const LAS u32x2*)(QEs + t * 136 + 16 * g16 + 4 * hh2), hi = *(const LAS u32x2*)(QEs + t * 136 + 16 * g16 + 8 + 4 * hh2);
                        u32x4 o; o.x = lo.x; o.y = lo.y; o.z = hi.x; o.w = hi.y; *(u32x4*)(QEg + ((size_t)u * 64 + t) * 128 + c8 * 8) = o; }
                    const int tr = wave >> 1, tc0 = 2 * (wave & 1), r16 = lane & 15, q4 = lane >> 4;
                    f32x4 tmp[2]; tmp[0] = (f32x4){0.f, 0.f, 0.f, 0.f}; tmp[1] = tmp[0];
#pragma unroll
                    for (int ks = 0; ks < 4; ++ks) { const bf16x8 a = *(const LAS bf16x8*)(QEs + (16 * tr + r16) * 136 + 32 * ks + 8 * q4);
#pragma unroll
                        for (int n = 0; n < 2; ++n) { const bf16x8 bb = *(const LAS bf16x8*)(KEs + (16 * (tc0 + n) + r16) * 136 + 32 * ks + 8 * q4);
                            tmp[n] = __builtin_amdgcn_mfma_f32_16x16x32_bf16(a, bb, tmp[n], 0, 0, 0); } }
#pragma unroll
                    for (int n = 0; n < 2; ++n)
#pragma unroll
                        for (int rg = 0; rg < 4; ++rg) { const int t = 16 * tr + 4 * q4 + rg, sx = 16 * (tc0 + n) + r16; const bool keep = dir == 0 ? sx <= t : sx >= t; att[n][rg] += keep ? tmp[n][rg] : 0.f; }
                }
                LBAR();
            }
            if (lat) {
                { const int tr = wave >> 1, tc0 = 2 * (wave & 1), r16 = lane & 15, q4 = lane >> 4;
#pragma unroll
                  for (int n = 0; n < 2; ++n)
#pragma unroll
                      for (int rg = 0; rg < 4; ++rg) ATTs[(16 * tr + 4 * q4 + rg) * 72 + 16 * (tc0 + n) + r16] = (bf16)f2bf(att[n][rg]); }
                LBAR();
                const int r16 = lane & 15, q4 = lane >> 4;
                f32x4 oa[4][2];
#pragma unroll
                for (int tr = 0; tr < 4; ++tr) { oa[tr][0] = (f32x4){0.f, 0.f, 0.f, 0.f}; oa[tr][1] = oa[tr][0]; }
#pragma unroll
                for (int ks = 0; ks < 2; ++ks) { bf16x8 bb[2];
#pragma unroll
                    for (int n = 0; n < 2; ++n) bb[n] = *(const LAS bf16x8*)(VTs + (16 * (2 * wave + n) + r16) * 72 + 32 * ks + 8 * q4);
#pragma unroll
                    for (int tr = 0; tr < 4; ++tr) { const bf16x8 a = *(const LAS bf16x8*)(ATTs + (16 * tr + r16) * 72 + 32 * ks + 8 * q4);
#pragma unroll
                        for (int n = 0; n < 2; ++n) oa[tr][n] = __builtin_amdgcn_mfma_f32_16x16x32_bf16(a, bb[n], oa[tr][n], 0, 0, 0); } }
#pragma unroll
                for (int tr = 0; tr < 4; ++tr)
#pragma unroll
                    for (int n = 0; n < 2; ++n)
#pragma unroll
                        for (int rg = 0; rg < 4; ++rg) OI[(size_t)(row0 + 16 * tr + 4 * q4 + rg) * 1024 + h * 256 + 16 * (2 * wave + n) + r16] = oa[tr][n][rg];
            }
            LBAR();
        }
    }
    SEAM(3);

    if (IN(4)) {
        if (bid < 64) {
            const int bhd = bid >> 1, eh = bid & 1, b = bhd >> 3, h = (bhd >> 1) & 3, dir = bhd & 1;
            const bf16* QEg = dir ? QEB : QEF; const bf16* KDg = dir ? KDB : KDF; const float* DECg = dir ? DECB : DECF; float* O = dir ? OB : OF;
            constexpr int GBUF = 55296;
            if (wave >= 4) {
                const int pt = tid - 256;
                u32x4 R0_[13], R1_[13], R2_[13];
#define G2_PLOAD(R, n) do { const int c_ = dir ? ((n) < 4 ? 3 - (n) : 71 - (n)) : (n); const size_t u_ = (size_t)(b * 68 + c_) * 4 + h; \
                    _Pragma("unroll") for (int i_ = 0; i_ < 4; ++i_) { const int q_ = pt + 256 * i_; R[i_] = c_ >= 4 ? *(const u32x4*)(QEg + u_ * 8192 + (size_t)q_ * 8) : (u32x4){0u, 0u, 0u, 0u}; \
                        R[4 + i_] = *(const u32x4*)(KDg + u_ * 8192 + (size_t)q_ * 8); R[8 + i_] = *(const u32x4*)(VTg + (u_ * 256 + eh * 128) * 64 + (size_t)q_ * 8); } \
                    R[12] = *(const u32x4*)(DECg + u_ * 128 + (pt & 31) * 4); } while (0)
#define G2_PSTORE(R, bb) do { LAS unsigned char* base_ = lds + (bb) * GBUF; \
                    _Pragma("unroll") for (int i_ = 0; i_ < 4; ++i_) { const int q_ = pt + 256 * i_; *(LAS u32x4*)(base_ + (q_ >> 4) * 272 + (q_ & 15) * 16) = R[i_]; \
                        *(LAS u32x4*)(base_ + 17408 + (q_ >> 3) * 144 + (q_ & 7) * 16) = R[4 + i_]; *(LAS u32x4*)(base_ + 36352 + (q_ >> 3) * 144 + (q_ & 7) * 16) = R[8 + i_]; } \
                    if (pt < 32) *(LAS u32x4*)(base_ + 35840 + pt * 16) = R[12]; } while (0)
                G2_PLOAD(R0_, 0); G2_PLOAD(R1_, 1); G2_PLOAD(R2_, 2); G2_PSTORE(R0_, 0); G2_PLOAD(R0_, 3);
                LBAR();
#pragma unroll 1
                for (int n = 0; n < 66; n += 3) {
                    G2_PSTORE(R1_, (n + 1) & 1); if (n + 4 < 68) G2_PLOAD(R1_, n + 4); LBAR();
                    G2_PSTORE(R2_, (n + 2) & 1); if (n + 5 < 68) G2_PLOAD(R2_, n + 5); LBAR();
                    G2_PSTORE(R0_, (n + 3) & 1); if (n + 6 < 68) G2_PLOAD(R0_, n + 6); LBAR();
                }
                G2_PSTORE(R1_, 1); LBAR();
                LBAR();
#undef G2_PLOAD
#undef G2_PSTORE
            } else {
                const int ws = eh * 4 + wave, r = lane & 31, hh = lane >> 5;
                __builtin_amdgcn_s_setprio(2);
                typedef float f32x16 __attribute__((ext_vector_type(16)));
                f32x16 S[4];
#pragma unroll
                for (int dt = 0; dt < 4; ++dt)
#pragma unroll
                    for (int i = 0; i < 16; ++i) S[dt][i] = 0.f;
                LBAR();
#pragma unroll 1
                for (int n = 0; n < 68; ++n) {
                    const int c = dir ? (n < 4 ? 3 - n : 71 - n) : n;
                    const LAS unsigned char* base = lds + (n & 1) * GBUF;
                    if (c >= 4) {
                        f32x16 o[2];
#pragma unroll
                        for (int i = 0; i < 16; ++i) { o[0][i] = 0.f; o[1][i] = 0.f; }
#pragma unroll
                        for (int dt = 0; dt < 4; ++dt)
#pragma unroll
                            for (int s2 = 0; s2 < 2; ++s2) {
                                u32x4 pk; pk.x = pk2(S[dt][8 * s2], S[dt][8 * s2 + 1]); pk.y = pk2(S[dt][8 * s2 + 2], S[dt][8 * s2 + 3]); pk.z = pk2(S[dt][8 * s2 + 4], S[dt][8 * s2 + 5]); pk.w = pk2(S[dt][8 * s2 + 6], S[dt][8 * s2 + 7]);
                                const bf16x8 bs = __builtin_bit_cast(bf16x8, pk);
#pragma unroll
                                for (int tt = 0; tt < 2; ++tt) { const bf16x8 a = *(const LAS bf16x8*)(base + (32 * tt + r) * 272 + (32 * dt + 16 * s2 + 8 * hh) * 2);
                                    o[tt] = __builtin_amdgcn_mfma_f32_32x32x16_bf16(a, bs, o[tt], 0, 0, 0); }
                            }
                        float* orow = O + (size_t)(b * SEQ + (c - 4) * 64) * 1024 + h * 256 + 32 * ws + r;
#pragma unroll
                        for (int tt = 0; tt < 2; ++tt)
#pragma unroll
                            for (int i = 0; i < 16; ++i) orow[(size_t)(32 * tt + (i & 3) + 8 * (i >> 2) + 4 * hh) * 1024] = o[tt][i];
                    }
                    bf16x8 vt[4];
#pragma unroll
                    for (int s4 = 0; s4 < 4; ++s4) vt[s4] = *(const LAS bf16x8*)(base + 36352 + (32 * wave + r) * 144 + (16 * s4 + 8 * hh) * 2);
#pragma unroll
                    for (int dt = 0; dt < 4; ++dt)
#pragma unroll
                        for (int g4 = 0; g4 < 4; ++g4) { const f32x4 dc = *(const LAS f32x4*)(base + 35840 + (32 * dt + 8 * g4 + 4 * hh) * 4);
                            S[dt][4 * g4] *= dc.x; S[dt][4 * g4 + 1] *= dc.y; S[dt][4 * g4 + 2] *= dc.z; S[dt][4 * g4 + 3] *= dc.w; }
#pragma unroll
                    for (int s4 = 0; s4 < 4; ++s4)
#pragma unroll
                        for (int dt = 0; dt < 4; ++dt) { const bf16x8 a = *(const LAS bf16x8*)(base + 17408 + (32 * dt + r) * 144 + (16 * s4 + 8 * hh) * 2);
                            S[dt] = __builtin_amdgcn_mfma_f32_32x32x16_bf16(a, vt[s4], S[dt], 0, 0, 0); }
                    LBAR();
                }
                __builtin_amdgcn_s_setprio(0);
            }
        } else {
            LAS float* stat = (LAS float*)lds;
            LAS float* gn = (LAS float*)(lds + 1024);
            LAS float* bn = (LAS float*)(lds + 5120);
            LAS float* bsl = (LAS float*)(lds + 9216);
            LAS bf16* Ws = (LAS bf16*)(lds + 13312);
            LAS bf16* VnT = (LAS bf16*)(lds + 48128);
            {
                for (int i = tid; i < 1024; i += NTHREADS) { gn[i] = cm_norm_g[i]; bn[i] = cm_norm_b[i]; bsl[i] = cm_b_s[i]; }
                LBAR();
                for (int u = bid - 64; u < NBATCH * 32 * 2; u += G - 64) {
                    const int r0 = (u >> 1) * 128, h0 = (u & 1) * 4, r16 = lane & 15, q4 = lane >> 4;
#pragma unroll 1
                    for (int qb = 0; qb < 16; qb += 8) {
                        u32x4 ra[8], rb[8];
#pragma unroll
                        for (int j = 0; j < 8; ++j) { const bf16* vr = P + (size_t)(r0 + wave * 16 + qb + j) * NP + C_V + 16 * lane; ra[j] = *(const u32x4*)vr; rb[j] = *(const u32x4*)(vr + 8); }
#pragma unroll
                        for (int j = 0; j < 8; ++j) {
                            const float f[16] = {bflo(ra[j].x), bfhi(ra[j].x), bflo(ra[j].y), bfhi(ra[j].y), bflo(ra[j].z), bfhi(ra[j].z), bflo(ra[j].w), bfhi(ra[j].w), bflo(rb[j].x), bfhi(rb[j].x), bflo(rb[j].y), bfhi(rb[j].y), bflo(rb[j].z), bfhi(rb[j].z), bflo(rb[j].w), bfhi(rb[j].w)};
                            float sm = 0.f;
#pragma unroll
                            for (int i = 0; i < 16; ++i) sm += f[i];
                            const float mean = wave_sum(sm) * (1.f / 1024.f); float s2 = 0.f;
#pragma unroll
                            for (int i = 0; i < 16; ++i) { const float dl = f[i] - mean; s2 += dl * dl; }
                            const float rstd = 1.f / sqrtf(wave_sum(s2) * (1.f / 1024.f) + LN_EPS);
                            if (lane == 0) { stat[2 * (wave * 16 + qb + j)] = mean; stat[2 * (wave * 16 + qb + j) + 1] = rstd; }
                        }
                    }
                    f32x4 wreg[8]; u32x4 vreg[4]; u32x2 ureg[8];
#define CM_LOAD(h_) do { int t_ = tid; asm volatile("" : "+v"(t_)); _Pragma("unroll") for (int i_ = 0; i_ < 8; ++i_) { const int ch_ = t_ + 512 * i_; wreg[i_] = *(const f32x4*)(cm_w_s + ((size_t)(h_) * 128 + (ch_ >> 5)) * 128 + 4 * (ch_ & 31)); } \
                        _Pragma("unroll") for (int i_ = 0; i_ < 4; ++i_) { const int ch_ = t_ + 512 * i_; vreg[i_] = *(const u32x4*)(P + (size_t)(r0 + (ch_ & 127)) * NP + C_V + (h_) * 128 + (ch_ >> 7) * 8); } } while (0)
                    CM_LOAD(h0);
                    LBAR();
#pragma unroll 1
                    for (int h = h0; h < h0 + 4; ++h) {
#pragma unroll
                        for (int tp = 0; tp < 8; ++tp) ureg[tp] = *(const u32x2*)(P + (size_t)(r0 + 16 * tp + r16) * NP + C_U + h * 128 + 16 * wave + 4 * q4);
#pragma unroll
                        for (int i = 0; i < 8; ++i) { const int ch = tid + 512 * i; u32x2 o; o.x = pk2(wreg[i].x, wreg[i].y); o.y = pk2(wreg[i].z, wreg[i].w); *(LAS u32x2*)(Ws + (ch >> 5) * 136 + 4 * (ch & 31)) = o; }
#pragma unroll
                        for (int i = 0; i < 4; ++i) { const int ch = tid + 512 * i, q = ch & 127, e8 = ch >> 7; const u32x4 w = vreg[i];
                            const float mean = stat[2 * q], rstd = stat[2 * q + 1]; const LAS float* gp = gn + h * 128 + e8 * 8; const LAS float* bp = bn + h * 128 + e8 * 8;
                            const f32x4 g0 = *(const LAS f32x4*)gp, g1 = *(const LAS f32x4*)(gp + 4), b0 = *(const LAS f32x4*)bp, b1 = *(const LAS f32x4*)(bp + 4);
                            const float vv[8] = {bflo(w.x), bfhi(w.x), bflo(w.y), bfhi(w.y), bflo(w.z), bfhi(w.z), bflo(w.w), bfhi(w.w)};
                            const float gg[8] = {g0.x, g0.y, g0.z, g0.w, g1.x, g1.y, g1.z, g1.w}, bb[8] = {b0.x, b0.y, b0.z, b0.w, b1.x, b1.y, b1.z, b1.w};
#pragma unroll
                            for (int j = 0; j < 8; ++j) VnT[(e8 * 8 + j) * 136 + q] = (bf16)f2bf((vv[j] - mean) * rstd * gg[j] + bb[j]); }
                        if (h + 1 < h0 + 4) CM_LOAD(h + 1);
                        LBAR();
                        f32x4 acc[8];
#pragma unroll
                        for (int tp = 0; tp < 8; ++tp) acc[tp] = (f32x4){0.f, 0.f, 0.f, 0.f};
#pragma unroll
                        for (int ks = 0; ks < 4; ++ks) { const bf16x8 a = *(const LAS bf16x8*)(VnT + (16 * wave + r16) * 136 + 32 * ks + 8 * q4);
#pragma unroll
                            for (int tp = 0; tp < 8; ++tp) { const bf16x8 bq = *(const LAS bf16x8*)(Ws + (16 * tp + r16) * 136 + 32 * ks + 8 * q4);
                                acc[tp] = __builtin_amdgcn_mfma_f32_16x16x32_bf16(a, bq, acc[tp], 0, 0, 0); } }
#pragma unroll
                        for (int tp = 0; tp < 8; ++tp) { const int pp = 16 * tp + r16, e0 = 16 * wave + 4 * q4; const float bs = bsl[h * 128 + pp]; const u32x2 uu = ureg[tp];
                            u32x2 o; o.x = pk2(bflo(uu.x) * (acc[tp][0] + bs), bfhi(uu.x) * (acc[tp][1] + bs)); o.y = pk2(bflo(uu.y) * (acc[tp][2] + bs), bfhi(uu.y) * (acc[tp][3] + bs));
                            *(u32x2*)(ACAT + (size_t)(r0 + pp) * D + h * 128 + e0) = o; }
                        LBAR();
                    }
#undef CM_LOAD
                }
            }
            if (wave < 4) MOE_RANGE(CV_P0 + CV2 + CV2X + CV3 + (bid - 64) * 4 + wave, CV_P0 + CV2 + CV2X + CV3 + CV4, (G - 64) * 4);
        }
    }
    SEAM(4);

    if (IN(5) && is_conv) CONV_SLICE(CV_P0 + CV2 + CV2X + CV3 + CV4, CV5);
    if (IN(5) && !is_conv) {
        const int c0 = 16 * lane; float ng[16];
#pragma unroll
        for (int j = 0; j < 4; ++j) { const f32x4 g4 = *(const f32x4*)(gla_norm_g + ((c0 + 4 * j) & 255)); ng[4 * j] = g4.x; ng[4 * j + 1] = g4.y; ng[4 * j + 2] = g4.z; ng[4 * j + 3] = g4.w; }
        for (int m0 = gw; m0 < T; m0 += 2 * NGWc) {
            f32x4 ra[2][4], rb[2][4], ri[2][4]; u32x4 rg[2][2];
#pragma unroll
            for (int t2 = 0; t2 < 2; ++t2) { const int m = (m0 + t2 * NGWc) < T ? m0 + t2 * NGWc : m0;
#pragma unroll
                for (int j = 0; j < 4; ++j) { ra[t2][j] = *(const f32x4*)(OF + (size_t)m * 1024 + c0 + 4 * j); rb[t2][j] = *(const f32x4*)(OB + (size_t)m * 1024 + c0 + 4 * j); ri[t2][j] = *(const f32x4*)(OI + (size_t)m * 1024 + c0 + 4 * j); }
                rg[t2][0] = *(const u32x4*)(P + (size_t)m * NP + C_GO + c0); rg[t2][1] = *(const u32x4*)(P + (size_t)m * NP + C_GO + c0 + 8); }
#pragma unroll
            for (int t2 = 0; t2 < 2; ++t2) { const int m = m0 + t2 * NGWc; if (m >= T) break;
                float o[16];
#pragma unroll
                for (int j = 0; j < 4; ++j) { const f32x4 a = ra[t2][j], b2 = rb[t2][j], i3 = ri[t2][j];
                    o[4 * j] = (a.x + b2.x) + i3.x; o[4 * j + 1] = (a.y + b2.y) + i3.y; o[4 * j + 2] = (a.z + b2.z) + i3.z; o[4 * j + 3] = (a.w + b2.w) + i3.w; }
                float ss = 0.f;
#pragma unroll
                for (int j = 0; j < 16; ++j) ss += o[j] * o[j];
                ss += __shfl_xor(ss, 1); ss += __shfl_xor(ss, 2); ss += __shfl_xor(ss, 4); ss += __shfl_xor(ss, 8);
                const float rms = 1.f / sqrtf(ss * (1.f / 256.f) + RMS_EPS);
                const unsigned gw8[8] = {rg[t2][0].x, rg[t2][0].y, rg[t2][0].z, rg[t2][0].w, rg[t2][1].x, rg[t2][1].y, rg[t2][1].z, rg[t2][1].w};
                float r[16];
#pragma unroll
                for (int j = 0; j < 8; ++j) { const float g0 = bflo(gw8[j]), g1 = bfhi(gw8[j]);
                    r[2 * j] = o[2 * j] * rms * ng[2 * j] * g0 * __builtin_amdgcn_rcpf(1.f + __expf(-g0)); r[2 * j + 1] = o[2 * j + 1] * rms * ng[2 * j + 1] * g1 * __builtin_amdgcn_rcpf(1.f + __expf(-g1)); }
                u32x4 w0, w1; w0.x = pk2(r[0], r[1]); w0.y = pk2(r[2], r[3]); w0.z = pk2(r[4], r[5]); w0.w = pk2(r[6], r[7]);
                w1.x = pk2(r[8], r[9]); w1.y = pk2(r[10], r[11]); w1.z = pk2(r[12], r[13]); w1.w = pk2(r[14], r[15]);
                *(u32x4*)(ACAT + (size_t)m * D + 1024 + c0) = w0; *(u32x4*)(ACAT + (size_t)m * D + 1024 + c0 + 8) = w1; }
        }
    }
    SEAM(5);

    if (IN(6)) {
        pg8::DenseOrder S; S.init(T, D, G, bid, WoutT, D);
        EpiOutProj E{Z, HN, MOD};
        pg8::gemm_phase<EpiOutProj, pg8::DenseOrder>(lds, ACAT, D, S, E);
    }
    SEAM(6);

    if (IN(7)) {
        LAS float* part = (LAS float*)lds;
        LAS float* lgt = (LAS float*)(lds + 32768);
        LAS int* selE = (LAS int*)(lds + 36864);
        LAS unsigned* lcnt = (LAS unsigned*)(lds + 36864 + 512);
        LAS unsigned* gbs = lcnt + 32;
        if (tid < 32) lcnt[tid] = 0u;
        typedef float f32x16 __attribute__((ext_vector_type(16)));
        LAS float* LG1 = (LAS float*)(lds + 40960); LAS float* LB1 = LG1 + D; LAS float* SH2 = LB1 + D; LAS float* SC2 = SH2 + D;
        for (int i = tid; i < D; i += NTHREADS) { LG1[i] = ln1_g[i]; LB1[i] = ln1_b[i]; }
        for (int g0 = bid * 32; g0 < T; g0 += G * 32) {
            { const float* sh2g = MOD + (g0 / SEQ) * (6 * D) + 3 * D; for (int i = tid; i < D; i += NTHREADS) { SH2[i] = sh2g[i]; SC2[i] = sh2g[D + i]; } }
            LBAR();
            u32x4 zc[4], zn[4];
#pragma unroll
            for (int j2 = 0; j2 < 4; ++j2) zc[j2] = *(const u32x4*)(Z + (size_t)(g0 + wave * 4) * D + 8 * (lane + 64 * j2));
#pragma unroll
            for (int j4 = 0; j4 < 4; ++j4) {
                const int m = g0 + wave * 4 + j4;
                if (j4 + 1 < 4) {
#pragma unroll
                    for (int j2 = 0; j2 < 4; ++j2) zn[j2] = *(const u32x4*)(Z + (size_t)(m + 1) * D + 8 * (lane + 64 * j2)); }
                f32x4 v[8]; float s = 0.f;
#pragma unroll
                for (int j2 = 0; j2 < 4; ++j2) { const u32x4 zz = zc[j2];
                    v[2 * j2] = (f32x4){bflo(zz.x), bfhi(zz.x), bflo(zz.y), bfhi(zz.y)}; v[2 * j2 + 1] = (f32x4){bflo(zz.z), bfhi(zz.z), bflo(zz.w), bfhi(zz.w)}; }
#pragma unroll
                for (int j = 0; j < 8; ++j) s += (v[j].x + v[j].y) + (v[j].z + v[j].w);
                const float mean = wave_sum(s) * (1.f / D); float s2 = 0.f;
#pragma unroll
                for (int j = 0; j < 8; ++j) { v[j] = v[j] - mean; s2 += (v[j].x * v[j].x + v[j].y * v[j].y) + (v[j].z * v[j].z + v[j].w * v[j].w); }
                const float rstd = 1.f / sqrtf(wave_sum(s2) * (1.f / D) + LN_EPS);
#pragma unroll
                for (int j = 0; j < 8; ++j) { const int c = 8 * (lane + 64 * (j >> 1)) + 4 * (j & 1); const f32x4 g = *(const LAS f32x4*)(LG1 + c), bb = *(const LAS f32x4*)(LB1 + c), a = *(const LAS f32x4*)(SH2 + c), sc = *(const LAS f32x4*)(SC2 + c);
                    f32x4 h; h.x = v[j].x * rstd * g.x + bb.x; h.y = v[j].y * rstd * g.y + bb.y; h.z = v[j].z * rstd * g.z + bb.z; h.w = v[j].w * rstd * g.w + bb.w;
                    u32x2 o; o.x = pk2(h.x, h.y); o.y = pk2(h.z, h.w); *(u32x2*)(H1 + (size_t)m * D + c) = o;
                    f32x4 hm; hm.x = h.x * (1.f + sc.x) + a.x; hm.y = h.y * (1.f + sc.y) + a.y; hm.z = h.z * (1.f + sc.z) + a.z; hm.w = h.w * (1.f + sc.w) + a.w;
                    o.x = pk2(hm.x, hm.y); o.y = pk2(hm.z, hm.w); *(u32x2*)(HM2 + (size_t)m * D + c) = o;
                    u32x2 l; l.x = pk2(hm.x - bflo(o.x), hm.y - bfhi(o.x)); l.y = pk2(hm.z - bflo(o.y), hm.w - bfhi(o.y)); *(u32x2*)(HM2LO + (size_t)m * D + c) = l;
                    int f8 = __builtin_amdgcn_cvt_pk_fp8_f32(hm.x, hm.y, 0, false); f8 = __builtin_amdgcn_cvt_pk_fp8_f32(hm.z, hm.w, f8, true); *(int*)(HM2F8 + (size_t)m * D + c) = f8; }
#pragma unroll
                for (int j2 = 0; j2 < 4; ++j2) zc[j2] = zn[j2];
            }
            asm volatile("s_waitcnt vmcnt(0)" ::: "memory"); __syncthreads();
            {
                const int r = lane & 31, hh = lane >> 5; f32x16 acc;
#pragma unroll
                for (int i = 0; i < 16; ++i) acc[i] = 0.f;
#pragma unroll 4
                for (int ks = 0; ks < 16; ++ks) { const int kk = 256 * wave + 16 * ks + 8 * hh;
                    const bf16x8 ahi = *(const bf16x8*)(HM2 + (size_t)(g0 + r) * D + kk), alo = *(const bf16x8*)(HM2LO + (size_t)(g0 + r) * D + kk);
                    const bf16x8 bhi = *(const bf16x8*)(WRH + (size_t)r * D + kk), blo = *(const bf16x8*)(WRL + (size_t)r * D + kk);
                    acc = __builtin_amdgcn_mfma_f32_32x32x16_bf16(ahi, bhi, acc, 0, 0, 0); acc = __builtin_amdgcn_mfma_f32_32x32x16_bf16(alo, bhi, acc, 0, 0, 0); acc = __builtin_amdgcn_mfma_f32_32x32x16_bf16(ahi, blo, acc, 0, 0, 0); }
#pragma unroll
                for (int i = 0; i < 16; ++i) part[(wave * 32 + (i & 3) + 8 * (i >> 2) + 4 * hh) * 32 + r] = acc[i];
            }
            LBAR();
#pragma unroll
            for (int j = 0; j < 2; ++j) { const int idx = tid + 512 * j; float sum = b_router[idx & 31];
#pragma unroll
                for (int w8 = 0; w8 < 8; ++w8) sum += part[w8 * 1024 + idx];
                lgt[idx] = sum; }
            LBAR();
#pragma unroll 1
            for (int j4 = 0; j4 < 4; ++j4) {
                const int tok = wave * 4 + j4, m = g0 + tok;
                float val = lane < 32 ? lgt[tok * 32 + lane] : -INFINITY; float tv[4]; int ti[4];
#pragma unroll
                for (int k = 0; k < 4; ++k) { const float mx = wave_max(val); const unsigned long long bm = __ballot(val == mx); const int idx = __ffsll((long long)bm) - 1;
                    tv[k] = mx; ti[k] = idx; if (lane == idx) val = -INFINITY; }
                const float e1 = expf(tv[1] - tv[0]), e2 = expf(tv[2] - tv[0]), e3 = expf(tv[3] - tv[0]); const float inv = 1.f / (1.f + e1 + e2 + e3);
                if (lane < 4) { const int ex = lane == 0 ? ti[0] : lane == 1 ? ti[1] : lane == 2 ? ti[2] : ti[3]; const float w = (lane == 0 ? 1.f : lane == 1 ? e1 : lane == 2 ? e2 : e3) * inv;
                    selE[tok * 4 + lane] = ex; TOPW[m * 4 + lane] = w; }
            }
            LBAR();
            int ex = 0; unsigned lpos = 0;
            if (tid < 128) { ex = selE[tid]; lpos = __hip_atomic_fetch_add(lcnt + ex, 1u, __ATOMIC_RELAXED, __HIP_MEMORY_SCOPE_WORKGROUP); }
            LBAR();
            if (tid < 32) { const unsigned c = lcnt[tid]; gbs[tid] = c ? atomicAdd(CNT + tid * 64, c) : 0u; lcnt[tid] = 0u; }
            LBAR();
            if (tid < 128) { const unsigned pos = gbs[ex] + lpos; const int m = g0 + (tid >> 2); LIST[ex * T + pos] = m * 4 + (tid & 3); TOPEP[m * 4 + (tid & 3)] = ((unsigned)ex << 16) | pos; }
        }
    }
    SEAM(7);

    if (IN(8) || IN(9)) {
        LAS int* tb = (LAS int*)(lds + TBL_OFF);
        LAS int* cn = tb + 64;
        LBAR();
        if (tid == 0) { int a = 0; for (int e = 0; e < NE; ++e) { const int c = (int)CNT[e * 64]; cn[e] = c; tb[e] = a; a += (c + 255) / 256; } tb[NE] = a; }
        LBAR();
        if (IN(8) && is_conv) CONV_SLICE(CV_GU, CV_TOT - CV_GU);
        if (IN(8) && !is_conv) {
            LAS int* UT = (LAS int*)(lds + TBL_OFF + 512);
            LAS bf16* BT = (LAS bf16*)(lds + EPT_OFF); LAS unsigned short* RL = (LAS unsigned short*)(lds + EPT_OFF + EPT_RL * 512);
            MoeOrder<true> S{tb, cn, 16, Gc, bid, WguT, (size_t)4096 * 2048, LIST, D, UT, RL};
            S.build(UT, tid); LBAR(); S.pack(lane);
            { int pr[EPT_RL]; float pv[EPT_RL]; const int t8 = tid & 255;
#pragma unroll
              for (int i = 0; i < EPT_RL; ++i) { pg8::Unit pu; const bool ok = S.next(i, pu); pr[i] = (ok && t8 < pu.nv) ? LIST[pu.e * T + pu.mt * 256 + t8] >> 2 : 0;
                  pv[i] = ok ? b_gu[(size_t)pu.e * 4096 + (t8 >> 7) * 2048 + pu.pn * 128 + (t8 & 127)] : 0.f; }
#pragma unroll
              for (int i = 0; i < EPT_RL; ++i) if (tid < 256) { RL[i * 256 + tid] = (unsigned short)pr[i]; BT[i * 256 + tid] = (bf16)f2bf(pv[i]); } }
            LBAR();
            EpiGateUp E{ACT, BT};
            pg8::gemm_phase<EpiGateUp, MoeOrder<true>, 1>(lds, HM2F8, D, S, E);
        }
        if (IN(8) && IN(9)) xcd_barrier(bar);
        if (IN(9)) {
            LAS int* UT = (LAS int*)(lds + TBL_OFF + 512);
            MoeOrder<false> S{tb, cn, 8, G, bid, WdnT, (size_t)2048 * 2048, LIST, D, UT, nullptr};
            S.build(UT, tid); LBAR(); S.pack(lane);
            LAS float* BT = (LAS float*)(lds + EPT_OFF); LAS int* LT = (LAS int*)(lds + EPT_OFF + EPT_UNITS9 * 1024);
            { float pv[EPT_UNITS9]; int pl[EPT_UNITS9]; const int t8 = tid & 255;
#pragma unroll
              for (int i = 0; i < EPT_UNITS9; ++i) { pg8::Unit pu; const bool ok = S.next(i, pu); pv[i] = ok ? b_dn[(size_t)pu.e * 2048 + pu.pn * 256 + t8] : 0.f; pl[i] = (ok && t8 < pu.nv) ? LIST[pu.e * T + pu.mt * 256 + t8] : 0; }
#pragma unroll
              for (int i = 0; i < EPT_UNITS9; ++i) if (tid < 256) { BT[i * 256 + tid] = pv[i]; LT[i * 256 + tid] = pl[i]; } }
            LBAR();
            EpiDown E{YB, BT, LT};
            pg8::gemm_phase<EpiDown, MoeOrder<false>, 1>(lds, ACT, D, S, E);
        }
    }
    SEAM(9);

    if (IN(10)) {
        LAS float* G2T = (LAS float*)lds; LAS float* LG = G2T + 4 * D; LAS float* LB = LG + D;
        for (int i = tid; i < 4 * D; i += NTHREADS) G2T[i] = MOD[(i / D) * (6 * D) + 5 * D + (i % D)];
        for (int i = tid; i < D; i += NTHREADS) { LG[i] = ln2_g[i]; LB[i] = ln2_b[i]; }
        LBAR();
        for (int m0 = gw; m0 < T; m0 += 2 * NGW) {
            u32x4 hr[2][4]; u32x2 yr[2][4][4]; f32x4 wr4[2];
#pragma unroll
            for (int t2 = 0; t2 < 2; ++t2) { const int m = (m0 + t2 * NGW) < T ? m0 + t2 * NGW : m0;
                wr4[t2] = *(const f32x4*)(TOPW + m * 4);
#pragma unroll
                for (int j = 0; j < 4; ++j) { const int c = 8 * (lane + 64 * j); hr[t2][j] = *(const u32x4*)(H1 + (size_t)m * D + c);
#pragma unroll
                    for (int k = 0; k < 4; ++k) yr[t2][j][k] = *(const u32x2*)(YB + ((size_t)m * 4 + k) * D + c); } }
#pragma unroll
            for (int t2 = 0; t2 < 2; ++t2) { const int m = m0 + t2 * NGW; if (m >= T) break;
                const LAS float* g2 = G2T + (m / SEQ) * D;
                const float w0 = wr4[t2].x, w1 = wr4[t2].y, w2 = wr4[t2].z, w3 = wr4[t2].w;
                float z[4][8]; float s = 0.f;
#pragma unroll
                for (int j = 0; j < 4; ++j) { const int c = 8 * (lane + 64 * j);
                    const u32x4 h = hr[t2][j]; const u32x2 y0 = yr[t2][j][0], y1 = yr[t2][j][1], y2 = yr[t2][j][2], y3 = yr[t2][j][3];
                    const f32x4 ga = *(const LAS f32x4*)(g2 + c), gb = *(const LAS f32x4*)(g2 + c + 4);
                    const unsigned hw[4] = {h.x, h.y, h.z, h.w}, a0[2] = {y0.x, y0.y}, a1[2] = {y1.x, y1.y}, a2[2] = {y2.x, y2.y}, a3[2] = {y3.x, y3.y};
                    const float gg[8] = {ga.x, ga.y, ga.z, ga.w, gb.x, gb.y, gb.z, gb.w};
#pragma unroll
                    for (int q = 0; q < 2; ++q)
#pragma unroll
                        for (int h2 = 0; h2 < 2; ++h2) { const int e0 = 4 * q + 2 * h2;
                            const f32v2 p0 = h2 ? __builtin_amdgcn_cvt_pk_f32_fp8((int)a0[q], true) : __builtin_amdgcn_cvt_pk_f32_fp8((int)a0[q], false), p1 = h2 ? __builtin_amdgcn_cvt_pk_f32_fp8((int)a1[q], true) : __builtin_amdgcn_cvt_pk_f32_fp8((int)a1[q], false);
                            const f32v2 p2 = h2 ? __builtin_amdgcn_cvt_pk_f32_fp8((int)a2[q], true) : __builtin_amdgcn_cvt_pk_f32_fp8((int)a2[q], false), p3 = h2 ? __builtin_amdgcn_cvt_pk_f32_fp8((int)a3[q], true) : __builtin_amdgcn_cvt_pk_f32_fp8((int)a3[q], false);
                            const float flo = (((w0 * p0.x + w1 * p1.x) + w2 * p2.x) + w3 * p3.x) * (1.f / YSC);
                            const float fhi = (((w0 * p0.y + w1 * p1.y) + w2 * p2.y) + w3 * p3.y) * (1.f / YSC);
                            const unsigned hword = hw[e0 >> 1];
                            z[j][e0] = ALPHA * bflo(hword) + gg[e0] * flo; z[j][e0 + 1] = ALPHA * bfhi(hword) + gg[e0 + 1] * fhi; s += z[j][e0] + z[j][e0 + 1]; }
                }
                const float mean = wave_sum(s) * (1.f / D); float s2 = 0.f;
#pragma unroll
                for (int j = 0; j < 4; ++j)
#pragma unroll
                    for (int q = 0; q < 8; ++q) { z[j][q] -= mean; s2 += z[j][q] * z[j][q]; }
                const float rstd = 1.f / sqrtf(wave_sum(s2) * (1.f / D) + LN_EPS);
#pragma unroll
                for (int j = 0; j < 4; ++j) { const int c = 8 * (lane + 64 * j);
                    const f32x4 ga = *(const LAS f32x4*)(LG + c), gb = *(const LAS f32x4*)(LG + c + 4), ba = *(const LAS f32x4*)(LB + c), bb = *(const LAS f32x4*)(LB + c + 4);
                    f32x4 o0, o1; o0.x = z[j][0] * rstd * ga.x + ba.x; o0.y = z[j][1] * rstd * ga.y + ba.y; o0.z = z[j][2] * rstd * ga.z + ba.z; o0.w = z[j][3] * rstd * ga.w + ba.w;
                    o1.x = z[j][4] * rstd * gb.x + bb.x; o1.y = z[j][5] * rstd * gb.y + bb.y; o1.z = z[j][6] * rstd * gb.z + bb.z; o1.w = z[j][7] * rstd * gb.w + bb.w;
                    *(f32x4*)(out + (size_t)m * D + c) = o0; *(f32x4*)(out + (size_t)m * D + c + 4) = o1; }
            }
        }
    }
#undef IN
#undef SEAM
}

extern "C" void kernel_launch(void* const* d_in, const int* in_sizes, int n_in, void* d_out, int out_size, void* d_ws, size_t ws_size, hipStream_t stream) {
    static int grid = 0;
    if (grid == 0) {
        if (n_in != 29 || out_size != T * D || ws_size < WS_END) { fprintf(stderr, "kernel_launch: unexpected shapes (n_in %d, out %d, ws %zu); nothing launched\n", n_in, out_size, ws_size); grid = -1; return; }
        int dev = 0, cus = 0, per_cu = 0;
        if (hipGetDevice(&dev) != hipSuccess || hipDeviceGetAttribute(&cus, hipDeviceAttributeMultiprocessorCount, dev) != hipSuccess) { grid = -1; return; }
        if (hipFuncSetAttribute((const void*)fwd, hipFuncAttributeMaxDynamicSharedMemorySize, LDS_BYTES) != hipSuccess) { fprintf(stderr, "kernel_launch: hipFuncSetAttribute failed\n"); grid = -1; return; }
        if (hipOccupancyMaxActiveBlocksPerMultiprocessor(&per_cu, (const void*)fwd, NTHREADS, LDS_BYTES) != hipSuccess || per_cu < 1) { fprintf(stderr, "kernel_launch: occupancy query says %d\n", per_cu); }
        (void)hipGetLastError();
        grid = cus;
    }
    if (grid < 0) return;
    if (hipMemsetAsync((char*)d_ws + WS_CTL, 0, CTL_BYTES, stream) != hipSuccess) return;
    Args a{};
    for (int i = 0; i < 29; ++i) a.in[i] = (const float*)d_in[i];
    a.out = (float*)d_out; a.ws = (unsigned char*)d_ws;
#if PROBE_DUP >= 0
    a.ph_lo = 0; a.ph_hi = PROBE_DUP + 1; hipLaunchKernelGGL(fwd, dim3(grid), dim3(NTHREADS), LDS_BYTES, stream, a);
    hipMemsetAsync((char*)d_ws + WS_CTL + CW_BAR * 4, 0, XCD_BAR_WORDS * 4, stream);
    a.ph_lo = PROBE_DUP; a.ph_hi = NPHASE; hipLaunchKernelGGL(fwd, dim3(grid), dim3(NTHREADS), LDS_BYTES, stream, a);
#elif MK_ONE_LAUNCH
    a.ph_lo = 0; a.ph_hi = NPHASE;
    hipLaunchKernelGGL(fwd, dim3(grid), dim3(NTHREADS), LDS_BYTES, stream, a);
#else
    for (int p = 0; p < NPHASE; ++p) { a.ph_lo = p; a.ph_hi = p + 1; hipLaunchKernelGGL(fwd, dim3(grid), dim3(NTHREADS), LDS_BYTES, stream, a); }
#endif
}
```

```cpp
#include <hip/hip_runtime.h>
#include <cstdio>
#include <cstdint>

#ifndef PROBE_DUP
#define PROBE_DUP -1
#endif
#ifndef PROBE_CM2
#define PROBE_CM2 0
#endif
#ifndef PROBE_XBAR
#define PROBE_XBAR 0
#endif
#ifndef MK_ONE_LAUNCH
#define MK_ONE_LAUNCH 1
#endif

#define GAS __attribute__((address_space(1)))
#define LAS __attribute__((address_space(3)))
typedef unsigned short bf16;
typedef short bf16x8 __attribute__((ext_vector_type(8)));
typedef float f32x4 __attribute__((ext_vector_type(4)));
typedef unsigned u32x4 __attribute__((ext_vector_type(4)));
typedef unsigned u32x2 __attribute__((ext_vector_type(2)));
#define RLX_AGENT __ATOMIC_RELAXED, __HIP_MEMORY_SCOPE_AGENT
#define LDS_WAIT() asm volatile("s_waitcnt lgkmcnt(0)" ::: "memory")
#define LBAR() do { asm volatile("s_waitcnt lgkmcnt(0)" ::: "memory"); __builtin_amdgcn_s_barrier(); asm volatile("" ::: "memory"); } while (0)

constexpr int D = 2048, NBATCH = 4, SEQ = 4096, T = NBATCH * SEQ, CTX = 256, TC = NBATCH * CTX, MR = T + TC;
constexpr int DIN = 5152, NP = 5120;
constexpr int C_U = 0, C_V = 1024, C_Q = 2048, C_K = 2560, C_VG = 3072, C_GO = 4096;
constexpr int NE = 32, NSLOTMAX = 73728;
constexpr float ALPHA = 1.189207115002721f;
constexpr float LN_EPS = 1e-5f, RMS_EPS = 1e-6f;
constexpr float YSC = 16.0f;
constexpr int NWAVES = 8, NTHREADS = 512;
constexpr int NPHASE = 11;
constexpr int CVSK = 1344;
constexpr int CVBG = 10752;
constexpr int NCMB = 96, CV4P0 = 4096;
constexpr int NCVB = 32, CV_GU = 65536, CV_TOT = 98304, CV2 = 20480, CV2X = 4096, CV3 = 0, CV4 = 24576, CV5 = 1536, CV_P0 = CV_GU - CV2 - CV2X - CV3 - CV4 - CV5;

constexpr size_t MiB = 1u << 20;
constexpr size_t WS_CTL = 0, CTL_BYTES = 1 * MiB;
constexpr size_t WS_MOD = 1 * MiB;
constexpr size_t WS_WIN = 4 * MiB;
constexpr size_t WS_WOUT = 26 * MiB;
constexpr size_t WS_WGU = 64 * MiB;
constexpr size_t WS_WDN = 576 * MiB;
constexpr size_t WS_HN = 832 * MiB;
constexpr size_t WS_HM = 900 * MiB;
constexpr size_t WS_P = 968 * MiB;
constexpr size_t WS_LR = 1138 * MiB;
constexpr size_t WS_ACAT = 1142 * MiB;
constexpr size_t WS_OF = 1206 * MiB;
constexpr size_t WS_OB = 1270 * MiB;
constexpr size_t WS_Z = 1334 * MiB;
constexpr size_t WS_H1 = 1462 * MiB;
constexpr size_t WS_HM2 = 1526 * MiB;
constexpr size_t WS_TOPW = 1590 * MiB;
constexpr size_t WS_TOPEP = 1591 * MiB;
constexpr size_t WS_LIST = 1592 * MiB;
constexpr size_t WS_ACT = 1594 * MiB;
constexpr size_t WS_YB = 1882 * MiB;
constexpr size_t WS_HM2LO = 2138 * MiB;
constexpr size_t WS_HM2F8 = 2202 * MiB;
constexpr size_t WS_END = 2234 * MiB;
constexpr int CW_CNT = 1024;
constexpr int CW_MODCNT = 3584;
constexpr int CW_BAR = 4096;

constexpr int LDS_BYTES = 163840;
constexpr int MISC_OFF = 135168 + 320;
constexpr int TBL_OFF = 135168 + 1024;
constexpr int EPT_OFF = 135168 + 2048;
constexpr int EPT_RL = 21, EPT_UNITS9 = 9;

typedef __bf16 bf16v2 __attribute__((ext_vector_type(2)));
typedef float f32v2 __attribute__((ext_vector_type(2)));
__device__ __forceinline__ unsigned pk2(float lo, float hi) { const f32v2 v = {lo, hi}; return __builtin_bit_cast(unsigned, __builtin_convertvector(v, bf16v2)); }
__device__ __forceinline__ unsigned f2bf(float f) { return pk2(f, 0.f) & 0xffffu; }
__device__ __forceinline__ float bf2f(unsigned b) { return __builtin_bit_cast(float, b << 16); }
__device__ __forceinline__ float bflo(unsigned w) { return __builtin_bit_cast(float, w << 16); }
__device__ __forceinline__ float bfhi(unsigned w) { return __builtin_bit_cast(float, w & 0xffff0000u); }
__device__ __forceinline__ float wave_sum(float v) {
#pragma unroll
    for (int o = 1; o < 64; o <<= 1) v += __shfl_xor(v, o);
    return v;
}
__device__ __forceinline__ float wave_max(float v) {
#pragma unroll
    for (int o = 1; o < 64; o <<= 1) v = fmaxf(v, __shfl_xor(v, o));
    return v;
}
__device__ __forceinline__ float wave_max_dpp(float x) {
#define WM_DPP(c) __builtin_bit_cast(float, __builtin_amdgcn_update_dpp(0, __builtin_bit_cast(int, x), (c), 0xF, 0xF, true))
    x = fmaxf(x, WM_DPP(0xB1)); x = fmaxf(x, WM_DPP(0x4E)); x = fmaxf(x, WM_DPP(0x141)); x = fmaxf(x, WM_DPP(0x140));
#undef WM_DPP
    float xa = x, xb = x;
    asm volatile("s_nop 1\n\tv_permlane16_swap_b32 %0, %1" : "+v"(xa), "+v"(xb));
    x = fmaxf(xa, xb); xa = x; xb = x;
    asm volatile("s_nop 1\n\tv_permlane32_swap_b32 %0, %1" : "+v"(xa), "+v"(xb));
    return fmaxf(xa, xb);
}
__device__ __forceinline__ float gelu_exact(float x) { return 0.5f * x * (1.0f + erff(x * 0.70710678118654752f)); }
__device__ __forceinline__ float siluf(float x) { return x / (1.0f + expf(-x)); }
__device__ __forceinline__ float logsigmoidf(float x) { return fminf(x, 0.f) - log1pf(expf(-fabsf(x))); }

__device__ __forceinline__ unsigned lds_rd_u16(unsigned addr) { unsigned v; asm volatile("ds_read_u16 %0, %1\n\ts_waitcnt lgkmcnt(0)" : "=v"(v) : "v"(addr) : "memory"); return v; }
__device__ __forceinline__ int lds_rd_b32(unsigned addr) { int v; asm volatile("ds_read_b32 %0, %1\n\ts_waitcnt lgkmcnt(0)" : "=v"(v) : "v"(addr) : "memory"); return v; }
__device__ __forceinline__ f32x4 lds_rd_b128(unsigned addr) { f32x4 v; asm volatile("ds_read_b128 %0, %1\n\ts_waitcnt lgkmcnt(0)" : "=v"(v) : "v"(addr) : "memory"); return v; }
#define XB_TMO      128
#define XB_XCNT(j)  (256  + 64 * (j))
#define XB_XSUB(j)  (1280 + 64 * (j))
#define XB_XGEN(j)  (2304 + 64 * (j))
#define XB_TOP      3328
#define XB_TOPGEN   3392
#define XCD_BAR_WORDS 3456
#define XB_SPIN_CAP (1u << 18)
__device__ __forceinline__ unsigned xb_ld(unsigned* p)              { return __hip_atomic_load(p, __ATOMIC_RELAXED, __HIP_MEMORY_SCOPE_AGENT); }
__device__ __forceinline__ unsigned xb_add(unsigned* p, unsigned v) { return __hip_atomic_fetch_add(p, v, __ATOMIC_RELAXED, __HIP_MEMORY_SCOPE_AGENT); }
__device__ __forceinline__ unsigned xb_xcc_id() { return (unsigned)__builtin_amdgcn_s_getreg((3 << 11) | 20) & 0xFu; }
#define XB_SPIN(cond, bar) do { unsigned _sp = 0; while (cond) { __builtin_amdgcn_s_sleep(1); \
    if ((++_sp & 255u) == 0u) { if (xb_ld(&(bar)[XB_TMO])) break; if (_sp > XB_SPIN_CAP) { atomicAdd(&(bar)[XB_TMO], 1u); break; } } } } while (0)
struct XcdBarrier { unsigned* bar; unsigned x; volatile LAS unsigned* st; };
__device__ __forceinline__ XcdBarrier xcd_barrier_post(unsigned* bar, volatile LAS unsigned* st) {
    XcdBarrier b; b.bar = bar; b.x = xb_xcc_id(); b.st = st;
    if (threadIdx.x == 0) (void)xb_add(&bar[XB_XCNT(b.x)], 1u);
    return b;
}
__device__ __forceinline__ void xcd_barrier_complete(unsigned* bar, unsigned x, unsigned& nloc, unsigned& nx) {
    const unsigned G = gridDim.x * gridDim.y * gridDim.z;
    unsigned sum, cnt, mine, sp = 0u;
    for (;;) {
        sum = 0u; cnt = 0u; mine = 0u;
#pragma unroll
        for (unsigned j = 0; j < 16; ++j) { const unsigned c = xb_ld(&bar[XB_XCNT(j)]); sum += c; cnt += (c > 0u) ? 1u : 0u; mine = (j == x) ? c : mine; }
        if (sum == G) break;
        __builtin_amdgcn_s_sleep(1);
        if ((++sp & 255u) == 0u) { if (xb_ld(&bar[XB_TMO])) break; if (sp > XB_SPIN_CAP) { atomicAdd(&bar[XB_TMO], 1u); break; } }
    }
    nloc = mine > 0u ? mine : 1u; nx = cnt > 0u ? cnt : 1u;
}
__device__ __forceinline__ void xcd_barrier(const XcdBarrier& b) {
    asm volatile("s_waitcnt vmcnt(0)" ::: "memory");
    __syncthreads();
    if (threadIdx.x == 0) {
        unsigned* bar = b.bar;
        __builtin_amdgcn_s_waitcnt(0);
        unsigned nloc = b.st[0], nx = b.st[1];
        if (nloc == 0u) { xcd_barrier_complete(bar, b.x, nloc, nx); b.st[0] = nloc; b.st[1] = nx; }
        const unsigned old = xb_add(&bar[XB_XSUB(b.x)], 1u);
        const unsigned gen = old / nloc;
        if (old + 1u == (gen + 1u) * nloc) {
            __builtin_amdgcn_fence(__ATOMIC_RELEASE, "agent");
            asm volatile("s_waitcnt vmcnt(0)" ::: "memory");
            const unsigned og = xb_add(&bar[XB_TOP], 1u);
            const unsigned tg = og / nx;
            if (og + 1u == (tg + 1u) * nx) xb_add(&bar[XB_TOPGEN], 1u);
            else XB_SPIN(xb_ld(&bar[XB_TOPGEN]) == tg, bar);
            __builtin_amdgcn_fence(__ATOMIC_ACQUIRE, "agent");
            xb_add(&bar[XB_XGEN(b.x)], 1u);
            asm volatile("s_waitcnt vmcnt(0)" ::: "memory");
        } else {
            XB_SPIN(xb_ld(&bar[XB_XGEN(b.x)]) == gen, bar);
            __builtin_amdgcn_fence(__ATOMIC_ACQUIRE, "agent");
            asm volatile("s_waitcnt vmcnt(0)" ::: "memory");
        }
    }
    __syncthreads();
}

template <class F>
__device__ __forceinline__ void xcd_barrier_bg(const XcdBarrier& b, const F& bg) {
    asm volatile("s_waitcnt vmcnt(0)" ::: "memory");
    __syncthreads();
    if (threadIdx.x == 0) {
        unsigned* bar = b.bar;
        __builtin_amdgcn_s_waitcnt(0);
        unsigned nloc = b.st[0], nx = b.st[1];
        if (nloc == 0u) { xcd_barrier_complete(bar, b.x, nloc, nx); b.st[0] = nloc; b.st[1] = nx; }
        const unsigned old = xb_add(&bar[XB_XSUB(b.x)], 1u);
        const unsigned gen = old / nloc;
        if (old + 1u == (gen + 1u) * nloc) {
            __builtin_amdgcn_fence(__ATOMIC_RELEASE, "agent");
            asm volatile("s_waitcnt vmcnt(0)" ::: "memory");
            const unsigned og = xb_add(&bar[XB_TOP], 1u);
            const unsigned tg = og / nx;
            if (og + 1u == (tg + 1u) * nx) xb_add(&bar[XB_TOPGEN], 1u);
            else XB_SPIN(xb_ld(&bar[XB_TOPGEN]) == tg, bar);
            __builtin_amdgcn_fence(__ATOMIC_ACQUIRE, "agent");
            xb_add(&bar[XB_XGEN(b.x)], 1u);
            asm volatile("s_waitcnt vmcnt(0)" ::: "memory");
        } else {
            XB_SPIN(xb_ld(&bar[XB_XGEN(b.x)]) == gen, bar);
            __builtin_amdgcn_fence(__ATOMIC_ACQUIRE, "agent");
            asm volatile("s_waitcnt vmcnt(0)" ::: "memory");
        }
    } else if (threadIdx.x >= 64) bg();
    __syncthreads();
}

template <int NB, class AR, class BR, class EP>
__device__ __forceinline__ void wave_gemm32(const AR& arow, const BR& brow, const EP& epi, int K, int lane) {
    const int r = lane & 15, kq = lane >> 4;
    const bf16* a[2]; const bf16* b[NB][2];
#pragma unroll
    for (int m = 0; m < 2; ++m) a[m] = arow(16 * m + r) + 8 * kq;
#pragma unroll
    for (int w = 0; w < NB; ++w)
#pragma unroll
        for (int n = 0; n < 2; ++n) b[w][n] = brow(16 * n + r, w) + 8 * kq;
    f32x4 acc[NB][2][2];
#pragma unroll
    for (int w = 0; w < NB; ++w)
#pragma unroll
        for (int m = 0; m < 2; ++m)
#pragma unroll
            for (int n = 0; n < 2; ++n) acc[w][m][n] = (f32x4){0.f, 0.f, 0.f, 0.f};
#pragma unroll 8
    for (int k = 0; k < K; k += 32) {
        bf16x8 af[2], bfr[NB][2];
#pragma unroll
        for (int m = 0; m < 2; ++m) af[m] = *(const bf16x8*)(a[m] + k);
#pragma unroll
        for (int w = 0; w < NB; ++w)
#pragma unroll
            for (int n = 0; n < 2; ++n) bfr[w][n] = *(const bf16x8*)(b[w][n] + k);
#pragma unroll
        for (int w = 0; w < NB; ++w)
#pragma unroll
            for (int m = 0; m < 2; ++m)
#pragma unroll
                for (int n = 0; n < 2; ++n) acc[w][m][n] = __builtin_amdgcn_mfma_f32_16x16x32_bf16(af[m], bfr[w][n], acc[w][m][n], 0, 0, 0);
    }
#pragma unroll
    for (int m = 0; m < 2; ++m)
#pragma unroll
        for (int n = 0; n < 2; ++n)
#pragma unroll
            for (int q = 0; q < 4; ++q) epi(16 * m + 4 * kq + q, 16 * n + r, acc[0][m][n][q], NB == 2 ? acc[NB - 1][m][n][q] : 0.f);
}

__device__ __forceinline__ void transpose_item(const float* W, int K, int N, bf16* WT, int k0, int n0, int r0, LAS float* scr, int lane) {
#pragma unroll
    for (int i = 0; i < 32; ++i) { const int kk = 2 * i + (lane >> 5); scr[kk * 33 + (lane & 31)] = W[(size_t)(k0 + kk) * N + n0 + (lane & 31)]; }
    LDS_WAIT();
    const int c = lane & 7;
#pragma unroll
    for (int j = 0; j < 4; ++j) { const int n = (lane >> 3) + 8 * j; const LAS float* s = scr + (8 * c) * 33 + n;
        u32x4 o; o.x = pk2(s[0 * 33], s[1 * 33]); o.y = pk2(s[2 * 33], s[3 * 33]); o.z = pk2(s[4 * 33], s[5 * 33]); o.w = pk2(s[6 * 33], s[7 * 33]);
        *(u32x4*)(WT + (size_t)(r0 + n) * K + k0 + 8 * c) = o; }
    LDS_WAIT();
}

__device__ __forceinline__ void itemb_load(const float* W, int N, int k0, int n0, int lane, f32x4 (&rg)[8]) {
#pragma unroll
    for (int i = 0; i < 8; ++i) rg[i] = __builtin_nontemporal_load((const f32x4*)(W + (size_t)(k0 + 8 * i + (lane >> 3)) * N + n0 + 4 * (lane & 7)));
}
__device__ __forceinline__ void itemb_finish(int K, bf16* WT, int k0, int r0, LAS float* scr, int lane, const f32x4 (&rg)[8]) {
#pragma unroll
    for (int i = 0; i < 8; ++i) { LAS float* d = scr + (8 * i + (lane >> 3)) * 33 + 4 * (lane & 7); d[0] = rg[i].x; d[1] = rg[i].y; d[2] = rg[i].z; d[3] = rg[i].w; }
    LDS_WAIT();
    const int c = lane & 7;
#pragma unroll
    for (int j = 0; j < 4; ++j) { const int n = (lane >> 3) + 8 * j; const LAS float* s = scr + (8 * c) * 33 + n;
        u32x4 o; o.x = pk2(s[0 * 33], s[1 * 33]); o.y = pk2(s[2 * 33], s[3 * 33]); o.z = pk2(s[4 * 33], s[5 * 33]); o.w = pk2(s[6 * 33], s[7 * 33]);
        *(u32x4*)(WT + (size_t)(r0 + n) * K + k0 + 8 * c) = o; }
    LDS_WAIT();
}

namespace pg8 {
typedef unsigned short bf16_t;
constexpr int BM = 256, BK = 64, HALF = 128, HTB = HALF * BK * 2, STAGE_BYTES = 8 * HTB, NXCD = 8;
__device__ __forceinline__ int lds_byte(int r, int c) { const int st = (r >> 4) * 2 + (c >> 5), rr = r & 15, cc = c & 31, ob = rr * 64 + cc * 2; return st * 1024 + (ob ^ (((ob >> 9) & 1) << 5)); }
__device__ __forceinline__ void stage_rc(int b, int& R, int& C) { const int st = b / 1024, sb = b % 1024, swz = sb ^ (((sb >> 9) & 1) << 5); R = (st >> 1) * 16 + swz / 64; C = (st & 1) * 32 + (swz % 64) / 2; }
__device__ __forceinline__ int perm32(int rho) { const int n = rho >> 4, i = rho & 15; return 8 * (i >> 2) + 4 * n + (i & 3); }
struct Unit { int pm, pn, e, mt, nv, ord; };
__device__ __forceinline__ unsigned cvt_pk_bf16(float lo, float hi) { unsigned r; asm volatile("v_cvt_pk_bf16_f32 %0, %1, %2" : "=v"(r) : "v"(lo), "v"(hi)); return r; }
typedef float f32x2 __attribute__((ext_vector_type(2)));
__device__ __forceinline__ f32x2 gelu_pk(f32x2 v) {
    const f32x2 av = __builtin_elementwise_abs(v), d = av * 0.2316418882f + 1.0f;
    f32x2 t; t.x = __builtin_amdgcn_rcpf(d.x); t.y = __builtin_amdgcn_rcpf(d.y);
    f32x2 q = t * 0.5307027145f + (-0.7265760135f); q = q * t + 0.7107068705f; q = q * t + (-0.142248368f); q = q * t + 0.127414796f; q = q * t;
    const f32x2 s = (v * v) * (-0.72134752044f);
    f32x2 e; e.x = __builtin_amdgcn_exp2f(s.x); e.y = __builtin_amdgcn_exp2f(s.y);
    const f32x2 m = v * (q * e), r = v - m;
    f32x2 o; o.x = v.x < 0.f ? m.x : r.x; o.y = v.y < 0.f ? m.y : r.y; return o;
}
typedef int i32x8 __attribute__((ext_vector_type(8)));
typedef int i32x4 __attribute__((ext_vector_type(4)));
template <class Epi, class Sched, int ESZ = 2>
__device__ __forceinline__ void gemm_phase(LAS unsigned char* lds, const void* A, int K, const Sched& S, const Epi& E) {
    const int tid = threadIdx.x, wid = __builtin_amdgcn_readfirstlane(tid >> 6), lane = tid & 63, wr = wid >> 2, wc = wid & 3, fr = lane & 15, fq = lane >> 4;
    const int rowb = K * ESZ, nt = rowb / 128;
    unsigned voffB[2];
#pragma unroll
    for (int i = 0; i < 2; ++i) { int R, C; stage_rc(tid * 16 + i * 8192, R, C); const int Rb = Epi::PERM ? ((R & ~31) + perm32(R & 31)) : R; voffB[i] = (unsigned)(Rb * rowb + C * 2); }
    const size_t kstep = (size_t)128;
    const size_t hstep = (size_t)HALF * rowb;
    const unsigned ldsw = (unsigned)wid * 1024u;
    const int aoff = lds_byte(wr * 64 + fr, fq * 8), boff = lds_byte(wc * 32 + fr, fq * 8);
#define PG8_SA(b, h) (((b) * 2 + (h)) * HTB)
#define PG8_SB(b, h) ((4 + (b) * 2 + (h)) * HTB)
#define PG8_STAGE(bufoff, gbase, voff) do { _Pragma("unroll") for (int _i = 0; _i < 2; ++_i) \
        __builtin_amdgcn_global_load_lds((const unsigned*)((const char*)(gbase) + (voff)[_i]), (LAS unsigned*)(lds + (bufoff) + ldsw + _i * 8192), 16, 0, 0); } while (0)
#define PG8_LDA(dst, b, h) do { _Pragma("unroll") for (int m = 0; m < 4; ++m) _Pragma("unroll") for (int k = 0; k < 2; ++k) dst[m][k] = *(const LAS bf16x8*)(lds + PG8_SA(b, h) + aoff + m * 2048 + k * 1024); } while (0)
#define PG8_LDB(dst, b, h) do { _Pragma("unroll") for (int n = 0; n < 2; ++n) _Pragma("unroll") for (int k = 0; k < 2; ++k) dst[n][k] = *(const LAS bf16x8*)(lds + PG8_SB(b, h) + boff + n * 2048 + k * 1024); } while (0)
#define PG8_CAT(x) __builtin_shufflevector(__builtin_bit_cast(i32x4, x[0]), __builtin_bit_cast(i32x4, x[1]), 0, 1, 2, 3, 4, 5, 6, 7)
#define PG8_MMA(ai, bj, At, Bt) do { __builtin_amdgcn_s_setprio(1); if constexpr (ESZ == 2) { _Pragma("unroll") for (int m = 0; m < 4; ++m) _Pragma("unroll") for (int n = 0; n < 2; ++n) _Pragma("unroll") for (int k = 0; k < 2; ++k) \
        acc[ai][bj][m][n] = __builtin_amdgcn_mfma_f32_16x16x32_bf16(Bt[n][k], At[m][k], acc[ai][bj][m][n], 0, 0, 0); } else { _Pragma("unroll") for (int m = 0; m < 4; ++m) _Pragma("unroll") for (int n = 0; n < 2; ++n) \
        acc[ai][bj][m][n] = __builtin_amdgcn_mfma_scale_f32_16x16x128_f8f6f4(PG8_CAT(Bt[n]), PG8_CAT(At[m]), acc[ai][bj][m][n], 0, 0, 0, 0x77777777, 0, 0x7f7f7f7f); } __builtin_amdgcn_s_setprio(0); } while (0)
#define PG8_WAIT_V(n) asm volatile("s_waitcnt vmcnt(" #n ")" ::: "memory")
#define PG8_WAIT_L(n) asm volatile("s_waitcnt lgkmcnt(" #n ")" ::: "memory")
#define PG8_BAR __builtin_amdgcn_s_barrier()
#define PG8_SCHED __builtin_amdgcn_sched_barrier(0)
#define PG8_ROWS(dst, u) do { int _t = threadIdx.x; asm volatile("" : "+v"(_t)); _Pragma("unroll") for (int _i = 0; _i < 2; ++_i) { int _R, _C; stage_rc(_t * 16 + _i * 8192, _R, _C); \
        _Pragma("unroll") for (int _h = 0; _h < 2; ++_h) dst[_h][_i] = (unsigned)(S.a_row(u, _h * HALF + _R) * rowb + _C * 2); } } while (0)
    Unit cur, nxt; int ui = 0;
    if (!S.next(0, cur)) return;
    f32x4 acc[2][2][4][2];
#pragma unroll
    for (int a = 0; a < 2; ++a)
#pragma unroll
        for (int b = 0; b < 2; ++b)
#pragma unroll
            for (int m = 0; m < 4; ++m)
#pragma unroll
                for (int n = 0; n < 2; ++n) acc[a][b][m][n] = (f32x4){0.f, 0.f, 0.f, 0.f};
    bf16x8 At[4][2], B0[2][2], B1[2][2];
    unsigned va[2][2], vn[2][2];
    PG8_ROWS(va, cur);
    const char* cA = (const char*)A; const char* cB = S.b_base(cur);
    PG8_WAIT_V(0);
    PG8_STAGE(PG8_SB(0, 0), cB, voffB); PG8_STAGE(PG8_SB(0, 1), cB + hstep, voffB); PG8_STAGE(PG8_SA(0, 0), cA, va[0]); PG8_STAGE(PG8_SA(0, 1), cA, va[1]);
    if (wr == 1) PG8_BAR;
    PG8_WAIT_V(2); PG8_BAR;
    PG8_STAGE(PG8_SB(1, 0), cB + kstep, voffB); PG8_STAGE(PG8_SA(1, 0), cA + kstep, va[0]); PG8_STAGE(PG8_SB(1, 1), cB + hstep + kstep, voffB);
    PG8_WAIT_V(6); PG8_BAR;
    for (;;) {
        const bool has_next = S.next(ui + 1, nxt);
        if (has_next) { PG8_ROWS(vn, nxt); }
        else {
#pragma unroll
            for (int h = 0; h < 2; ++h)
#pragma unroll
                for (int i = 0; i < 2; ++i) vn[h][i] = va[h][i]; }
        const char* nB = has_next ? S.b_base(nxt) : cB;
        for (int t = 0; t < nt; t += 2) {
            const bool last = (t == nt - 2);
            const char* a1 = cA + (size_t)(t + 1) * kstep;
            const char* a2 = last ? cA : cA + (size_t)(t + 2) * kstep; const char* b2 = last ? nB : cB + (size_t)(t + 2) * kstep;
            const char* a3 = a2 + kstep; const char* b3 = b2 + kstep;
            PG8_LDB(B0, 0, 0); PG8_LDB(B1, 0, 1); PG8_SCHED; PG8_LDA(At, 0, 0); PG8_STAGE(PG8_SA(1, 1), a1, va[1]);
            if (last) {
#pragma unroll
                for (int h = 0; h < 2; ++h)
#pragma unroll
                    for (int i = 0; i < 2; ++i) va[h][i] = vn[h][i]; }
            PG8_WAIT_V(8); PG8_WAIT_L(0); PG8_BAR; PG8_MMA(0, 0, At, B0); PG8_MMA(0, 1, At, B1); PG8_BAR; PG8_SCHED;
            PG8_LDA(At, 0, 1); PG8_STAGE(PG8_SB(0, 0), b2, voffB); PG8_STAGE(PG8_SB(0, 1), b2 + hstep, voffB); PG8_STAGE(PG8_SA(0, 0), a2, va[0]);
            PG8_WAIT_V(8); PG8_WAIT_L(0); PG8_BAR; PG8_MMA(1, 0, At, B0); PG8_MMA(1, 1, At, B1); PG8_BAR; PG8_SCHED;
            PG8_LDB(B0, 1, 0); PG8_LDB(B1, 1, 1); PG8_SCHED; PG8_LDA(At, 1, 0); PG8_STAGE(PG8_SA(0, 1), a2, va[1]);
            PG8_WAIT_V(8); PG8_WAIT_L(0); PG8_BAR; PG8_MMA(0, 0, At, B0); PG8_MMA(0, 1, At, B1); PG8_BAR; PG8_SCHED;
            PG8_LDA(At, 1, 1); PG8_STAGE(PG8_SB(1, 0), b3, voffB); PG8_STAGE(PG8_SB(1, 1), b3 + hstep, voffB); PG8_STAGE(PG8_SA(1, 0), a3, va[0]);
            PG8_WAIT_V(8); PG8_WAIT_L(0); PG8_BAR; PG8_MMA(1, 0, At, B0); PG8_MMA(1, 1, At, B1); PG8_BAR; PG8_SCHED;
        }
        if (wr == 0) PG8_BAR;
        E(acc, cur, wr, wc, fr, fq, ui);
        if (!has_next) break;
#pragma unroll
        for (int a = 0; a < 2; ++a)
#pragma unroll
            for (int b = 0; b < 2; ++b)
#pragma unroll
                for (int m = 0; m < 4; ++m)
#pragma unroll
                    for (int n = 0; n < 2; ++n) acc[a][b][m][n] = (f32x4){0.f, 0.f, 0.f, 0.f};
        cur = nxt; cB = nB; ++ui;
        if (wr == 1) PG8_BAR;
    }
    PG8_WAIT_V(0);
    PG8_BAR;
#undef PG8_SA
#undef PG8_SB
#undef PG8_STAGE
#undef PG8_LDA
#undef PG8_LDB
#undef PG8_MMA
#undef PG8_CAT
#undef PG8_WAIT_V
#undef PG8_WAIT_L
#undef PG8_BAR
#undef PG8_SCHED
#undef PG8_ROWS
}

struct DenseOrder {
    int nM, nN, nwg, G, c; const bf16_t* Bt; int K;
    __device__ __forceinline__ void init(int M, int N, int G_, int c_, const bf16_t* Bt_, int K_) { nM = M / BM; nN = N / BM; nwg = nM * nN; G = G_; c = c_; Bt = Bt_; K = K_; }
    __device__ __forceinline__ bool next(int i, Unit& u) const {
        const long L = (long)i * G + c; if (L >= nwg) return false;
        int wgid = (int)L; { const int q = nwg / NXCD, r = nwg % NXCD, xcd = wgid % NXCD, off = wgid / NXCD; wgid = (xcd < r ? xcd * (q + 1) : r * (q + 1) + (xcd - r) * q) + off; }
        const int nig = 8 * nN, gid = wgid / nig, fm = gid * 8, gsz = (nM - fm) < 8 ? (nM - fm) : 8;
        u.pm = fm + ((wgid % nig) % gsz); u.pn = (wgid % nig) / gsz; u.e = 0; u.mt = u.pm; u.nv = 256; u.ord = 0; return true;
    }
    __device__ __forceinline__ const char* b_base(const Unit& u) const { return (const char*)Bt + (size_t)u.pn * 256 * K * 2; }
    __device__ __forceinline__ int a_row(const Unit& u, int r) const { return u.pm * 256 + r; }
};
}

struct EpiInProj {
    static constexpr bool PERM = true;
    bf16* P;
    __device__ __forceinline__ void operator()(const f32x4 (&acc)[2][2][4][2], const pg8::Unit& u, int wr, int wc, int fr, int fq, int ui) const {
        asm volatile("" : "+v"(fr), "+v"(fq));
        const int row0 = u.pm * 256 + wr * 64 + fr, col0 = u.pn * 256 + wc * 32 + 8 * fq; const bool act = u.pn < 8;
#pragma unroll
        for (int ai = 0; ai < 2; ++ai)
#pragma unroll
            for (int m = 0; m < 4; ++m) { bf16* rowp = P + (size_t)(row0 + ai * 128 + m * 16) * NP + col0;
#pragma unroll
                for (int bj = 0; bj < 2; ++bj) { f32x4 v0 = acc[ai][bj][m][0], v1 = acc[ai][bj][m][1];
                    if (act) { pg8::f32x2 a = pg8::gelu_pk((pg8::f32x2){v0[0], v0[1]}), b = pg8::gelu_pk((pg8::f32x2){v0[2], v0[3]}), c = pg8::gelu_pk((pg8::f32x2){v1[0], v1[1]}), d = pg8::gelu_pk((pg8::f32x2){v1[2], v1[3]});
                        v0 = (f32x4){a.x, a.y, b.x, b.y}; v1 = (f32x4){c.x, c.y, d.x, d.y}; }
                    u32x4 w; w.x = pg8::cvt_pk_bf16(v0[0], v0[1]); w.y = pg8::cvt_pk_bf16(v0[2], v0[3]); w.z = pg8::cvt_pk_bf16(v1[0], v1[1]); w.w = pg8::cvt_pk_bf16(v1[2], v1[3]);
                    *(u32x4*)(rowp + bj * 128) = w; } }
    }
};
struct EpiOutProj {
    static constexpr bool PERM = true;
    bf16* Z; const bf16* HN; const float* MOD;
    __device__ __forceinline__ void operator()(const f32x4 (&acc)[2][2][4][2], const pg8::Unit& u, int wr, int wc, int fr, int fq, int ui) const {
        asm volatile("" : "+v"(fr), "+v"(fq));
        const int row0 = u.pm * 256 + wr * 64 + fr, col0 = u.pn * 256 + wc * 32 + 8 * fq;
        const float* g1 = MOD + ((u.pm * 256) / SEQ) * (6 * D) + 2 * D;
        f32x4 gv[2][2];
#pragma unroll
        for (int bj = 0; bj < 2; ++bj)
#pragma unroll
            for (int n = 0; n < 2; ++n) gv[bj][n] = *(const f32x4*)(g1 + col0 + bj * 128 + 4 * n);
#pragma unroll
        for (int ai = 0; ai < 2; ++ai)
#pragma unroll
            for (int m = 0; m < 4; ++m) { const size_t ro = (size_t)(row0 + ai * 128 + m * 16) * D + col0;
#pragma unroll
                for (int bj = 0; bj < 2; ++bj) { const u32x4 h = *(const u32x4*)(HN + ro + bj * 128); const f32x4 a0 = acc[ai][bj][m][0], a1 = acc[ai][bj][m][1], g0 = gv[bj][0], g1v = gv[bj][1];
                    u32x4 o; o.x = pk2(ALPHA * bflo(h.x) + g0.x * a0.x, ALPHA * bfhi(h.x) + g0.y * a0.y); o.y = pk2(ALPHA * bflo(h.y) + g0.z * a0.z, ALPHA * bfhi(h.y) + g0.w * a0.w);
                    o.z = pk2(ALPHA * bflo(h.z) + g1v.x * a1.x, ALPHA * bfhi(h.z) + g1v.y * a1.y); o.w = pk2(ALPHA * bflo(h.w) + g1v.z * a1.z, ALPHA * bfhi(h.w) + g1v.w * a1.w);
                    *(u32x4*)(Z + ro + bj * 128) = o; } }
    }
};
struct EpiGateUp {
    static constexpr bool PERM = true;
    unsigned char* ACT; const LAS bf16* BT;
    __device__ __forceinline__ void operator()(const f32x4 (&acc)[2][2][4][2], const pg8::Unit& u, int wr, int wc, int fr, int fq, int ui) const {
        asm volatile("" : "+v"(fr), "+v"(fq));
        const unsigned bt = (unsigned)(size_t)BT + (unsigned)(ui * 256 + wc * 32 + 8 * fq) * 2u;
        const f32x4 rg = lds_rd_b128(bt), ru = lds_rd_b128(bt + 256);
        const u32x4 rgu = __builtin_bit_cast(u32x4, rg), ruu = __builtin_bit_cast(u32x4, ru);
        const f32x4 bg0 = {bflo(rgu.x), bfhi(rgu.x), bflo(rgu.y), bfhi(rgu.y)}, bg1 = {bflo(rgu.z), bfhi(rgu.z), bflo(rgu.w), bfhi(rgu.w)};
        const f32x4 bu0 = {bflo(ruu.x), bfhi(ruu.x), bflo(ruu.y), bfhi(ruu.y)}, bu1 = {bflo(ruu.z), bfhi(ruu.z), bflo(ruu.w), bfhi(ruu.w)};
        constexpr float CG = -2.4554669595930156f, ICG = 1.f / CG;
        const pg8::f32x2 cbg[4] = {pg8::f32x2{bg0.x, bg0.y} * CG, pg8::f32x2{bg0.z, bg0.w} * CG, pg8::f32x2{bg1.x, bg1.y} * CG, pg8::f32x2{bg1.z, bg1.w} * CG};
        const pg8::f32x2 buc[4] = {(pg8::f32x2{bu0.x, bu0.y} + 1.f) * ICG, (pg8::f32x2{bu0.z, bu0.w} + 1.f) * ICG, (pg8::f32x2{bu1.x, bu1.y} + 1.f) * ICG, (pg8::f32x2{bu1.z, bu1.w} + 1.f) * ICG};
#pragma unroll
        for (int ai = 0; ai < 2; ++ai)
#pragma unroll
            for (int mp = 0; mp < 4; mp += 2) {
                unsigned wv[2][2];
#pragma unroll
                for (int k = 0; k < 2; ++k) { const int m = mp + k;
                    const f32x4 ga0 = acc[ai][0][m][0], ga1 = acc[ai][0][m][1], ua0 = acc[ai][1][m][0], ua1 = acc[ai][1][m][1];
                    const pg8::f32x2 gp[4] = {{ga0.x, ga0.y}, {ga0.z, ga0.w}, {ga1.x, ga1.y}, {ga1.z, ga1.w}}, upp[4] = {{ua0.x, ua0.y}, {ua0.z, ua0.w}, {ua1.x, ua1.y}, {ua1.z, ua1.w}};
                    pg8::f32x2 r[4];
#pragma unroll
                    for (int p = 0; p < 4; ++p) { pg8::f32x2 gc = gp[p] * CG + cbg[p]; gc.x = fmaxf(gc.x, 7.f * CG); gc.y = fmaxf(gc.y, 7.f * CG);
                        pg8::f32x2 uc = upp[p] * ICG + buc[p]; uc.x = __builtin_amdgcn_fmed3f(uc.x, 8.f * ICG, -6.f * ICG); uc.y = __builtin_amdgcn_fmed3f(uc.y, 8.f * ICG, -6.f * ICG);
                        pg8::f32x2 e; e.x = __builtin_amdgcn_exp2f(gc.x); e.y = __builtin_amdgcn_exp2f(gc.y); const pg8::f32x2 dd = e + 1.f;
                        pg8::f32x2 s; s.x = __builtin_amdgcn_rcpf(dd.x); s.y = __builtin_amdgcn_rcpf(dd.y); r[p] = (uc * gc) * s; }
                    int w0 = __builtin_amdgcn_cvt_pk_fp8_f32(r[0].x, r[0].y, 0, false); w0 = __builtin_amdgcn_cvt_pk_fp8_f32(r[1].x, r[1].y, w0, true);
                    int w1 = __builtin_amdgcn_cvt_pk_fp8_f32(r[2].x, r[2].y, 0, false); w1 = __builtin_amdgcn_cvt_pk_fp8_f32(r[3].x, r[3].y, w1, true);
                    wv[k][0] = (unsigned)w0; wv[k][1] = (unsigned)w1; }
                const auto s0 = __builtin_amdgcn_permlane16_swap(wv[0][0], wv[1][0], false, false), s1 = __builtin_amdgcn_permlane16_swap(wv[0][1], wv[1][1], false, false);
                u32x4 w; w.x = s0[0]; w.y = s1[0]; w.z = s0[1]; w.w = s1[1];
                const int i = ai * 128 + wr * 64 + (mp + (fq & 1)) * 16 + fr;
                if (i < u.nv) *(u32x4*)(ACT + ((size_t)u.pm * 256 + i) * D + u.pn * 128 + wc * 32 + 8 * (fq & ~1)) = w; }
    }
};
struct EpiDown {
    static constexpr bool PERM = true;
    unsigned char* YB; const LAS float* BT; const LAS int* LT;
    __device__ __forceinline__ void operator()(const f32x4 (&acc)[2][2][4][2], const pg8::Unit& u, int wr, int wc, int fr, int fq, int ui) const {
        asm volatile("" : "+v"(fr), "+v"(fq));
        f32x4 bv[2][2];
#pragma unroll
        for (int bj = 0; bj < 2; ++bj)
#pragma unroll
            for (int n = 0; n < 2; ++n) bv[bj][n] = lds_rd_b128((unsigned)(size_t)BT + (unsigned)(ui * 256 + wc * 32 + 8 * fq + bj * 128 + 4 * n) * 4u) * YSC;
#pragma unroll
        for (int ai = 0; ai < 2; ++ai)
#pragma unroll
            for (int mp = 0; mp < 4; mp += 2) {
                const int i = ai * 128 + wr * 64 + (mp + (fq & 1)) * 16 + fr;
                const int flat = lds_rd_b32((unsigned)(size_t)LT + (unsigned)(ui * 256 + (i < u.nv ? i : 0)) * 4u); unsigned char* rowp = YB + (size_t)flat * D + u.pn * 256 + wc * 32 + 8 * (fq & ~1);
#pragma unroll
                for (int bj = 0; bj < 2; ++bj) { unsigned wv[2][2];
#pragma unroll
                    for (int k = 0; k < 2; ++k) { const f32x4 v0 = acc[ai][bj][mp + k][0] * YSC + bv[bj][0], v1 = acc[ai][bj][mp + k][1] * YSC + bv[bj][1];
                        int w0 = __builtin_amdgcn_cvt_pk_fp8_f32(v0[0], v0[1], 0, false); w0 = __builtin_amdgcn_cvt_pk_fp8_f32(v0[2], v0[3], w0, true);
                        int w1 = __builtin_amdgcn_cvt_pk_fp8_f32(v1[0], v1[1], 0, false); w1 = __builtin_amdgcn_cvt_pk_fp8_f32(v1[2], v1[3], w1, true);
                        wv[k][0] = (unsigned)w0; wv[k][1] = (unsigned)w1; }
                    const auto s0 = __builtin_amdgcn_permlane16_swap(wv[0][0], wv[1][0], false, false), s1 = __builtin_amdgcn_permlane16_swap(wv[0][1], wv[1][1], false, false);
                    u32x4 w; w.x = s0[0]; w.y = s1[0]; w.z = s0[1]; w.w = s1[1];
                    if (i < u.nv) *(u32x4*)(rowp + bj * 128) = w; } }
    }
};
struct InProjOrder {
    int G, c; const bf16* Bt;
    __device__ __forceinline__ bool next(int i, pg8::Unit& u) const {
        const int L = i * G + c; if (L >= 1304) return false;
        if (L < 1280) { int wgid = L; { const int q = 1280 / 8, xcd = wgid % 8, off = wgid / 8; wgid = xcd * q + off; }
            const int nig = 8 * 20, gid = wgid / nig, fm = gid * 8; u.pm = fm + ((wgid % nig) % 8); u.pn = (wgid % nig) / 8; }
        else { const int j = L - 1280; u.pm = 64 + j / 6; u.pn = 10 + j % 6; }
        u.e = 0; u.mt = u.pm; u.nv = 256; u.ord = 0; return true;
    }
    __device__ __forceinline__ const char* b_base(const pg8::Unit& u) const { return (const char*)Bt + (size_t)u.pn * 256 * D * 2; }
    __device__ __forceinline__ int a_row(const pg8::Unit& u, int r) const { return u.pm * 256 + r; }
};
template <bool GATHER> struct MoeOrder {
    const LAS int* tb; const LAS int* cn; int NT, G, c; const void* Bt; size_t estride; const int* LIST; int rowb;
    const LAS int* UT;
    const LAS unsigned short* RL;
    __device__ __forceinline__ bool search(int i, pg8::Unit& u) const {
        const int nwg = tb[NE] * NT; const long L = (long)i * G + c; if (L >= nwg) return false;
        int v = (int)L; { const int q = nwg / 8, r = nwg % 8, xcd = v % 8, off = v / 8; v = (xcd < r ? xcd * (q + 1) : r * (q + 1) + (xcd - r) * q) + off; }
        int e = 0; while (v >= tb[e + 1] * NT) ++e;
        const int local = v - tb[e] * NT, mte = tb[e + 1] - tb[e];
        u.e = e; u.mt = local % mte; u.pn = local / mte; u.pm = tb[e] + u.mt; const int rem = cn[e] - u.mt * 256; u.nv = rem < 256 ? rem : 256; return true;
    }
    __device__ __forceinline__ void build(LAS int* ut, int tid) const {
        if (tid < 32) { pg8::Unit u; const bool ok = search(tid, u); ut[4 * tid] = ok ? u.e : -1; ut[4 * tid + 1] = u.mt; ut[4 * tid + 2] = u.pn; ut[4 * tid + 3] = u.nv; }
    }
    int utv;
    int utp;
    __device__ __forceinline__ void pack(int lane) { const int l = lane & 31; const int e = UT[4 * l]; utv = e < 0 ? -1 : (e | (UT[4 * l + 2] << 5) | (UT[4 * l + 1] << 9) | (UT[4 * l + 3] << 16)); utp = e < 0 ? 0 : tb[e] + UT[4 * l + 1]; }
    __device__ __forceinline__ bool next(int i, pg8::Unit& u) const {
        if (i >= 32) return false;
        const int w = __builtin_amdgcn_readlane(utv, i); if (w < 0) return false;
        u.e = w & 31; u.pn = (w >> 5) & 15; u.mt = (w >> 9) & 127; u.nv = (w >> 16) & 511; u.pm = __builtin_amdgcn_readlane(utp, i); u.ord = i; return true;
    }
    __device__ __forceinline__ const char* b_base(const pg8::Unit& u) const { return (const char*)Bt + (size_t)u.e * estride + (size_t)u.pn * 256 * rowb; }
    __device__ __forceinline__ int a_row(const pg8::Unit& u, int r) const {
        if constexpr (GATHER) return (int)lds_rd_u16((unsigned)(size_t)RL + (unsigned)(u.ord * 256 + (r < u.nv ? r : 0)) * 2u);
        else return u.pm * 256 + r;
    }
};

__device__ __forceinline__ void item8_load(const float* W, int N, int k0, int n0, int lane, f32x4 (&rg)[16]) {
#pragma unroll
    for (int i = 0; i < 16; ++i) rg[i] = __builtin_nontemporal_load((const f32x4*)(W + (size_t)(k0 + 8 * i + (lane >> 3)) * N + n0 + 4 * (lane & 7)));
}
__device__ __forceinline__ void item8_finish(int K, unsigned char* WT, int k0, int r0, LAS float* scr, int lane, const f32x4 (&rg)[16]) {
#pragma unroll
    for (int i = 0; i < 16; ++i) { LAS float* d = scr + (8 * i + (lane >> 3)) * 33 + 4 * (lane & 7); d[0] = rg[i].x; d[1] = rg[i].y; d[2] = rg[i].z; d[3] = rg[i].w; }
    LDS_WAIT();
    const int c = lane & 7;
#pragma unroll
    for (int j = 0; j < 4; ++j) { const int n = (lane >> 3) + 8 * j; const LAS float* sp = scr + (16 * c) * 33 + n; int w[4];
#pragma unroll
        for (int q = 0; q < 4; ++q) { w[q] = __builtin_amdgcn_cvt_pk_fp8_f32(sp[(4 * q) * 33] * 256.f, sp[(4 * q + 1) * 33] * 256.f, 0, false); w[q] = __builtin_amdgcn_cvt_pk_fp8_f32(sp[(4 * q + 2) * 33] * 256.f, sp[(4 * q + 3) * 33] * 256.f, w[q], true); }
        u32x4 o; o.x = (unsigned)w[0]; o.y = (unsigned)w[1]; o.z = (unsigned)w[2]; o.w = (unsigned)w[3];
        __builtin_nontemporal_store(o, (u32x4*)(WT + (size_t)(r0 + n) * K + k0 + 16 * c)); }
    LDS_WAIT();
}

struct Args { const float* in[29]; float* out; unsigned char* ws; int ph_lo, ph_hi; };

__global__ void __launch_bounds__(NTHREADS, 2) fwd(Args args) {
    extern __shared__ __attribute__((aligned(16))) unsigned char lds_raw[];
    LAS unsigned char* lds = (LAS unsigned char*)lds_raw;
    volatile LAS unsigned* MISC = (volatile LAS unsigned*)(lds + MISC_OFF);
    const int tid = threadIdx.x, lane = tid & 63, wave = __builtin_amdgcn_readfirstlane(tid >> 6);
    const int G = gridDim.x, bid = blockIdx.x;
    const int gw = bid * NWAVES + wave, NGW = G * NWAVES;
    unsigned char* ws = args.ws;
    unsigned* ctl = (unsigned*)(ws + WS_CTL);
    const float* x = args.in[0]; const float* cvec = args.in[1]; const float* ctx = args.in[2]; const float* c_ctx = args.in[3];
    const float* ln_in_g = args.in[4]; const float* ln_in_b = args.in[5]; const float* w_ada = args.in[6]; const float* b_ada = args.in[7];
    const float* w_in = args.in[8]; const float* cm_norm_g = args.in[9]; const float* cm_norm_b = args.in[10]; const float* cm_w_s = args.in[11];
    const float* cm_b_s = args.in[12]; const float* wgk_f = args.in[13]; const float* bgk_f = args.in[14]; const float* wgk_b = args.in[15];
    const float* bgk_b = args.in[16]; const float* gla_norm_g = args.in[17]; const float* w_out = args.in[18]; const float* ln1_g = args.in[19];
    const float* ln1_b = args.in[20]; const float* w_router = args.in[21]; const float* b_router = args.in[22]; const float* w_gu = args.in[23];
    const float* b_gu = args.in[24]; const float* w_dn = args.in[25]; const float* b_dn = args.in[26]; const float* ln2_g = args.in[27]; const float* ln2_b = args.in[28];
    float* out = args.out;
    float* MOD = (float*)(ws + WS_MOD);
    bf16* WinT = (bf16*)(ws + WS_WIN); bf16* WoutT = (bf16*)(ws + WS_WOUT); unsigned char* WguT = (unsigned char*)(ws + WS_WGU); unsigned char* WdnT = (unsigned char*)(ws + WS_WDN);
    bf16* HN = (bf16*)(ws + WS_HN); bf16* HM = (bf16*)(ws + WS_HM); bf16* P = (bf16*)(ws + WS_P); float* LR = (float*)(ws + WS_LR);
    bf16* ACAT = (bf16*)(ws + WS_ACAT); bf16* OF = (bf16*)(ws + WS_OF); bf16* OB = (bf16*)(ws + WS_OB);     bf16* Z = (bf16*)(ws + WS_Z);
    bf16* H1 = (bf16*)(ws + WS_H1); bf16* HM2 = (bf16*)(ws + WS_HM2); float* TOPW = (float*)(ws + WS_TOPW); unsigned* TOPEP = (unsigned*)(ws + WS_TOPEP);
    int* LIST = (int*)(ws + WS_LIST); unsigned char* ACT = (unsigned char*)(ws + WS_ACT); unsigned char* YB = ws + WS_YB;
    unsigned* CNT = ctl + CW_CNT;
    unsigned char* HM2F8 = ws + WS_HM2F8;
    bf16* HM2LO = (bf16*)(ws + WS_HM2LO); bf16* WRH = (bf16*)(ws + WS_MOD + 512 * 1024); bf16* WRL = (bf16*)(ws + WS_MOD + 640 * 1024);
    bf16* QEF = (bf16*)(ws + WS_ACT); bf16* QEB = (bf16*)(ws + WS_ACT + 18 * MiB); bf16* KDF = (bf16*)(ws + WS_ACT + 36 * MiB); bf16* KDB = (bf16*)(ws + WS_ACT + 54 * MiB);
    bf16* VTg = (bf16*)(ws + WS_ACT + 72 * MiB); float* DECF = (float*)(ws + WS_ACT + 108 * MiB); float* DECB = (float*)(ws + WS_ACT + 109 * MiB); bf16* OI = (bf16*)(ws + WS_ACT + 110 * MiB);

    for (int u = tid; u < (LDS_BYTES - 131072) / 4; u += NTHREADS) ((LAS unsigned*)(lds + 131072))[u] = 0u;
    LBAR();
    XcdBarrier bar; bar.bar = ctl + CW_BAR; bar.x = 0; bar.st = nullptr;
    if (MK_ONE_LAUNCH) bar = xcd_barrier_post(ctl + CW_BAR, MISC + 8);
    const int lo = args.ph_lo, hi = args.ph_hi;
#define IN(k) (lo <= (k) && (k) < hi)
#define SEAM(k) do { if (IN(k) && IN((k) + 1)) xcd_barrier(bar); } while (0)
#define SEAM_BG(k, j) do { if (IN(k) && IN((k) + 1)) xcd_barrier_bg(bar, [&]() { for (int sl_ = bid * 7 + wave - 1; sl_ < CVBG / 6; sl_ += G * 7) { const int it_ = CV_P0 - CVBG + (j) * (CVBG / 6) + sl_; \
        f32x4 rg_[16]; MOE_LOAD(it_, rg_); MOE_FIN(it_, rg_); } }); } while (0)
#define MOE_LOAD(r_, RG) do { int rr_ = (r_); \
        if (rr_ < 65536) { const int e_ = rr_ / 2048, q_ = rr_ % 2048; item8_load(w_gu + (size_t)e_ * 2048 * 4096, 4096, 128 * (q_ / 128), 32 * (q_ % 128), lane, RG); } \
        else { rr_ -= 65536; const int e_ = rr_ / 1024, q_ = rr_ % 1024; item8_load(w_dn + (size_t)e_ * 2048 * 2048, D, 128 * (q_ / 64), 32 * (q_ % 64), lane, RG); } } while (0)
#define MOE_FIN(r_, RG) do { LAS float* scr_ = (LAS float*)(lds + wave * 16896); int rr_ = (r_); \
        if (rr_ < 65536) { const int e_ = rr_ / 2048, q_ = rr_ % 2048, n0_ = 32 * (q_ % 128), half_ = n0_ / 2048, j0_ = n0_ % 2048; \
            item8_finish(D, WguT + (size_t)e_ * 4096 * 2048, 128 * (q_ / 128), 256 * (j0_ / 128) + 128 * half_ + (j0_ % 128), scr_, lane, RG); } \
        else { rr_ -= 65536; const int e_ = rr_ / 1024, q_ = rr_ % 1024; item8_finish(D, WdnT + (size_t)e_ * 2048 * 2048, 128 * (q_ / 64), 32 * (q_ % 64), scr_, lane, RG); } } while (0)
#define MOE_RANGE(first_, end_, stride_) do { f32x4 rgA_[16], rgB_[16]; int ia_ = (first_); if (ia_ < (end_)) MOE_LOAD(ia_, rgA_); \
        while (ia_ < (end_)) { const int ib_ = ia_ + (stride_); if (ib_ < (end_)) MOE_LOAD(ib_, rgB_); MOE_FIN(ia_, rgA_); if (ib_ >= (end_)) break; \
            ia_ = ib_ + (stride_); if (ia_ < (end_)) MOE_LOAD(ia_, rgA_); MOE_FIN(ib_, rgB_); } } while (0)
    const int Gc = G - NCVB; const bool is_conv = bid >= Gc;
    const int NGWc = Gc * NWAVES;
#define CONV_SLICE(first_, count_) MOE_RANGE((first_) + (bid - Gc) * NWAVES + wave, (first_) + (count_), NCVB * NWAVES)

    if (IN(0)) {
        {
            LAS float* sc = (LAS float*)lds;
            LAS float* red = (LAS float*)(lds + 40960);
            if (bid < 192) {
                for (int i = tid; i < 5 * D; i += NTHREADS) { const int r = i / D, k = i % D; const float v = r < 4 ? cvec[r * D + k] : c_ctx[k]; sc[i] = siluf(v); }
                LBAR();
            }
            for (int u = bid; u < 192; u += G) {
                const int cg = tid & 15, kg = tid >> 4, n0 = u * 64 + cg * 4;
                float acc[5][4];
#pragma unroll
                for (int r = 0; r < 5; ++r)
#pragma unroll
                    for (int j = 0; j < 4; ++j) acc[r][j] = 0.f;
#pragma unroll 16
                for (int kk = 0; kk < 64; ++kk) { const int k = kg * 64 + kk; const f32x4 w = *(const f32x4*)(w_ada + (size_t)k * (6 * D) + n0);
#pragma unroll
                    for (int r = 0; r < 5; ++r) { const float s = sc[r * D + k]; acc[r][0] += s * w.x; acc[r][1] += s * w.y; acc[r][2] += s * w.z; acc[r][3] += s * w.w; } }
#pragma unroll
                for (int r = 0; r < 5; ++r)
#pragma unroll
                    for (int j = 0; j < 4; ++j) red[(kg * 5 + r) * 64 + cg * 4 + j] = acc[r][j];
                LBAR();
                if (tid < 320) { const int r = tid / 64, cidx = tid % 64; float s = 0.f;
                    for (int g2 = 0; g2 < 32; ++g2) s += red[(g2 * 5 + r) * 64 + cidx];
                    MOD[r * (6 * D) + u * 64 + cidx] = s + b_ada[u * 64 + cidx]; }
                LBAR();
            }
            LBAR();
            asm volatile("s_waitcnt vmcnt(0)" ::: "memory"); __syncthreads();
            if (tid == 0 && bid < 192) { __builtin_amdgcn_fence(__ATOMIC_RELEASE, "agent"); asm volatile("s_waitcnt vmcnt(0)" ::: "memory"); __hip_atomic_fetch_add(ctl + CW_MODCNT, 1u, RLX_AGENT); }
        }
        {
            LAS float* scr = (LAS float*)(lds + wave * 16896);
            constexpr int I_IN = 32 * 161, I_OUT = 32 * 64;
            {
#define WB_LOAD(it_, RG) do { const int t_ = (it_); const bool in_ = t_ < I_IN; const int r_ = in_ ? t_ : t_ - I_IN; const int kb_ = in_ ? r_ / 161 : r_ >> 6, nb_ = in_ ? r_ % 161 : r_ & 63; \
                    itemb_load(in_ ? w_in : w_out, in_ ? DIN : D, 64 * kb_, 32 * nb_, lane, RG); } while (0)
#define WB_FIN(it_, RG) do { const int t_ = (it_); const bool in_ = t_ < I_IN; const int r_ = in_ ? t_ : t_ - I_IN; const int kb_ = in_ ? r_ / 161 : r_ >> 6, nb_ = in_ ? r_ % 161 : r_ & 63; \
                    itemb_finish(D, in_ ? WinT : WoutT, 64 * kb_, 32 * nb_, scr, lane, RG); } while (0)
                const int n_ = (I_IN + I_OUT - gw + NGW - 1) / NGW, last_ = gw + (n_ - 1) * NGW;
                f32x4 ga[8], gb[8]; WB_LOAD(gw, ga);
#pragma unroll 1
                for (int k_ = 0; k_ < n_; k_ += 2) { const int ia = gw + k_ * NGW; int ib = ia + NGW; ib = ib < I_IN + I_OUT ? ib : last_; int ic = ia + 2 * NGW; ic = ic < I_IN + I_OUT ? ic : last_;
                    WB_LOAD(ib, gb); WB_FIN(ia, ga); WB_LOAD(ic, ga); WB_FIN(ib, gb); }
#undef WB_LOAD
#undef WB_FIN
            }
            MOE_RANGE(gw, CV_P0 - CVBG - CVSK, NGW);
            if (bid >= 192) MOE_RANGE(CV_P0 + CV2 + CV2X + CV3 + CV4 - CV4P0 + (bid - 192) * NWAVES + wave, CV_P0 + CV2 + CV2X + CV3 + CV4, (G - 192) * NWAVES);
        }
        for (int i = gw * 64 + lane; i < D * NE; i += NGW * 64) { const int k = i >> 5, e = i & 31; const float w = w_router[i]; const unsigned hi = f2bf(w); WRH[(size_t)e * D + k] = (bf16)hi; WRL[(size_t)e * D + k] = (bf16)f2bf(w - bf2f(hi)); }
        if (tid == 0) { const unsigned want = G < 192 ? (unsigned)G : 192u; unsigned sp = 0;
            while (__hip_atomic_load(ctl + CW_MODCNT, RLX_AGENT) < want) { __builtin_amdgcn_s_sleep(2); if (++sp > (1u << 22)) break; }
            __builtin_amdgcn_fence(__ATOMIC_ACQUIRE, "agent"); asm volatile("s_waitcnt vmcnt(0)" ::: "memory"); }
        __syncthreads();
        LAS float* LGI = (LAS float*)lds; LAS float* LBI = LGI + D; LAS float* SHI = LBI + D; LAS float* SCI = SHI + 5 * D;
        for (int i = tid; i < D / 4; i += NTHREADS) { *(LAS f32x4*)(LGI + 4 * i) = *(const f32x4*)(ln_in_g + 4 * i); *(LAS f32x4*)(LBI + 4 * i) = *(const f32x4*)(ln_in_b + 4 * i); }
        for (int i = tid; i < 5 * D / 4; i += NTHREADS) { const int r = i / (D / 4), c = 4 * (i % (D / 4)); *(LAS f32x4*)(SHI + r * D + c) = *(const f32x4*)(MOD + r * (6 * D) + c); *(LAS f32x4*)(SCI + r * D + c) = *(const f32x4*)(MOD + r * (6 * D) + D + c); }
        LBAR();
        for (int m0 = gw; m0 < MR; m0 += 2 * NGW) {
            f32x4 vv[2][8];
#pragma unroll
            for (int t2 = 0; t2 < 2; ++t2) { const int m = (m0 + t2 * NGW) < MR ? m0 + t2 * NGW : m0; const float* xr = m < T ? x + (size_t)m * D : ctx + (size_t)(m - T) * D;
#pragma unroll
                for (int j = 0; j < 8; ++j) vv[t2][j] = *(const f32x4*)(xr + 8 * (lane + 64 * (j >> 1)) + 4 * (j & 1)); }
#pragma unroll
            for (int t2 = 0; t2 < 2; ++t2) { const int m = m0 + t2 * NGW; if (m >= MR) break;
                const LAS float* shp = SHI + (m < T ? m / SEQ : 4) * D; const LAS float* scp = SCI + (m < T ? m / SEQ : 4) * D;
                f32x4 v[8]; float s = 0.f;
#pragma unroll
                for (int j = 0; j < 8; ++j) { v[j] = vv[t2][j]; s += (v[j].x + v[j].y) + (v[j].z + v[j].w); }
                const float mean = wave_sum(s) * (1.f / D); float s2 = 0.f;
#pragma unroll
                for (int j = 0; j < 8; ++j) { v[j] = v[j] - mean; s2 += (v[j].x * v[j].x + v[j].y * v[j].y) + (v[j].z * v[j].z + v[j].w * v[j].w); }
                const float rstd = 1.f / sqrtf(wave_sum(s2) * (1.f / D) + LN_EPS);
#pragma unroll
                for (int j2 = 0; j2 < 4; ++j2) { const int c8 = 8 * (lane + 64 * j2); u32x4 on, om;
#pragma unroll
                    for (int hf = 0; hf < 2; ++hf) { const int j = 2 * j2 + hf, c = c8 + 4 * hf; const f32x4 g = *(const LAS f32x4*)(LGI + c), bb = *(const LAS f32x4*)(LBI + c);
                        f32x4 hh; hh.x = v[j].x * rstd * g.x + bb.x; hh.y = v[j].y * rstd * g.y + bb.y; hh.z = v[j].z * rstd * g.z + bb.z; hh.w = v[j].w * rstd * g.w + bb.w;
                        const f32x4 s4 = *(const LAS f32x4*)(shp + c), c4 = *(const LAS f32x4*)(scp + c);
                        const unsigned n0 = pk2(hh.x, hh.y), n1 = pk2(hh.z, hh.w), m0_ = pk2(hh.x * (1.f + c4.x) + s4.x, hh.y * (1.f + c4.y) + s4.y), m1_ = pk2(hh.z * (1.f + c4.z) + s4.z, hh.w * (1.f + c4.w) + s4.w);
                        if (hf == 0) { on.x = n0; on.y = n1; om.x = m0_; om.y = m1_; } else { on.z = n0; on.w = n1; om.z = m0_; om.w = m1_; } }
                    *(u32x4*)(HN + (size_t)m * D + c8) = on; *(u32x4*)(HM + (size_t)m * D + c8) = om; }
            }
        }
    }
    SEAM_BG(0, 0);


    if (IN(2) && is_conv) CONV_SLICE(CV_P0, CV2);
    if (IN(2) && !is_conv) {
        {
            const int ntask = (bid + 2 * Gc < MR / 32) ? 3 : 2, parts = ntask == 3 ? 2 : 4, kspan = D / parts;
            LAS float* part = (LAS float*)lds;
            const int tl = wave / parts, kp = wave % parts;
            if (tl < ntask) {
                const int row0 = (bid + Gc * tl) * 32;
                auto arow = [=](int i) { return HM + (size_t)(row0 + i) * D + kp * kspan; };
                auto brow = [=](int j, int) { return WinT + (size_t)(NP + j) * D + kp * kspan; };
                auto epi = [=](int i, int j, float v, float) { part[wave * 1024 + i * 32 + j] = v; };
                if (parts == 4) wave_gemm32<1>(arow, brow, epi, D / 4, lane); else wave_gemm32<1>(arow, brow, epi, D / 2, lane);
            }
            LBAR();
            for (int o = tid; o < ntask * 1024; o += NTHREADS) { const int t2 = o >> 10, e = o & 1023; float s = 0.f;
                for (int p = 0; p < parts; ++p) s += part[(t2 * parts + p) * 1024 + e];
                LR[(size_t)(bid + Gc * t2) * 1024 + e] = s; }
        }
        asm volatile("s_waitcnt vmcnt(0)" ::: "memory"); LBAR();
        InProjOrder S{Gc, bid, WinT};
        EpiInProj E{P};
        pg8::gemm_phase<EpiInProj, InProjOrder>(lds, HM, D, S, E);
        if (bid >= 1304 - 5 * Gc) MOE_RANGE(CV_P0 + CV2 + (bid - (1304 - 5 * Gc)) * NWAVES + wave, CV_P0 + CV2 + CV2X, (6 * Gc - 1304) * NWAVES);
    }
    SEAM_BG(2, 1);

    if (IN(3)) {
        LAS float* LRs = (LAS float*)lds;
        LAS float* PART = (LAS float*)(lds + 8192);
        LAS bf16* QEs = (LAS bf16*)(lds + 10240);
        LAS bf16* KEs = (LAS bf16*)(lds + 27648);
        LAS bf16* ATTs = (LAS bf16*)(lds + 45056);
        LAS bf16* VTs = (LAS bf16*)(lds + 54272);
        LAS bf16* Qs = (LAS bf16*)(lds + 91136);
        LAS bf16* Ks = (LAS bf16*)(lds + 108544);
        float wg[2][16], bias2[2]; int hprev = -1;
        for (int u = bid; u < NBATCH * 68 * 4; u += G) {
            const int h = u & 3, bc = u >> 2, b = bc / 68, c = bc % 68; const bool lat = c >= 4;
            const int row0 = lat ? b * SEQ + (c - 4) * 64 : T + b * CTX + c * 64;
            const int d = tid & 127, tq = tid >> 7;
            const f32x4 lr4 = *(const f32x4*)(LR + (size_t)(row0 + (tid >> 3)) * 32 + (tid & 7) * 4);
            u32x4 vraw[4];
#pragma unroll
            for (int i = 0; i < 4; ++i) { const int ch = tid + 512 * i, sx = ch & 63, e8 = ch >> 6; vraw[i] = *(const u32x4*)(P + (size_t)(row0 + sx) * NP + C_VG + h * 256 + e8 * 8); }
            u32x4 qk4[4];
#pragma unroll
            for (int i = 0; i < 2; ++i) { const int ch = tid + 512 * i, t = ch >> 4, c16 = ch & 15; const bf16* pr = P + (size_t)(row0 + t) * NP + h * 128 + c16 * 8; qk4[i] = *(const u32x4*)(pr + C_Q); qk4[2 + i] = *(const u32x4*)(pr + C_K); }
            if (h != hprev) { hprev = h;
#pragma unroll
                for (int r = 0; r < 16; ++r) { wg[0][r] = wgk_f[r * 512 + h * 128 + d]; wg[1][r] = wgk_b[r * 512 + h * 128 + d]; }
                bias2[0] = bgk_f[h * 128 + d]; bias2[1] = bgk_b[h * 128 + d]; }
            *(LAS f32x4*)(LRs + (tid >> 3) * 32 + (tid & 7) * 4) = lr4;
#pragma unroll
            for (int i = 0; i < 2; ++i) { const int ch = tid + 512 * i, t = ch >> 4, c16 = ch & 15; *(LAS u32x4*)(Qs + t * 136 + c16 * 8) = qk4[i]; *(LAS u32x4*)(Ks + t * 136 + c16 * 8) = qk4[2 + i]; }
#pragma unroll
            for (int i = 0; i < 4; ++i) { const int ch = tid + 512 * i, sx = ch & 63, e8 = ch >> 6; const unsigned ww[4] = {vraw[i].x, vraw[i].y, vraw[i].z, vraw[i].w};
#pragma unroll
                for (int j = 0; j < 4; ++j) { VTs[(e8 * 8 + 2 * j) * 72 + sx] = (bf16)(ww[j] & 0xffffu); VTs[(e8 * 8 + 2 * j + 1) * 72 + sx] = (bf16)(ww[j] >> 16); } }
            LBAR();
#pragma unroll
            for (int i = 0; i < 4; ++i) { const int ch = tid + 512 * i, e = ch >> 3, c8 = ch & 7; *(u32x4*)(VTg + ((size_t)u * 256 + e) * 64 + c8 * 8) = *(const LAS u32x4*)(VTs + e * 72 + c8 * 8); }
            bf16 qraw[16], kraw[16];
#pragma unroll
            for (int i = 0; i < 16; ++i) { qraw[i] = Qs[(16 * tq + i) * 136 + d]; kraw[i] = Ks[(16 * tq + i) * 136 + d]; }
            f32x4 att[2]; att[0] = (f32x4){0.f, 0.f, 0.f, 0.f}; att[1] = att[0];
#pragma unroll
            for (int dir = 0; dir < 2; ++dir) {
                bf16* QEg = dir ? QEB : QEF; bf16* KDg = dir ? KDB : KDF; float* DECg = dir ? DECB : DECF;
                const float (&w)[16] = wg[dir]; const float bias = bias2[dir];
                float cs[16];
#pragma unroll
                for (int i = 0; i < 16; ++i) { const LAS float* lr = LRs + (16 * tq + i) * 32 + dir * 16; float pre = bias;
#pragma unroll
                    for (int r4 = 0; r4 < 4; ++r4) { const f32x4 l4 = *(const LAS f32x4*)(lr + 4 * r4); pre += l4.x * w[4 * r4] + l4.y * w[4 * r4 + 1] + l4.z * w[4 * r4 + 2] + l4.w * w[4 * r4 + 3]; }
                    cs[i] = (fminf(pre, 0.f) - __logf(1.f + __expf(-fabsf(pre)))) * (1.f / 16.f); }
                if (dir == 0) {
#pragma unroll
                    for (int i = 1; i < 16; ++i) cs[i] += cs[i - 1];
                    PART[tq * 128 + d] = cs[15];
                } else {
#pragma unroll
                    for (int i = 14; i >= 0; --i) cs[i] += cs[i + 1];
                    PART[tq * 128 + d] = cs[0];
                }
                LBAR();
                const float p0 = PART[d], p1 = PART[128 + d], p2 = PART[256 + d], p3 = PART[384 + d]; const float blast = (p0 + p1) + (p2 + p3);
                float off;
                if (dir == 0) off = (tq > 0 ? p0 : 0.f) + (tq > 1 ? p1 : 0.f) + (tq > 2 ? p2 : 0.f);
                else off = (tq < 3 ? p3 : 0.f) + (tq < 2 ? p2 : 0.f) + (tq < 1 ? p1 : 0.f);
                unsigned kdp[8];
#pragma unroll
                for (int i = 0; i < 16; ++i) { const int t = 16 * tq + i; const float bcm = off + cs[i];
                    const float q = bf2f(qraw[i]) * 0.08838834764831845f, k = bf2f(kraw[i]);
                    const unsigned qe = f2bf(q * __expf(bcm)), ke = f2bf(k * __expf(-bcm)), kd = f2bf(k * __expf(blast - bcm));
                    QEs[t * 136 + d] = (bf16)qe; KEs[t * 136 + d] = (bf16)ke;
                    if (i & 1) kdp[i >> 1] |= kd << 16; else kdp[i >> 1] = kd; }
                { u32x4 k0, k1; k0.x = kdp[0]; k0.y = kdp[1]; k0.z = kdp[2]; k0.w = kdp[3]; k1.x = kdp[4]; k1.y = kdp[5]; k1.z = kdp[6]; k1.w = kdp[7];
                  bf16* kr = KDg + ((size_t)u * 128 + d) * 64 + 16 * tq; *(u32x4*)kr = k0; *(u32x4*)(kr + 8) = k1; }
                if (tq == 0) DECg[(size_t)u * 128 + d] = expf(blast);
                LBAR();
                if (lat) {
#pragma unroll
                    for (int i = 0; i < 2; ++i) { const int ch = tid + 512 * i, t = ch >> 4, c8 = ch & 15, g16 = c8 >> 1, hh2 = c8 & 1;
                        const u32x2 lo = *(const LAS u32x2*)(QEs + t * 136 + 16 * g16 + 4 * hh2), hi = *(const LAS u32x2*)(QEs + t * 136 + 16 * g16 + 8 + 4 * hh2);
                        u32x4 o; o.x = lo.x; o.y = lo.y; o.z = hi.x; o.w = hi.y; *(u32x4*)(QEg + ((size_t)u * 64 + t) * 128 + c8 * 8) = o; }
                    const int tr = wave >> 1, tc0 = 2 * (wave & 1), r16 = lane & 15, q4 = lane >> 4;
                    f32x4 tmp[2]; tmp[0] = (f32x4){0.f, 0.f, 0.f, 0.f}; tmp[1] = tmp[0];
#pragma unroll
                    for (int ks = 0; ks < 4; ++ks) { const bf16x8 a = *(const LAS bf16x8*)(QEs + (16 * tr + r16) * 136 + 32 * ks + 8 * q4);
#pragma unroll
                        for (int n = 0; n < 2; ++n) { const bf16x8 bb = *(const LAS bf16x8*)(KEs + (16 * (tc0 + n) + r16) * 136 + 32 * ks + 8 * q4);
                            tmp[n] = __builtin_amdgcn_mfma_f32_16x16x32_bf16(a, bb, tmp[n], 0, 0, 0); } }
#pragma unroll
                    for (int n = 0; n < 2; ++n)
#pragma unroll
                        for (int rg = 0; rg < 4; ++rg) { const int t = 16 * tr + 4 * q4 + rg, sx = 16 * (tc0 + n) + r16; const bool keep = dir == 0 ? sx <= t : sx >= t; att[n][rg] += keep ? tmp[n][rg] : 0.f; }
                }
                LBAR();
            }
            if (lat) {
                { const int tr = wave >> 1, tc0 = 2 * (wave & 1), r16 = lane & 15, q4 = lane >> 4;
#pragma unroll
                  for (int n = 0; n < 2; ++n)
#pragma unroll
                      for (int rg = 0; rg < 4; ++rg) ATTs[(16 * tr + 4 * q4 + rg) * 72 + 16 * (tc0 + n) + r16] = (bf16)f2bf(att[n][rg]); }
                LBAR();
                const int r16 = lane & 15, q4 = lane >> 4;
                f32x4 oa[4][2];
#pragma unroll
                for (int tr = 0; tr < 4; ++tr) { oa[tr][0] = (f32x4){0.f, 0.f, 0.f, 0.f}; oa[tr][1] = oa[tr][0]; }
#pragma unroll
                for (int ks = 0; ks < 2; ++ks) { bf16x8 bb[2];
#pragma unroll
                    for (int n = 0; n < 2; ++n) bb[n] = *(const LAS bf16x8*)(VTs + (16 * (2 * wave + n) + r16) * 72 + 32 * ks + 8 * q4);
#pragma unroll
                    for (int tr = 0; tr < 4; ++tr) { const bf16x8 a = *(const LAS bf16x8*)(ATTs + (16 * tr + r16) * 72 + 32 * ks + 8 * q4);
#pragma unroll
                        for (int n = 0; n < 2; ++n) oa[tr][n] = __builtin_amdgcn_mfma_f32_16x16x32_bf16(bb[n], a, oa[tr][n], 0, 0, 0); } }
                LAS unsigned char* OIs = lds + 10240;
#pragma unroll
                for (int tr = 0; tr < 4; ++tr)
#pragma unroll
                    for (int n = 0; n < 2; ++n) { u32x2 w; w.x = pk2(oa[tr][n][0], oa[tr][n][1]); w.y = pk2(oa[tr][n][2], oa[tr][n][3]);
                        *(LAS u32x2*)(OIs + (16 * tr + r16) * 520 + (16 * (2 * wave + n) + 4 * q4) * 2) = w; }
                LBAR();
#pragma unroll
                for (int i = 0; i < 4; ++i) { const int q = tid + 512 * i, rw = q >> 5, pc = q & 31;
                    const u32x2 lo = *(const LAS u32x2*)(OIs + rw * 520 + pc * 16), hi = *(const LAS u32x2*)(OIs + rw * 520 + pc * 16 + 8);
                    u32x4 w; w.x = lo.x; w.y = lo.y; w.z = hi.x; w.w = hi.y; *(u32x4*)(OI + (size_t)(row0 + rw) * 1024 + h * 256 + pc * 8) = w; }
            }
            LBAR();
        }
    }
    if (IN(3) && IN(4)) xcd_barrier_bg(bar, [&]() {
        for (int sl_ = bid * 7 + wave - 1; sl_ < CVBG / 6; sl_ += G * 7) { const int it_ = CV_P0 - CVBG + 2 * (CVBG / 6) + sl_; f32x4 rg_[16]; MOE_LOAD(it_, rg_); MOE_FIN(it_, rg_); }
        if (bid >= 64) for (int sl_ = (bid - 64) * 7 + wave - 1; sl_ < CVSK; sl_ += (G - 64) * 7) { const int it_ = CV_P0 - CVBG - CVSK + sl_; f32x4 rg_[16]; MOE_LOAD(it_, rg_); MOE_FIN(it_, rg_); } });

    if (IN(4)) {
        if (bid < 64) {
            const int bhd = bid >> 1, eh = bid & 1, b = bhd >> 3, h = (bhd >> 1) & 3, dir = bhd & 1;
            const bf16* QEg = dir ? QEB : QEF; const bf16* KDg = dir ? KDB : KDF; const float* DECg = dir ? DECB : DECF; bf16* O = dir ? OB : OF;
            constexpr int GBUF = 55296;
            constexpr int OL0 = 2 * GBUF, OL1 = 139264;
            if (wave >= 4) {
                const int pt = tid - 256;
                u32x4 R0_[13], R1_[13], R2_[13];
#define G2_PLOAD(R, n) do { const int c_ = dir ? ((n) < 4 ? 3 - (n) : 71 - (n)) : (n); const size_t u_ = (size_t)(b * 68 + c_) * 4 + h; \
                    _Pragma("unroll") for (int i_ = 0; i_ < 4; ++i_) { const int q_ = pt + 256 * i_; R[i_] = c_ >= 4 ? *(const u32x4*)(QEg + u_ * 8192 + (size_t)q_ * 8) : (u32x4){0u, 0u, 0u, 0u}; \
                        R[4 + i_] = *(const u32x4*)(KDg + u_ * 8192 + (size_t)q_ * 8); R[8 + i_] = *(const u32x4*)(VTg + (u_ * 256 + eh * 128) * 64 + (size_t)q_ * 8); } \
                    R[12] = *(const u32x4*)(DECg + u_ * 128 + (pt & 31) * 4); } while (0)
#define G2_PSTORE(R, bb) do { LAS unsigned char* base_ = lds + (bb) * GBUF; \
                    _Pragma("unroll") for (int i_ = 0; i_ < 4; ++i_) { const int q_ = pt + 256 * i_; *(LAS u32x4*)(base_ + (q_ >> 4) * 272 + (q_ & 15) * 16) = R[i_]; \
                        *(LAS u32x4*)(base_ + 17408 + (q_ >> 3) * 144 + (q_ & 7) * 16) = R[4 + i_]; *(LAS u32x4*)(base_ + 36352 + (q_ >> 3) * 144 + (q_ & 7) * 16) = R[8 + i_]; } \
                    if (pt < 32) *(LAS u32x4*)(base_ + 35840 + pt * 16) = R[12]; } while (0)
#define G2_OSTORE(m) do { const int m_ = (m); const int c_ = dir ? (m_ < 4 ? 3 - m_ : 71 - m_) : m_; if (m_ >= 0 && c_ >= 4) { const LAS unsigned char* ol_ = lds + ((m_ & 1) ? OL1 : OL0); \
                    bf16* og_ = O + (size_t)(b * SEQ + (c_ - 4) * 64) * 1024 + h * 256 + eh * 128; \
                    _Pragma("unroll") for (int i_ = 0; i_ < 4; ++i_) { const int q_ = pt + 256 * i_, row_ = q_ >> 4, pc_ = q_ & 15; \
                        const u32x2 lo_ = *(const LAS u32x2*)(ol_ + row_ * 264 + pc_ * 16), hi_ = *(const LAS u32x2*)(ol_ + row_ * 264 + pc_ * 16 + 8); \
                        u32x4 w_; w_.x = lo_.x; w_.y = lo_.y; w_.z = hi_.x; w_.w = hi_.y; *(u32x4*)(og_ + (size_t)row_ * 1024 + pc_ * 8) = w_; } } } while (0)
                G2_PLOAD(R0_, 0); G2_PLOAD(R1_, 1); G2_PLOAD(R2_, 2); G2_PSTORE(R0_, 0); G2_PLOAD(R0_, 3);
                LBAR();
#pragma unroll 1
                for (int n = 0; n < 66; n += 3) {
                    G2_PSTORE(R1_, (n + 1) & 1); if (n + 4 < 68) G2_PLOAD(R1_, n + 4); G2_OSTORE(n - 1); LBAR();
                    G2_PSTORE(R2_, (n + 2) & 1); if (n + 5 < 68) G2_PLOAD(R2_, n + 5); G2_OSTORE(n); LBAR();
                    G2_PSTORE(R0_, (n + 3) & 1); if (n + 6 < 68) G2_PLOAD(R0_, n + 6); G2_OSTORE(n + 1); LBAR();
                }
                G2_PSTORE(R1_, 1); G2_OSTORE(65); LBAR();
                G2_OSTORE(66); LBAR();
                G2_OSTORE(67);
#undef G2_OSTORE
#undef G2_PLOAD
#undef G2_PSTORE
            } else {
                const int ws = eh * 4 + wave, r = lane & 31, hh = lane >> 5;
                __builtin_amdgcn_s_setprio(2);
                typedef float f32x16 __attribute__((ext_vector_type(16)));
                f32x16 S[4];
#pragma unroll
                for (int dt = 0; dt < 4; ++dt)
#pragma unroll
                    for (int i = 0; i < 16; ++i) S[dt][i] = 0.f;
                LBAR();
#pragma unroll 1
                for (int n = 0; n < 68; ++n) {
                    const int c = dir ? (n < 4 ? 3 - n : 71 - n) : n;
                    const LAS unsigned char* base = lds + (n & 1) * GBUF;
                    if (c >= 4) {
                        f32x16 o[2];
#pragma unroll
                        for (int i = 0; i < 16; ++i) { o[0][i] = 0.f; o[1][i] = 0.f; }
#pragma unroll
                        for (int dt = 0; dt < 4; ++dt)
#pragma unroll
                            for (int s2 = 0; s2 < 2; ++s2) {
                                u32x4 pk; pk.x = pk2(S[dt][8 * s2], S[dt][8 * s2 + 1]); pk.y = pk2(S[dt][8 * s2 + 2], S[dt][8 * s2 + 3]); pk.z = pk2(S[dt][8 * s2 + 4], S[dt][8 * s2 + 5]); pk.w = pk2(S[dt][8 * s2 + 6], S[dt][8 * s2 + 7]);
                                const bf16x8 bs = __builtin_bit_cast(bf16x8, pk);
#pragma unroll
                                for (int tt = 0; tt < 2; ++tt) { const bf16x8 a = *(const LAS bf16x8*)(base + (32 * tt + r) * 272 + (32 * dt + 16 * s2 + 8 * hh) * 2);
                                    o[tt] = __builtin_amdgcn_mfma_f32_32x32x16_bf16(bs, a, o[tt], 0, 0, 0); }
                            }
                        LAS unsigned char* ol = lds + ((n & 1) ? OL1 : OL0) + (32 * wave + 4 * hh) * 2;
#pragma unroll
                        for (int tt = 0; tt < 2; ++tt)
#pragma unroll
                            for (int g = 0; g < 4; ++g) { u32x2 w; w.x = pk2(o[tt][4 * g], o[tt][4 * g + 1]); w.y = pk2(o[tt][4 * g + 2], o[tt][4 * g + 3]);
                                *(LAS u32x2*)(ol + (32 * tt + r) * 264 + 16 * g) = w; }
                    }
                    bf16x8 vt[4];
#pragma unroll
                    for (int s4 = 0; s4 < 4; ++s4) vt[s4] = *(const LAS bf16x8*)(base + 36352 + (32 * wave + r) * 144 + (16 * s4 + 8 * hh) * 2);
#pragma unroll
                    for (int dt = 0; dt < 4; ++dt)
#pragma unroll
                        for (int g4 = 0; g4 < 4; ++g4) { const f32x4 dc = *(const LAS f32x4*)(base + 35840 + (32 * dt + 8 * g4 + 4 * hh) * 4);
                            S[dt][4 * g4] *= dc.x; S[dt][4 * g4 + 1] *= dc.y; S[dt][4 * g4 + 2] *= dc.z; S[dt][4 * g4 + 3] *= dc.w; }
#pragma unroll
                    for (int s4 = 0; s4 < 4; ++s4)
#pragma unroll
                        for (int dt = 0; dt < 4; ++dt) { const bf16x8 a = *(const LAS bf16x8*)(base + 17408 + (32 * dt + r) * 144 + (16 * s4 + 8 * hh) * 2);
                            S[dt] = __builtin_amdgcn_mfma_f32_32x32x16_bf16(a, vt[s4], S[dt], 0, 0, 0); }
                    LBAR();
                }
                __builtin_amdgcn_s_setprio(0);
            }
        } else {
            LAS float* stat = (LAS float*)lds;
            LAS float* gn = (LAS float*)(lds + 1024);
            LAS float* bn = (LAS float*)(lds + 5120);
            LAS float* bsl = (LAS float*)(lds + 9216);
            LAS bf16* Ws = (LAS bf16*)(lds + 13312);
            LAS bf16* VnT = (LAS bf16*)(lds + 48128);
            if (bid < 64 + NCMB) {
                for (int i = tid; i < 1024; i += NTHREADS) { gn[i] = cm_norm_g[i]; bn[i] = cm_norm_b[i]; bsl[i] = cm_b_s[i]; }
                LBAR();
                for (int u = bid - 64; u < NBATCH * 32 * 2; u += NCMB) {
                    const int r0 = (u >> 1) * 128, h0 = (u & 1) * 4, r16 = lane & 15, q4 = lane >> 4;
#pragma unroll 1
                    for (int qb = 0; qb < 16; qb += 8) {
                        u32x4 ra[8], rb[8];
#pragma unroll
                        for (int j = 0; j < 8; ++j) { const bf16* vr = P + (size_t)(r0 + wave * 16 + qb + j) * NP + C_V + 16 * lane; ra[j] = *(const u32x4*)vr; rb[j] = *(const u32x4*)(vr + 8); }
#pragma unroll
                        for (int j = 0; j < 8; ++j) {
                            const float f[16] = {bflo(ra[j].x), bfhi(ra[j].x), bflo(ra[j].y), bfhi(ra[j].y), bflo(ra[j].z), bfhi(ra[j].z), bflo(ra[j].w), bfhi(ra[j].w), bflo(rb[j].x), bfhi(rb[j].x), bflo(rb[j].y), bfhi(rb[j].y), bflo(rb[j].z), bfhi(rb[j].z), bflo(rb[j].w), bfhi(rb[j].w)};
                            float sm = 0.f;
#pragma unroll
                            for (int i = 0; i < 16; ++i) sm += f[i];
                            const float mean = wave_sum(sm) * (1.f / 1024.f); float s2 = 0.f;
#pragma unroll
                            for (int i = 0; i < 16; ++i) { const float dl = f[i] - mean; s2 += dl * dl; }
                            const float rstd = 1.f / sqrtf(wave_sum(s2) * (1.f / 1024.f) + LN_EPS);
                            if (lane == 0) { stat[2 * (wave * 16 + qb + j)] = mean; stat[2 * (wave * 16 + qb + j) + 1] = rstd; }
                        }
                    }
                    f32x4 wreg[8]; u32x4 vreg[4]; u32x2 ureg[8];
#define CM_LOAD(h_) do { int t_ = tid; asm volatile("" : "+v"(t_)); _Pragma("unroll") for (int i_ = 0; i_ < 8; ++i_) { const int ch_ = t_ + 512 * i_; wreg[i_] = *(const f32x4*)(cm_w_s + ((size_t)(h_) * 128 + (ch_ >> 5)) * 128 + 4 * (ch_ & 31)); } \
                        _Pragma("unroll") for (int i_ = 0; i_ < 4; ++i_) { const int ch_ = t_ + 512 * i_; vreg[i_] = *(const u32x4*)(P + (size_t)(r0 + (ch_ & 127)) * NP + C_V + (h_) * 128 + (ch_ >> 7) * 8); } } while (0)
                    CM_LOAD(h0);
                    LBAR();
#pragma unroll 1
                    for (int h = h0; h < h0 + 4; ++h) {
#pragma unroll
                        for (int tp = 0; tp < 8; ++tp) ureg[tp] = *(const u32x2*)(P + (size_t)(r0 + 16 * tp + r16) * NP + C_U + h * 128 + 16 * wave + 4 * q4);
#pragma unroll
                        for (int i = 0; i < 8; ++i) { const int ch = tid + 512 * i; u32x2 o; o.x = pk2(wreg[i].x, wreg[i].y); o.y = pk2(wreg[i].z, wreg[i].w); *(LAS u32x2*)(Ws + (ch >> 5) * 136 + 4 * (ch & 31)) = o; }
#pragma unroll
                        for (int i = 0; i < 4; ++i) { const int ch = tid + 512 * i, q = ch & 127, e8 = ch >> 7; const u32x4 w = vreg[i];
                            const float mean = stat[2 * q], rstd = stat[2 * q + 1]; const LAS float* gp = gn + h * 128 + e8 * 8; const LAS float* bp = bn + h * 128 + e8 * 8;
                            const f32x4 g0 = *(const LAS f32x4*)gp, g1 = *(const LAS f32x4*)(gp + 4), b0 = *(const LAS f32x4*)bp, b1 = *(const LAS f32x4*)(bp + 4);
                            const float vv[8] = {bflo(w.x), bfhi(w.x), bflo(w.y), bfhi(w.y), bflo(w.z), bfhi(w.z), bflo(w.w), bfhi(w.w)};
                            const float gg[8] = {g0.x, g0.y, g0.z, g0.w, g1.x, g1.y, g1.z, g1.w}, bb[8] = {b0.x, b0.y, b0.z, b0.w, b1.x, b1.y, b1.z, b1.w};
#pragma unroll
                            for (int j = 0; j < 8; ++j) VnT[(e8 * 8 + j) * 136 + q] = (bf16)f2bf((vv[j] - mean) * rstd * gg[j] + bb[j]); }
                        if (h + 1 < h0 + 4) CM_LOAD(h + 1);
                        LBAR();
                        f32x4 acc[8];
#pragma unroll
                        for (int tp = 0; tp < 8; ++tp) acc[tp] = (f32x4){0.f, 0.f, 0.f, 0.f};
#pragma unroll
                        for (int ks = 0; ks < 4; ++ks) { const bf16x8 a = *(const LAS bf16x8*)(VnT + (16 * wave + r16) * 136 + 32 * ks + 8 * q4);
#pragma unroll
                            for (int tp = 0; tp < 8; ++tp) { const bf16x8 bq = *(const LAS bf16x8*)(Ws + (16 * tp + r16) * 136 + 32 * ks + 8 * q4);
                                acc[tp] = __builtin_amdgcn_mfma_f32_16x16x32_bf16(a, bq, acc[tp], 0, 0, 0); } }
#pragma unroll
                        for (int tp = 0; tp < 8; ++tp) { const int pp = 16 * tp + r16, e0 = 16 * wave + 4 * q4; const float bs = bsl[h * 128 + pp]; const u32x2 uu = ureg[tp];
                            u32x2 o; o.x = pk2(bflo(uu.x) * (acc[tp][0] + bs), bfhi(uu.x) * (acc[tp][1] + bs)); o.y = pk2(bflo(uu.y) * (acc[tp][2] + bs), bfhi(uu.y) * (acc[tp][3] + bs));
                            *(u32x2*)(ACAT + (size_t)(r0 + pp) * D + h * 128 + e0) = o; }
                        LBAR();
                    }
#undef CM_LOAD
                }
            }
            if (bid >= 64 + NCMB && wave < 6) MOE_RANGE(CV_P0 + CV2 + CV2X + CV3 + (bid - 64 - NCMB) * 6 + wave, CV_P0 + CV2 + CV2X + CV3 + CV4 - CV4P0, (G - 64 - NCMB) * 6);
        }
    }
    SEAM_BG(4, 3);

    if (IN(5) && is_conv) CONV_SLICE(CV_P0 + CV2 + CV2X + CV3 + CV4, CV5);
    if (IN(5) && !is_conv) {
        const int c0 = 16 * lane; float ng[16];
#pragma unroll
        for (int j = 0; j < 4; ++j) { const f32x4 g4 = *(const f32x4*)(gla_norm_g + ((c0 + 4 * j) & 255)); ng[4 * j] = g4.x; ng[4 * j + 1] = g4.y; ng[4 * j + 2] = g4.z; ng[4 * j + 3] = g4.w; }
        for (int m0 = gw; m0 < T; m0 += 2 * NGWc) {
            u32x4 ra[2][2], rb[2][2], ri[2][2]; u32x4 rg[2][2];
#pragma unroll
            for (int t2 = 0; t2 < 2; ++t2) { const int m = (m0 + t2 * NGWc) < T ? m0 + t2 * NGWc : m0;
#pragma unroll
                for (int j = 0; j < 2; ++j) { ra[t2][j] = *(const u32x4*)(OF + (size_t)m * 1024 + c0 + 8 * j); rb[t2][j] = *(const u32x4*)(OB + (size_t)m * 1024 + c0 + 8 * j); ri[t2][j] = *(const u32x4*)(OI + (size_t)m * 1024 + c0 + 8 * j); }
                rg[t2][0] = *(const u32x4*)(P + (size_t)m * NP + C_GO + c0); rg[t2][1] = *(const u32x4*)(P + (size_t)m * NP + C_GO + c0 + 8); }
#pragma unroll
            for (int t2 = 0; t2 < 2; ++t2) { const int m = m0 + t2 * NGWc; if (m >= T) break;
                float o[16];
#pragma unroll
                for (int j = 0; j < 2; ++j) { const unsigned a[4] = {ra[t2][j].x, ra[t2][j].y, ra[t2][j].z, ra[t2][j].w}, b2[4] = {rb[t2][j].x, rb[t2][j].y, rb[t2][j].z, rb[t2][j].w}, i3[4] = {ri[t2][j].x, ri[t2][j].y, ri[t2][j].z, ri[t2][j].w};
#pragma unroll
                    for (int q = 0; q < 4; ++q) { o[8 * j + 2 * q] = (bflo(a[q]) + bflo(b2[q])) + bflo(i3[q]); o[8 * j + 2 * q + 1] = (bfhi(a[q]) + bfhi(b2[q])) + bfhi(i3[q]); } }
                float ss = 0.f;
#pragma unroll
                for (int j = 0; j < 16; ++j) ss += o[j] * o[j];
                ss += __shfl_xor(ss, 1); ss += __shfl_xor(ss, 2); ss += __shfl_xor(ss, 4); ss += __shfl_xor(ss, 8);
                const float rms = 1.f / sqrtf(ss * (1.f / 256.f) + RMS_EPS);
                const unsigned gw8[8] = {rg[t2][0].x, rg[t2][0].y, rg[t2][0].z, rg[t2][0].w, rg[t2][1].x, rg[t2][1].y, rg[t2][1].z, rg[t2][1].w};
                float r[16];
#pragma unroll
                for (int j = 0; j < 8; ++j) { const float g0 = bflo(gw8[j]), g1 = bfhi(gw8[j]);
                    r[2 * j] = o[2 * j] * rms * ng[2 * j] * g0 * __builtin_amdgcn_rcpf(1.f + __expf(-g0)); r[2 * j + 1] = o[2 * j + 1] * rms * ng[2 * j + 1] * g1 * __builtin_amdgcn_rcpf(1.f + __expf(-g1)); }
                u32x4 w0, w1; w0.x = pk2(r[0], r[1]); w0.y = pk2(r[2], r[3]); w0.z = pk2(r[4], r[5]); w0.w = pk2(r[6], r[7]);
                w1.x = pk2(r[8], r[9]); w1.y = pk2(r[10], r[11]); w1.z = pk2(r[12], r[13]); w1.w = pk2(r[14], r[15]);
                *(u32x4*)(ACAT + (size_t)m * D + 1024 + c0) = w0; *(u32x4*)(ACAT + (size_t)m * D + 1024 + c0 + 8) = w1; }
        }
    }
    SEAM_BG(5, 4);

    if (IN(6)) {
        pg8::DenseOrder S; S.init(T, D, G, bid, WoutT, D);
        EpiOutProj E{Z, HN, MOD};
        pg8::gemm_phase<EpiOutProj, pg8::DenseOrder>(lds, ACAT, D, S, E);
    }
    SEAM_BG(6, 5);

    if (IN(7)) {
        LAS float* part = (LAS float*)lds;
        LAS float* lgt = (LAS float*)(lds + 32768);
        LAS int* selE = (LAS int*)(lds + 36864);
        LAS unsigned* lcnt = (LAS unsigned*)(lds + 36864 + 512);
        LAS unsigned* gbs = lcnt + 32;
        if (tid < 32) lcnt[tid] = 0u;
        typedef float f32x16 __attribute__((ext_vector_type(16)));
        LAS float* LG1 = (LAS float*)(lds + 40960); LAS float* LB1 = LG1 + D; LAS float* SH2 = LB1 + D; LAS float* SC2 = SH2 + D;
        for (int i = tid; i < D; i += NTHREADS) { LG1[i] = ln1_g[i]; LB1[i] = ln1_b[i]; }
        const int GPW = (T / 32 + G - 1) / G; int bprev = -1;
        for (int gi = bid * GPW; gi < bid * GPW + GPW && gi < T / 32; ++gi) { const int g0 = gi * 32;
            if (g0 / SEQ != bprev) { bprev = g0 / SEQ; const float* sh2g = MOD + (g0 / SEQ) * (6 * D) + 3 * D; for (int i = tid; i < D; i += NTHREADS) { SH2[i] = sh2g[i]; SC2[i] = sh2g[D + i]; } }
            LBAR();
            u32x4 zc[4], zn[4];
#pragma unroll
            for (int j2 = 0; j2 < 4; ++j2) zc[j2] = *(const u32x4*)(Z + (size_t)(g0 + wave * 4) * D + 8 * (lane + 64 * j2));
#pragma unroll
            for (int j4 = 0; j4 < 4; ++j4) {
                const int m = g0 + wave * 4 + j4;
                if (j4 + 1 < 4) {
#pragma unroll
                    for (int j2 = 0; j2 < 4; ++j2) zn[j2] = *(const u32x4*)(Z + (size_t)(m + 1) * D + 8 * (lane + 64 * j2)); }
                f32x4 v[8]; float s = 0.f;
#pragma unroll
                for (int j2 = 0; j2 < 4; ++j2) { const u32x4 zz = zc[j2];
                    v[2 * j2] = (f32x4){bflo(zz.x), bfhi(zz.x), bflo(zz.y), bfhi(zz.y)}; v[2 * j2 + 1] = (f32x4){bflo(zz.z), bfhi(zz.z), bflo(zz.w), bfhi(zz.w)}; }
#pragma unroll
                for (int j = 0; j < 8; ++j) s += (v[j].x + v[j].y) + (v[j].z + v[j].w);
                const float mean = wave_sum(s) * (1.f / D); float s2 = 0.f;
#pragma unroll
                for (int j = 0; j < 8; ++j) { v[j] = v[j] - mean; s2 += (v[j].x * v[j].x + v[j].y * v[j].y) + (v[j].z * v[j].z + v[j].w * v[j].w); }
                const float rstd = 1.f / sqrtf(wave_sum(s2) * (1.f / D) + LN_EPS);
#pragma unroll
                for (int j = 0; j < 8; ++j) { const int c = 8 * (lane + 64 * (j >> 1)) + 4 * (j & 1); const f32x4 g = *(const LAS f32x4*)(LG1 + c), bb = *(const LAS f32x4*)(LB1 + c), a = *(const LAS f32x4*)(SH2 + c), sc = *(const LAS f32x4*)(SC2 + c);
                    f32x4 h; h.x = v[j].x * rstd * g.x + bb.x; h.y = v[j].y * rstd * g.y + bb.y; h.z = v[j].z * rstd * g.z + bb.z; h.w = v[j].w * rstd * g.w + bb.w;
                    u32x2 o; o.x = pk2(h.x, h.y); o.y = pk2(h.z, h.w); *(u32x2*)(H1 + (size_t)m * D + c) = o;
                    f32x4 hm; hm.x = h.x * (1.f + sc.x) + a.x; hm.y = h.y * (1.f + sc.y) + a.y; hm.z = h.z * (1.f + sc.z) + a.z; hm.w = h.w * (1.f + sc.w) + a.w;
                    o.x = pk2(hm.x, hm.y); o.y = pk2(hm.z, hm.w); *(u32x2*)(HM2 + (size_t)m * D + c) = o;
                    u32x2 l; l.x = pk2(hm.x - bflo(o.x), hm.y - bfhi(o.x)); l.y = pk2(hm.z - bflo(o.y), hm.w - bfhi(o.y)); *(u32x2*)(HM2LO + (size_t)m * D + c) = l;
                    int f8 = __builtin_amdgcn_cvt_pk_fp8_f32(hm.x, hm.y, 0, false); f8 = __builtin_amdgcn_cvt_pk_fp8_f32(hm.z, hm.w, f8, true); *(int*)(HM2F8 + (size_t)m * D + c) = f8; }
#pragma unroll
                for (int j2 = 0; j2 < 4; ++j2) zc[j2] = zn[j2];
            }
            asm volatile("s_waitcnt vmcnt(0)" ::: "memory"); __syncthreads();
            {
                const int r = lane & 31, hh = lane >> 5; f32x16 acc;
#pragma unroll
                for (int i = 0; i < 16; ++i) acc[i] = 0.f;
#pragma unroll 4
                for (int ks = 0; ks < 16; ++ks) { const int kk = 256 * wave + 16 * ks + 8 * hh;
                    const bf16x8 ahi = *(const bf16x8*)(HM2 + (size_t)(g0 + r) * D + kk), alo = *(const bf16x8*)(HM2LO + (size_t)(g0 + r) * D + kk);
                    const bf16x8 bhi = *(const bf16x8*)(WRH + (size_t)r * D + kk), blo = *(const bf16x8*)(WRL + (size_t)r * D + kk);
                    acc = __builtin_amdgcn_mfma_f32_32x32x16_bf16(ahi, bhi, acc, 0, 0, 0); acc = __builtin_amdgcn_mfma_f32_32x32x16_bf16(alo, bhi, acc, 0, 0, 0); acc = __builtin_amdgcn_mfma_f32_32x32x16_bf16(ahi, blo, acc, 0, 0, 0); }
#pragma unroll
                for (int i = 0; i < 16; ++i) part[(wave * 32 + (i & 3) + 8 * (i >> 2) + 4 * hh) * 32 + r] = acc[i];
            }
            LBAR();
#pragma unroll
            for (int j = 0; j < 2; ++j) { const int idx = tid + 512 * j; float sum = b_router[idx & 31];
#pragma unroll
                for (int w8 = 0; w8 < 8; ++w8) sum += part[w8 * 1024 + idx];
                lgt[idx] = sum; }
            LBAR();
#pragma unroll 1
            for (int j4 = 0; j4 < 4; ++j4) {
                const int tok = wave * 4 + j4, m = g0 + tok;
                float val = lane < 32 ? lgt[tok * 32 + lane] : -INFINITY; float tv[4]; int ti[4];
#pragma unroll
                for (int k = 0; k < 4; ++k) { const float mx = wave_max_dpp(val); const unsigned long long bm = __ballot(val == mx); const int idx = __ffsll((long long)bm) - 1;
                    tv[k] = mx; ti[k] = idx; if (lane == idx) val = -INFINITY; }
                const float e1 = expf(tv[1] - tv[0]), e2 = expf(tv[2] - tv[0]), e3 = expf(tv[3] - tv[0]); const float inv = 1.f / (1.f + e1 + e2 + e3);
                if (lane < 4) { const int ex = lane == 0 ? ti[0] : lane == 1 ? ti[1] : lane == 2 ? ti[2] : ti[3]; const float w = (lane == 0 ? 1.f : lane == 1 ? e1 : lane == 2 ? e2 : e3) * inv;
                    selE[tok * 4 + lane] = ex; TOPW[m * 4 + lane] = w; }
            }
            LBAR();
            int ex = 0; unsigned lpos = 0;
            if (tid < 128) { ex = selE[tid]; lpos = __hip_atomic_fetch_add(lcnt + ex, 1u, __ATOMIC_RELAXED, __HIP_MEMORY_SCOPE_WORKGROUP); }
            LBAR();
            if (tid < 32) { const unsigned c = lcnt[tid]; gbs[tid] = c ? atomicAdd(CNT + tid * 64, c) : 0u; lcnt[tid] = 0u; }
            LBAR();
            if (tid < 128) { const unsigned pos = gbs[ex] + lpos; const int m = g0 + (tid >> 2); LIST[ex * T + pos] = m * 4 + (tid & 3); TOPEP[m * 4 + (tid & 3)] = ((unsigned)ex << 16) | pos; }
        }
    }
    SEAM(7);

    if (IN(8) || IN(9)) {
        LAS int* tb = (LAS int*)(lds + TBL_OFF);
        LAS int* cn = tb + 64;
        LBAR();
        if (tid == 0) { int a = 0; for (int e = 0; e < NE; ++e) { const int c = (int)CNT[e * 64]; cn[e] = c; tb[e] = a; a += (c + 255) / 256; } tb[NE] = a; }
        LBAR();
        if (IN(8) && is_conv) CONV_SLICE(CV_GU, CV_TOT - CV_GU);
        if (IN(8) && !is_conv) {
            LAS int* UT = (LAS int*)(lds + TBL_OFF + 512);
            LAS bf16* BT = (LAS bf16*)(lds + EPT_OFF); LAS unsigned short* RL = (LAS unsigned short*)(lds + EPT_OFF + EPT_RL * 512);
            MoeOrder<true> S{tb, cn, 16, Gc, bid, WguT, (size_t)4096 * 2048, LIST, D, UT, RL};
            S.build(UT, tid); LBAR(); S.pack(lane);
            { int pr[EPT_RL]; float pv[EPT_RL]; const int t8 = tid & 255;
#pragma unroll
              for (int i = 0; i < EPT_RL; ++i) { pg8::Unit pu; const bool ok = S.next(i, pu); pr[i] = (ok && t8 < pu.nv) ? LIST[pu.e * T + pu.mt * 256 + t8] >> 2 : 0;
                  pv[i] = ok ? b_gu[(size_t)pu.e * 4096 + (t8 >> 7) * 2048 + pu.pn * 128 + (t8 & 127)] : 0.f; }
#pragma unroll
              for (int i = 0; i < EPT_RL; ++i) if (tid < 256) { RL[i * 256 + tid] = (unsigned short)pr[i]; BT[i * 256 + tid] = (bf16)f2bf(pv[i]); } }
            LBAR();
            EpiGateUp E{ACT, BT};
            pg8::gemm_phase<EpiGateUp, MoeOrder<true>, 1>(lds, HM2F8, D, S, E);
        }
        if (IN(9)) {
            LAS int* UT = (LAS int*)(lds + TBL_OFF + 512);
            MoeOrder<false> S{tb, cn, 8, G, bid, WdnT, (size_t)2048 * 2048, LIST, D, UT, nullptr};
            S.build(UT, tid); LBAR(); S.pack(lane);
            LAS float* BT = (LAS float*)(lds + EPT_OFF); LAS int* LT = (LAS int*)(lds + EPT_OFF + EPT_UNITS9 * 1024);
            { float pv[EPT_UNITS9]; int pl[EPT_UNITS9]; const int t8 = tid & 255;
#pragma unroll
              for (int i = 0; i < EPT_UNITS9; ++i) { pg8::Unit pu; const bool ok = S.next(i, pu); pv[i] = ok ? b_dn[(size_t)pu.e * 2048 + pu.pn * 256 + t8] : 0.f; pl[i] = (ok && t8 < pu.nv) ? LIST[pu.e * T + pu.mt * 256 + t8] : 0; }
#pragma unroll
              for (int i = 0; i < EPT_UNITS9; ++i) if (tid < 256) { BT[i * 256 + tid] = pv[i]; LT[i * 256 + tid] = pl[i]; } }
            LBAR();
            if (IN(8)) xcd_barrier(bar);
            EpiDown E{YB, BT, LT};
            pg8::gemm_phase<EpiDown, MoeOrder<false>, 1>(lds, ACT, D, S, E);
        }
    }
    if (IN(10)) {
        LAS float* G2T = (LAS float*)lds; LAS float* LG = G2T + 4 * D; LAS float* LB = LG + D;
        for (int i = tid; i < 4 * D; i += NTHREADS) G2T[i] = MOD[(i / D) * (6 * D) + 5 * D + (i % D)];
        for (int i = tid; i < D; i += NTHREADS) { LG[i] = ln2_g[i]; LB[i] = ln2_b[i]; }
    }
    SEAM(9);

    if (IN(10)) {
        LAS float* G2T = (LAS float*)lds; LAS float* LG = G2T + 4 * D; LAS float* LB = LG + D;
        LBAR();
        for (int m0 = gw; m0 < T; m0 += 2 * NGW) {
            u32x4 hr[2][4]; u32x2 yr[2][4][4]; f32x4 wr4[2];
#pragma unroll
            for (int t2 = 0; t2 < 2; ++t2) { const int m = (m0 + t2 * NGW) < T ? m0 + t2 * NGW : m0;
                wr4[t2] = *(const f32x4*)(TOPW + m * 4);
#pragma unroll
                for (int j = 0; j < 4; ++j) { const int c = 8 * (lane + 64 * j); hr[t2][j] = *(const u32x4*)(H1 + (size_t)m * D + c);
#pragma unroll
                    for (int k = 0; k < 4; ++k) yr[t2][j][k] = *(const u32x2*)(YB + ((size_t)m * 4 + k) * D + c); } }
#pragma unroll
            for (int t2 = 0; t2 < 2; ++t2) { const int m = m0 + t2 * NGW; if (m >= T) break;
                const LAS float* g2 = G2T + (m / SEQ) * D;
                const float w0 = wr4[t2].x, w1 = wr4[t2].y, w2 = wr4[t2].z, w3 = wr4[t2].w;
                float z[4][8]; float s = 0.f;
#pragma unroll
                for (int j = 0; j < 4; ++j) { const int c = 8 * (lane + 64 * j);
                    const u32x4 h = hr[t2][j]; const u32x2 y0 = yr[t2][j][0], y1 = yr[t2][j][1], y2 = yr[t2][j][2], y3 = yr[t2][j][3];
                    const f32x4 ga = *(const LAS f32x4*)(g2 + c), gb = *(const LAS f32x4*)(g2 + c + 4);
                    const unsigned hw[4] = {h.x, h.y, h.z, h.w}, a0[2] = {y0.x, y0.y}, a1[2] = {y1.x, y1.y}, a2[2] = {y2.x, y2.y}, a3[2] = {y3.x, y3.y};
                    const float gg[8] = {ga.x, ga.y, ga.z, ga.w, gb.x, gb.y, gb.z, gb.w};
#pragma unroll
                    for (int q = 0; q < 2; ++q)
#pragma unroll
                        for (int h2 = 0; h2 < 2; ++h2) { const int e0 = 4 * q + 2 * h2;
                            const f32v2 p0 = h2 ? __builtin_amdgcn_cvt_pk_f32_fp8((int)a0[q], true) : __builtin_amdgcn_cvt_pk_f32_fp8((int)a0[q], false), p1 = h2 ? __builtin_amdgcn_cvt_pk_f32_fp8((int)a1[q], true) : __builtin_amdgcn_cvt_pk_f32_fp8((int)a1[q], false);
                            const f32v2 p2 = h2 ? __builtin_amdgcn_cvt_pk_f32_fp8((int)a2[q], true) : __builtin_amdgcn_cvt_pk_f32_fp8((int)a2[q], false), p3 = h2 ? __builtin_amdgcn_cvt_pk_f32_fp8((int)a3[q], true) : __builtin_amdgcn_cvt_pk_f32_fp8((int)a3[q], false);
                            const float flo = (((w0 * p0.x + w1 * p1.x) + w2 * p2.x) + w3 * p3.x) * (1.f / YSC);
                            const float fhi = (((w0 * p0.y + w1 * p1.y) + w2 * p2.y) + w3 * p3.y) * (1.f / YSC);
                            const unsigned hword = hw[e0 >> 1];
                            z[j][e0] = ALPHA * bflo(hword) + gg[e0] * flo; z[j][e0 + 1] = ALPHA * bfhi(hword) + gg[e0 + 1] * fhi; s += z[j][e0] + z[j][e0 + 1]; }
                }
                const float mean = wave_sum(s) * (1.f / D); float s2 = 0.f;
#pragma unroll
                for (int j = 0; j < 4; ++j)
#pragma unroll
                    for (int q = 0; q < 8; ++q) { z[j][q] -= mean; s2 += z[j][q] * z[j][q]; }
                const float rstd = 1.f / sqrtf(wave_sum(s2) * (1.f / D) + LN_EPS);
#pragma unroll
                for (int j = 0; j < 4; ++j) { const int c = 8 * (lane + 64 * j);
                    const f32x4 ga = *(const LAS f32x4*)(LG + c), gb = *(const LAS f32x4*)(LG + c + 4), ba = *(const LAS f32x4*)(LB + c), bb = *(const LAS f32x4*)(LB + c + 4);
                    f32x4 o0, o1; o0.x = z[j][0] * rstd * ga.x + ba.x; o0.y = z[j][1] * rstd * ga.y + ba.y; o0.z = z[j][2] * rstd * ga.z + ba.z; o0.w = z[j][3] * rstd * ga.w + ba.w;
                    o1.x = z[j][4] * rstd * gb.x + bb.x; o1.y = z[j][5] * rstd * gb.y + bb.y; o1.z = z[j][6] * rstd * gb.z + bb.z; o1.w = z[j][7] * rstd * gb.w + bb.w;
                    *(f32x4*)(out + (size_t)m * D + c) = o0; *(f32x4*)(out + (size_t)m * D + c + 4) = o1; }
            }
        }
    }
#undef IN
#undef SEAM
}

extern "C" void kernel_launch(void* const* d_in, const int* in_sizes, int n_in, void* d_out, int out_size, void* d_ws, size_t ws_size, hipStream_t stream) {
    static int grid = 0;
    if (grid == 0) {
        if (n_in != 29 || out_size != T * D || ws_size < WS_END) { fprintf(stderr, "kernel_launch: unexpected shapes (n_in %d, out %d, ws %zu); nothing launched\n", n_in, out_size, ws_size); grid = -1; return; }
        int dev = 0, cus = 0, per_cu = 0;
        if (hipGetDevice(&dev) != hipSuccess || hipDeviceGetAttribute(&cus, hipDeviceAttributeMultiprocessorCount, dev) != hipSuccess) { grid = -1; return; }
        if (hipFuncSetAttribute((const void*)fwd, hipFuncAttributeMaxDynamicSharedMemorySize, LDS_BYTES) != hipSuccess) { fprintf(stderr, "kernel_launch: hipFuncSetAttribute failed\n"); grid = -1; return; }
        if (hipOccupancyMaxActiveBlocksPerMultiprocessor(&per_cu, (const void*)fwd, NTHREADS, LDS_BYTES) != hipSuccess || per_cu < 1) { fprintf(stderr, "kernel_launch: occupancy query says %d\n", per_cu); }
        (void)hipGetLastError();
        grid = cus;
    }
    if (grid < 0) return;
    if (hipMemsetAsync((char*)d_ws + WS_CTL, 0, CTL_BYTES, stream) != hipSuccess) return;
    Args a{};
    for (int i = 0; i < 29; ++i) a.in[i] = (const float*)d_in[i];
    a.out = (float*)d_out; a.ws = (unsigned char*)d_ws;
#if PROBE_DUP >= 0
    a.ph_lo = 0; a.ph_hi = PROBE_DUP + 1; hipLaunchKernelGGL(fwd, dim3(grid), dim3(NTHREADS), LDS_BYTES, stream, a);
    hipMemsetAsync((char*)d_ws + WS_CTL + CW_BAR * 4, 0, XCD_BAR_WORDS * 4, stream);
    a.ph_lo = PROBE_DUP; a.ph_hi = NPHASE; hipLaunchKernelGGL(fwd, dim3(grid), dim3(NTHREADS), LDS_BYTES, stream, a);
#elif MK_ONE_LAUNCH
    a.ph_lo = 0; a.ph_hi = NPHASE;
    hipLaunchKernelGGL(fwd, dim3(grid), dim3(NTHREADS), LDS_BYTES, stream, a);
#else
    for (int p = 0; p < NPHASE; ++p) { a.ph_lo = p; a.ph_hi = p + 1; hipLaunchKernelGGL(fwd, dim3(grid), dim3(NTHREADS), LDS_BYTES, stream, a); }
#endif
}
```
